# Optimizing an MI355X kernel written in HIP

```python
import jax, jax.numpy as jnp
from jax import lax
import numpy as np

D_MODEL = 2048
BATCH = 4
SEQ = 2048
DEPTH = 4

N_HEADS = 16
HEAD_DIM = D_MODEL // N_HEADS
MIX_WIDTH = N_HEADS * HEAD_DIM
DIL_GROUPS = ((128, 1), (512, 4), (2048, 16))
N_GROUPS = len(DIL_GROUPS)
ROPE_THETA = 500000.0
ROT_DIM = HEAD_DIM // 4
CHUNK = 128
N_CH_GROUPS = 16
CH_GROUP = MIX_WIDTH // N_CH_GROUPS
RMS_EPS = 1e-6
LN_EPS = 1e-5
NEG_INF = -1e30
N_A = (DEPTH + 1) // 2
N_B = DEPTH // 2
A_IN = N_GROUPS * 3 * MIX_WIDTH + MIX_WIDTH
B_IN = 3 * MIX_WIDTH

kernel_name = "hybrid_dilated_attn_chunked_gmlp"


def rmsnorm(x, g):
    xf = x.astype(jnp.float32)
    y = xf * lax.rsqrt(jnp.mean(xf * xf, axis=-1, keepdims=True) + RMS_EPS)
    return (y * g.astype(jnp.float32)).astype(x.dtype)


def partial_rope(t, positions):
    half = ROT_DIM // 2
    inv_freq = ROPE_THETA ** (-(jnp.arange(half, dtype=jnp.float32) * 2.0) / ROT_DIM)
    ang = positions.astype(jnp.float32)[..., None] * inv_freq
    cos = jnp.cos(ang)[:, :, None, :]
    sin = jnp.sin(ang)[:, :, None, :]
    tf = t.astype(jnp.float32)
    x1, x2 = tf[..., :half], tf[..., half:ROT_DIM]
    out = jnp.concatenate([x1 * cos - x2 * sin, x2 * cos + x1 * sin, tf[..., ROT_DIM:]], axis=-1)
    return out.astype(t.dtype)


def dilated_window_attention(q, k, v, window, dilation):
    b, s, h, e = q.shape
    blk = window // dilation
    span = blk * dilation
    s_pad = -(-s // span) * span
    L = s_pad // dilation
    nb = L // blk
    pad = ((0, 0), (0, s_pad - s), (0, 0), (0, 0))

    def to_blocks(t):
        t = jnp.pad(t.astype(jnp.float32), pad).reshape(b, L, dilation, h, e)
        return t.transpose(0, 2, 1, 3, 4).reshape(b, dilation, nb, blk, h, e)

    def with_prev(t):
        prev = jnp.pad(t, ((0, 0), (0, 0), (1, 0), (0, 0), (0, 0), (0, 0)))[:, :, :-1]
        return jnp.concatenate([prev, t], axis=3)

    qb = to_blocks(q)
    kk = with_prev(to_blocks(k))
    vv = with_prev(to_blocks(v))
    scores = jnp.einsum('brnqhe,brnkhe->brnhqk', qb, kk) * (e ** -0.5)
    qi = jnp.arange(blk)[:, None]
    kj = jnp.arange(2 * blk)[None, :]
    dist = blk + qi - kj
    band = (dist >= 0) & (dist <= blk)
    has_prev = (jnp.arange(nb) > 0)[:, None, None] | (kj >= blk)[None]
    mask = band[None] & has_prev
    scores = jnp.where(mask[:, None], scores, NEG_INF)
    lse = jax.nn.logsumexp(scores, axis=-1)
    p = jnp.exp(scores - lse[..., None])
    out = jnp.einsum('brnhqk,brnkhe->brnqhe', p, vv)
    out = out.reshape(b, dilation, L, h, e).transpose(0, 2, 1, 3, 4).reshape(b, s_pad, h, e)[:, :s]
    lse = lse.transpose(0, 1, 2, 4, 3).reshape(b, dilation, L, h)
    lse = lse.transpose(0, 2, 1, 3).reshape(b, s_pad, h)[:, :s]
    return out, lse


def dilated_attention_layer(x, positions, norm_g, w_in, w_out):
    b, s, _ = x.shape
    hn = rmsnorm(x, norm_g)
    proj = hn @ w_in
    n_qkv = N_GROUPS * 3 * MIX_WIDTH
    qkv = proj[..., :n_qkv].reshape(b, s, N_GROUPS, 3, N_HEADS, HEAD_DIM)
    gate = proj[..., n_qkv:]
    outs, lses = [], []
    for g, (window, dilation) in enumerate(DIL_GROUPS):
        q = partial_rope(qkv[:, :, g, 0], positions)
        k = partial_rope(qkv[:, :, g, 1], positions)
        o, l = dilated_window_attention(q, k, qkv[:, :, g, 2], window, dilation)
        outs.append(o)
        lses.append(l)
    wts = jax.nn.softmax(jnp.stack(lses, axis=0), axis=0)
    mixed = jnp.sum(wts[..., None] * jnp.stack(outs, axis=0), axis=0)
    y = mixed.reshape(b, s, MIX_WIDTH).astype(x.dtype) * jax.nn.silu(gate)
    return x + y @ w_out


def chunked_spatial_gating_layer(x, norm_g, w_in, ln_g, ln_b, w_s, b_s, w_out):
    b, s, _ = x.shape
    hn = rmsnorm(x, norm_g)
    u, v, z = jnp.split(hn @ w_in, 3, axis=-1)
    u = jax.nn.gelu(u, approximate=False)
    v = jax.nn.gelu(v, approximate=False)
    vf = v.astype(jnp.float32)
    mu = jnp.mean(vf, axis=-1, keepdims=True)
    var = jnp.mean(jnp.square(vf - mu), axis=-1, keepdims=True)
    vn = (vf - mu) * lax.rsqrt(var + LN_EPS) * ln_g.astype(jnp.float32) + ln_b.astype(jnp.float32)
    nc = s // CHUNK
    vc = vn.reshape(b, nc, CHUNK, N_CH_GROUPS, CH_GROUP)
    causal = jnp.tril(jnp.ones((CHUNK, CHUNK), dtype=bool))
    wm = jnp.where(causal[None], w_s.astype(jnp.float32), 0.0)
    sv = jnp.einsum('gts,bnsgc->bntgc', wm, vc) + b_s.astype(jnp.float32).T[None, None, :, :, None]
    sgu = u.astype(jnp.float32) * sv.reshape(b, s, MIX_WIDTH)
    y = sgu.astype(x.dtype) * jax.nn.silu(z)
    return x + y @ w_out


def setup_inputs(seed: int = 0) -> dict:
    key = jax.random.key(seed)
    ks = jax.random.split(key, 14)
    f32 = jnp.float32
    x = jax.random.normal(ks[0], (BATCH, SEQ, D_MODEL), f32)
    positions = jnp.broadcast_to(jnp.arange(SEQ, dtype=jnp.int32)[None, :], (BATCH, SEQ))
    a_norm_g = 1.0 + 0.01 * jax.random.normal(ks[1], (N_A, D_MODEL), f32)
    a_w_in = jax.random.normal(ks[2], (N_A, D_MODEL, A_IN), f32) * D_MODEL ** -0.5
    a_w_out = jax.random.normal(ks[3], (N_A, MIX_WIDTH, D_MODEL), f32) * MIX_WIDTH ** -0.5
    b_norm_g = 1.0 + 0.01 * jax.random.normal(ks[4], (N_B, D_MODEL), f32)
    b_w_in = jax.random.normal(ks[5], (N_B, D_MODEL, B_IN), f32) * D_MODEL ** -0.5
    b_ln_g = 1.0 + 0.01 * jax.random.normal(ks[6], (N_B, MIX_WIDTH), f32)
    b_ln_b = 0.01 * jax.random.normal(ks[7], (N_B, MIX_WIDTH), f32)
    b_w_s = jax.random.normal(ks[8], (N_B, N_CH_GROUPS, CHUNK, CHUNK), f32) * CHUNK ** -0.5
    b_b_s = 1.0 + 0.02 * jax.random.normal(ks[9], (N_B, N_CH_GROUPS, CHUNK), f32)
    b_w_out = jax.random.normal(ks[10], (N_B, MIX_WIDTH, D_MODEL), f32) * MIX_WIDTH ** -0.5
    final_norm_g = 1.0 + 0.01 * jax.random.normal(ks[11], (D_MODEL,), f32)
    return {"x": x, "positions": positions,
            "a_norm_g": a_norm_g, "a_w_in": a_w_in, "a_w_out": a_w_out,
            "b_norm_g": b_norm_g, "b_w_in": b_w_in, "b_ln_g": b_ln_g, "b_ln_b": b_ln_b,
            "b_w_s": b_w_s, "b_b_s": b_b_s, "b_w_out": b_w_out,
            "final_norm_g": final_norm_g}


def reference(x, positions, a_norm_g, a_w_in, a_w_out, b_norm_g, b_w_in, b_ln_g, b_ln_b,
              b_w_s, b_b_s, b_w_out, final_norm_g):
    for i in range(DEPTH):
        j = i // 2
        if i % 2 == 0:
            x = dilated_attention_layer(x, positions, a_norm_g[j], a_w_in[j], a_w_out[j])
        else:
            x = chunked_spatial_gating_layer(x, b_norm_g[j], b_w_in[j], b_ln_g[j], b_ln_b[j],
                                             b_w_s[j], b_b_s[j], b_w_out[j])
    return rmsnorm(x, final_norm_g)
```

```cpp
#include <hip/hip_runtime.h>
#include <hip/hip_cooperative_groups.h>
#include <cstdio>
#include <cstdint>
#include <cmath>
namespace cg = cooperative_groups;
#ifndef MK_PER_PHASE
#define MK_PER_PHASE 0
#endif
namespace pg8 {
#define PG8_LAS __attribute__((address_space(3)))
typedef unsigned short bf16_t;
typedef short bf16x8 __attribute__((ext_vector_type(8)));
typedef float f32x4 __attribute__((ext_vector_type(4)));
typedef unsigned u32x4 __attribute__((ext_vector_type(4)));
constexpr int BM = 256, BK = 64, HALF = 128, HTB = HALF * BK * 2  , STAGE_BYTES = 8 * HTB, NXCD = 8, WGM = 8;

__host__ __device__ __forceinline__ int lds_byte(int r, int c) { const int st = (r >> 4) * 2 + (c >> 5), rr = r & 15, cc = c & 31, ob = rr * 64 + cc * 2; return st * 1024 + (ob ^ (((ob >> 9) & 1) << 5)); }
__host__ __device__ __forceinline__ void stage_rc(int b, int& R, int& C) { const int st = b / 1024, sb = b % 1024, swz = sb ^ (((sb >> 9) & 1) << 5); R = (st >> 1) * 16 + swz / 64; C = (st & 1) * 32 + (swz % 64) / 2; }
__host__ __device__ __forceinline__ int perm32(int rho) { const int n = rho >> 4, i = rho & 15; return 8 * (i >> 2) + 4 * n + (i & 3); }

struct Unit { int pm, pn; };
struct Gemm { const bf16_t* A; const bf16_t* Bt; int M, N, K; int bdil; };
__device__ __forceinline__ size_t b_tile_off(const Gemm& g, int pn) { const int t8 = pn & 7; const int r = (pn >> 3) * 2048 + (g.bdil == 1 ? 256 * t8 : (g.bdil == 4 ? 1024 * (t8 & 1) + (t8 >> 1) : 2 * t8)); return (size_t)r * g.K * 2; }

struct StaticOrder {
    int nM, nN, nwg, G, c;
    __host__ __device__ void init(int M, int N, int G_, int c_) { nM = M / BM; nN = N / BM; nwg = nM * nN; G = G_; c = c_; }
    __host__ __device__ bool next(int i, Unit& u) const {
        const long L = (long)i * G + c; if (L >= nwg) return false;
        int wgid = (int)L; { const int q = nwg / NXCD, r = nwg % NXCD, xcd = wgid % NXCD, off = wgid / NXCD; wgid = (xcd < r ? xcd * (q + 1) : r * (q + 1) + (xcd - r) * q) + off; }
        const int nig = WGM * nN, gid = wgid / nig, fm = gid * WGM, gsz = (nM - fm) < WGM ? (nM - fm) : WGM;
        u.pm = fm + ((wgid % nig) % gsz); u.pn = (wgid % nig) / gsz; return true;
    }
    __device__ __forceinline__ void a_ready(const Unit&) const {}
    __device__ __forceinline__ void done(const Unit&) const {}
};

__device__ __forceinline__ unsigned cvt_pk_bf16(float lo, float hi) { unsigned r; asm volatile("v_cvt_pk_bf16_f32 %0, %1, %2" : "=v"(r) : "v"(lo), "v"(hi)); return r; }
typedef float f32x2 __attribute__((ext_vector_type(2)));
__device__ __forceinline__ f32x2 gelu_pk(f32x2 v) {
    const f32x2 av = __builtin_elementwise_abs(v), d = av * 0.2316418882f + 1.0f;
    f32x2 t; t.x = __builtin_amdgcn_rcpf(d.x); t.y = __builtin_amdgcn_rcpf(d.y);
    f32x2 q = t * 0.5307027145f + (-0.7265760135f); q = q * t + 0.7107068705f; q = q * t + (-0.142248368f); q = q * t + 0.127414796f; q = q * t;
    const f32x2 s = (v * v) * (-0.72134752044f);
    f32x2 e; e.x = __builtin_amdgcn_exp2f(s.x); e.y = __builtin_amdgcn_exp2f(s.y);
    const f32x2 m = v * (q * e), r = v - m;
    f32x2 o; o.x = v.x < 0.f ? m.x : r.x; o.y = v.y < 0.f ? m.y : r.y; return o;
}

constexpr float C2 = 0.08838834764831845f * 1.4426950408889634f;
__device__ __forceinline__ float silu_f(float x) { return x * __builtin_amdgcn_rcpf(1.0f + __builtin_amdgcn_exp2f(-1.4426950408889634f * x)); }
__device__ __forceinline__ u32x4 pack8(const f32x4& v0, const f32x4& v1) { u32x4 w; w.x = cvt_pk_bf16(v0[0], v0[1]); w.y = cvt_pk_bf16(v0[2], v0[3]); w.z = cvt_pk_bf16(v1[0], v1[1]); w.w = cvt_pk_bf16(v1[2], v1[3]); return w; }
__device__ __forceinline__ void gelu8(f32x4& v0, f32x4& v1) { f32x2 a = gelu_pk((f32x2){v0[0], v0[1]}), b = gelu_pk((f32x2){v0[2], v0[3]}), c = gelu_pk((f32x2){v1[0], v1[1]}), d = gelu_pk((f32x2){v1[2], v1[3]});
    v0 = (f32x4){a.x, a.y, b.x, b.y}; v1 = (f32x4){c.x, c.y, d.x, d.y}; }

struct EpiA1 {
    static constexpr bool PERM = true, AFTER_DRAIN = false;
    bf16_t* QK; bf16_t* GATE; const float* COS; const float* SIN;
    __device__ __forceinline__ void operator()(const f32x4 (&acc)[2][2][4][2], const Unit& u, int wr, int wc, int fr, int fq) const {
        const int pn = u.pn; const int rowb = u.pm * BM + wr * 64 + fr;
        if (pn >= 48) {
            const int col0 = (pn - 48) * 256 + wc * 32 + 8 * fq;
#pragma unroll
            for (int ai = 0; ai < 2; ++ai)
#pragma unroll
                for (int m = 0; m < 4; ++m) { bf16_t* rowp = GATE + (size_t)(rowb + ai * HALF + m * 16) * 2048 + col0;
#pragma unroll
                    for (int bj = 0; bj < 2; ++bj) { f32x4 v0 = acc[ai][bj][m][0], v1 = acc[ai][bj][m][1];
#pragma unroll
                        for (int i = 0; i < 4; ++i) { v0[i] = silu_f(v0[i]); v1[i] = silu_f(v1[i]); }
                        *(u32x4*)(rowp + bj * HALF) = pack8(v0, v1); } }
        } else {
            const int g = pn >> 4, qk = (pn >> 3) & 1, hp = pn & 7, dsh = 2 * g, dm1 = (1 << dsh) - 1;
            const float sc = qk == 0 ? C2 : 1.0f; const float sgn = fq < 2 ? -1.0f : 1.0f; const int e0 = wc * 32 + 8 * fq;
#pragma unroll
            for (int ai = 0; ai < 2; ++ai)
#pragma unroll
                for (int m = 0; m < 4; ++m) { const int row = rowb + ai * HALF + m * 16, b = row >> 11, s = row & 2047, p = ((s & dm1) << (11 - dsh)) | (s >> dsh);
                    f32x4 c0, c1, s0, s1;
                    if (wc == 0) { const float* cp = COS + (size_t)row * 16 + 8 * (fq & 1); const float* sp = SIN + (size_t)row * 16 + 8 * (fq & 1);
                        c0 = *(const f32x4*)cp; c1 = *(const f32x4*)(cp + 4); s0 = *(const f32x4*)sp; s1 = *(const f32x4*)(sp + 4); }
#pragma unroll
                    for (int bj = 0; bj < 2; ++bj) { f32x4 v0 = acc[ai][bj][m][0], v1 = acc[ai][bj][m][1];
                        if (wc == 0) {
#pragma unroll
                            for (int i = 0; i < 4; ++i) { const float p0 = __shfl_xor(v0[i], 32), p1 = __shfl_xor(v1[i], 32);
                                v0[i] = v0[i] * c0[i] + sgn * p0 * s0[i]; v1[i] = v1[i] * c1[i] + sgn * p1 * s1[i]; } }
                        v0 = v0 * sc; v1 = v1 * sc;
                        bf16_t* dst = QK + ((((size_t)((g * 2 + qk) * 4 + b) * 16 + (2 * hp + bj)) * 2048 + p) * 128 + e0);
                        *(u32x4*)dst = pack8(v0, v1); } }
        }
    }
};
struct EpiB1 {
    static constexpr bool PERM = true, AFTER_DRAIN = false;
    bf16_t* U; bf16_t* ZS;
    __device__ __forceinline__ void operator()(const f32x4 (&acc)[2][2][4][2], const Unit& u, int wr, int wc, int fr, int fq) const {
        const int pn = u.pn; const int rowb = u.pm * BM + wr * 64 + fr; const bool isz = pn >= 8;
        bf16_t* base = isz ? ZS : U; const int col0 = (pn & 7) * 256 + wc * 32 + 8 * fq;
#pragma unroll
        for (int ai = 0; ai < 2; ++ai)
#pragma unroll
            for (int m = 0; m < 4; ++m) { bf16_t* rowp = base + (size_t)(rowb + ai * HALF + m * 16) * 2048 + col0;
#pragma unroll
                for (int bj = 0; bj < 2; ++bj) { f32x4 v0 = acc[ai][bj][m][0], v1 = acc[ai][bj][m][1];
                    if (isz) {
#pragma unroll
                        for (int i = 0; i < 4; ++i) { v0[i] = silu_f(v0[i]); v1[i] = silu_f(v1[i]); }
                    } else gelu8(v0, v1);
                    *(u32x4*)(rowp + bj * HALF) = pack8(v0, v1); } }
    }
};
struct EpiPlain {
    static constexpr bool PERM = true, AFTER_DRAIN = false;
    bf16_t* O; int ldc;
    __device__ __forceinline__ void operator()(const f32x4 (&acc)[2][2][4][2], const Unit& u, int wr, int wc, int fr, int fq) const {
        const int rowb = u.pm * BM + wr * 64 + fr; const int col0 = u.pn * BM + wc * 32 + 8 * fq;
#pragma unroll
        for (int ai = 0; ai < 2; ++ai)
#pragma unroll
            for (int m = 0; m < 4; ++m) { bf16_t* rowp = O + (size_t)(rowb + ai * HALF + m * 16) * ldc + col0;
#pragma unroll
                for (int bj = 0; bj < 2; ++bj) *(u32x4*)(rowp + bj * HALF) = pack8(acc[ai][bj][m][0], acc[ai][bj][m][1]); }
    }
};
struct EpiB2 {
    static constexpr bool PERM = true, AFTER_DRAIN = false;
    bf16_t* VT; float* STATS;
    __device__ __forceinline__ void operator()(const f32x4 (&acc)[2][2][4][2], const Unit& u, int wr, int wc, int fr, int fq) const {
        const int rowb = u.pm * BM + wr * 64 + fr; const int col0 = u.pn * BM + wc * 32 + 8 * fq;
        float s1[2][8], s2[2][8];
#pragma unroll
        for (int bj = 0; bj < 2; ++bj)
#pragma unroll
            for (int k = 0; k < 8; ++k) { s1[bj][k] = 0.f; s2[bj][k] = 0.f; }
#pragma unroll
        for (int ai = 0; ai < 2; ++ai)
#pragma unroll
            for (int m = 0; m < 4; ++m) { bf16_t* rowp = VT + (size_t)(rowb + ai * HALF + m * 16) * 8192 + col0;
#pragma unroll
                for (int bj = 0; bj < 2; ++bj) { f32x4 v0 = acc[ai][bj][m][0], v1 = acc[ai][bj][m][1]; gelu8(v0, v1);
#pragma unroll
                    for (int i = 0; i < 4; ++i) { s1[bj][i] += v0[i]; s2[bj][i] += v0[i] * v0[i]; s1[bj][4 + i] += v1[i]; s2[bj][4 + i] += v1[i] * v1[i]; }
                    *(u32x4*)(rowp + bj * HALF) = pack8(v0, v1); } }
#pragma unroll
        for (int bj = 0; bj < 2; ++bj)
#pragma unroll
            for (int k = 0; k < 8; ++k) {
#pragma unroll
                for (int o = 1; o < 16; o <<= 1) { s1[bj][k] += __shfl_xor(s1[bj][k], o); s2[bj][k] += __shfl_xor(s2[bj][k], o); }
                if (fr == 0) { float* sp = STATS + 2 * (size_t)(col0 + bj * HALF + k); atomicAdd(sp, s1[bj][k]); atomicAdd(sp + 1, s2[bj][k]); } }
    }
};
struct EpiOut {
    static constexpr bool PERM = false, AFTER_DRAIN = false;
    const float* base; float* out;
    __device__ __forceinline__ void operator()(const f32x4 (&acc)[2][2][4][2], const Unit& u, int wr, int wc, int fr, int fq) const {
        const int rowb = u.pm * BM + wr * 64 + fr; const int col0 = u.pn * BM + wc * 32 + 4 * fq;
#pragma unroll
        for (int ai = 0; ai < 2; ++ai)
#pragma unroll
            for (int m = 0; m < 4; ++m) { const size_t off = (size_t)(rowb + ai * HALF + m * 16) * 2048 + col0;
#pragma unroll
                for (int bj = 0; bj < 2; ++bj)
#pragma unroll
                    for (int n = 0; n < 2; ++n) { const f32x4 bs = *(const f32x4*)(base + off + bj * HALF + n * 16); *(f32x4*)(out + off + bj * HALF + n * 16) = bs + acc[ai][bj][m][n]; } }
    }
};
template <class Epi, class Sched, bool ALIGN_EPI = false, bool SP2 = false>
__device__ __forceinline__ void gemm_phase(PG8_LAS unsigned char* lds, const Gemm g, const Sched& S, const Epi& E) {
    int tid = threadIdx.x; asm volatile("" : "+v"(tid)); const int wid = __builtin_amdgcn_readfirstlane(tid >> 6), lane = tid & 63, wr = wid >> 2, wc = wid & 3, fr = lane & 15, fq = lane >> 4;
    const int K = g.K, nt = K / BK;
    unsigned voffA[2], voffB[2];
#pragma unroll
    for (int i = 0; i < 2; ++i) { int R, C; stage_rc(tid * 16 + i * 8192, R, C); const int Rb = Epi::PERM ? ((R & ~31) + perm32(R & 31)) : R;
        voffA[i] = (unsigned)(R * K + C) * 2u; voffB[i] = (unsigned)(Rb * g.bdil * K + C) * 2u; }
    const size_t kstep = (size_t)(BK * 2);
    const size_t hstep = (size_t)HALF * K * 2;
    const size_t tstep = 2 * hstep;
    const size_t hstepB = (g.bdil == 16) ? (size_t)K * 2 : (size_t)HALF * g.bdil * K * 2;
    const unsigned ldsw = (unsigned)wid * 1024u;
    const int aoff = lds_byte(wr * 64 + fr, fq * 8), boff = lds_byte(wc * 32 + fr, fq * 8);
#define PG8_SA(b, h) (((b) * 2 + (h)) * HTB)
#define PG8_SB(b, h) ((4 + (b) * 2 + (h)) * HTB)
#define PG8_STAGE(bufoff, gbase, voff) do { _Pragma("unroll") for (int _i = 0; _i < 2; ++_i) \
        __builtin_amdgcn_global_load_lds((const unsigned*)((const char*)(gbase) + (voff)[_i]), (PG8_LAS unsigned*)(lds + (bufoff) + ldsw + _i * 8192), 16, 0, 0); } while (0)
#define PG8_LDA(dst, b, h) do { _Pragma("unroll") for (int m = 0; m < 4; ++m) _Pragma("unroll") for (int k = 0; k < 2; ++k) dst[m][k] = *(const PG8_LAS bf16x8*)(lds + PG8_SA(b, h) + aoff + m * 2048 + k * 1024); } while (0)
#define PG8_LDB(dst, b, h) do { _Pragma("unroll") for (int n = 0; n < 2; ++n) _Pragma("unroll") for (int k = 0; k < 2; ++k) dst[n][k] = *(const PG8_LAS bf16x8*)(lds + PG8_SB(b, h) + boff + n * 2048 + k * 1024); } while (0)
#define PG8_MMA(ai, bj, At, Bt) do { __builtin_amdgcn_s_setprio(1); _Pragma("unroll") for (int m = 0; m < 4; ++m) _Pragma("unroll") for (int n = 0; n < 2; ++n) _Pragma("unroll") for (int k = 0; k < 2; ++k) \
        acc[ai][bj][m][n] = __builtin_amdgcn_mfma_f32_16x16x32_bf16(Bt[n][k], At[m][k], acc[ai][bj][m][n], 0, 0, 0); __builtin_amdgcn_s_setprio(0); } while (0)
#define PG8_WAIT_V(n) asm volatile("s_waitcnt vmcnt(" #n ")" ::: "memory")
#define PG8_WAIT_L(n) asm volatile("s_waitcnt lgkmcnt(" #n ")" ::: "memory")
#define PG8_BAR __builtin_amdgcn_s_barrier()
#define PG8_SCHED __builtin_amdgcn_sched_barrier(0)
    Unit cur, nxt; int ui = 0;
    if (!S.next(0, cur)) return;
    f32x4 acc[2][2][4][2];
#pragma unroll
    for (int a = 0; a < 2; ++a)
#pragma unroll
        for (int b = 0; b < 2; ++b)
#pragma unroll
            for (int m = 0; m < 4; ++m)
#pragma unroll
                for (int n = 0; n < 2; ++n) acc[a][b][m][n] = (f32x4){0.f, 0.f, 0.f, 0.f};
    bf16x8 At[4][2], B0[2][2], B1[2][2];
    const char* cA = (const char*)g.A + (size_t)cur.pm * tstep; const char* cB = (const char*)g.Bt + b_tile_off(g, cur.pn);
    S.a_ready(cur);
    if constexpr (SP2) {
        PG8_STAGE(PG8_SB(0, 0), cB, voffB); PG8_STAGE(PG8_SB(0, 1), cB + hstepB, voffB); PG8_STAGE(PG8_SA(0, 0), cA, voffA); PG8_STAGE(PG8_SA(0, 1), cA + hstep, voffA);
        if (wr == 1) PG8_BAR;
        PG8_WAIT_V(2); PG8_BAR;
        PG8_STAGE(PG8_SB(1, 0), cB + kstep, voffB); PG8_STAGE(PG8_SA(1, 0), cA + kstep, voffA); PG8_STAGE(PG8_SB(1, 1), cB + hstepB + kstep, voffB);
        PG8_WAIT_V(6); PG8_BAR;
    } else {
        PG8_STAGE(PG8_SB(0, 0), cB, voffB); PG8_STAGE(PG8_SA(0, 0), cA, voffA); PG8_STAGE(PG8_SB(0, 1), cB + hstepB, voffB); PG8_STAGE(PG8_SA(0, 1), cA + hstep, voffA);
        if (wr == 1) PG8_BAR;
        PG8_WAIT_V(4); PG8_BAR;
        PG8_STAGE(PG8_SB(1, 0), cB + kstep, voffB); PG8_STAGE(PG8_SA(1, 0), cA + kstep, voffA); PG8_STAGE(PG8_SB(1, 1), cB + hstepB + kstep, voffB);
        PG8_WAIT_V(6); PG8_BAR;
    }
    for (;;) {
        const bool has_next = S.next(ui + 1, nxt);
        const char* nA = has_next ? (const char*)g.A + (size_t)nxt.pm * tstep : cA; const char* nB = has_next ? (const char*)g.Bt + b_tile_off(g, nxt.pn) : cB;
        for (int t = 0; t < nt; t += 2) {
            const bool last = (t == nt - 2);
            const char* a1 = cA + (size_t)(t + 1) * kstep;
            const char* a2 = last ? nA : cA + (size_t)(t + 2) * kstep; const char* b2 = last ? nB : cB + (size_t)(t + 2) * kstep;
            const char* a3 = a2 + kstep; const char* b3 = b2 + kstep;
            if (last && has_next) S.a_ready(nxt);
            if constexpr (SP2) {
            PG8_LDB(B0, 0, 0); PG8_LDB(B1, 0, 1); PG8_SCHED; PG8_LDA(At, 0, 0); PG8_STAGE(PG8_SA(1, 1), a1 + hstep, voffA);
            PG8_WAIT_V(8); PG8_WAIT_L(0); PG8_BAR; PG8_MMA(0, 0, At, B0); PG8_MMA(0, 1, At, B1); PG8_BAR; PG8_SCHED;
            PG8_LDA(At, 0, 1); PG8_STAGE(PG8_SB(0, 0), b2, voffB); PG8_STAGE(PG8_SB(0, 1), b2 + hstepB, voffB); PG8_STAGE(PG8_SA(0, 0), a2, voffA);
            PG8_WAIT_V(8); PG8_WAIT_L(0); PG8_BAR; PG8_MMA(1, 0, At, B0); PG8_MMA(1, 1, At, B1); PG8_BAR; PG8_SCHED;
            PG8_LDB(B0, 1, 0); PG8_LDB(B1, 1, 1); PG8_SCHED; PG8_LDA(At, 1, 0); PG8_STAGE(PG8_SA(0, 1), a2 + hstep, voffA);
            PG8_WAIT_V(8); PG8_WAIT_L(0); PG8_BAR; PG8_MMA(0, 0, At, B0); PG8_MMA(0, 1, At, B1); PG8_BAR; PG8_SCHED;
            PG8_LDA(At, 1, 1); PG8_STAGE(PG8_SB(1, 0), b3, voffB); PG8_STAGE(PG8_SB(1, 1), b3 + hstepB, voffB); PG8_STAGE(PG8_SA(1, 0), a3, voffA);
            PG8_WAIT_V(8); PG8_WAIT_L(0); PG8_BAR; PG8_MMA(1, 0, At, B0); PG8_MMA(1, 1, At, B1); PG8_BAR; PG8_SCHED;
            } else {
            PG8_LDB(B0, 0, 0); PG8_SCHED; PG8_LDA(At, 0, 0); PG8_STAGE(PG8_SA(1, 1), a1 + hstep, voffA);
            PG8_WAIT_L(8); PG8_BAR; PG8_WAIT_L(0); PG8_MMA(0, 0, At, B0); PG8_BAR; PG8_SCHED;
            PG8_LDB(B1, 0, 1); PG8_STAGE(PG8_SB(0, 0), b2, voffB);
            PG8_BAR; PG8_WAIT_L(0); PG8_MMA(0, 1, At, B1); PG8_BAR;
            PG8_LDA(At, 0, 1); PG8_STAGE(PG8_SA(0, 0), a2, voffA);
            PG8_BAR; PG8_WAIT_L(0); PG8_MMA(1, 0, At, B0); PG8_BAR; PG8_SCHED;
            PG8_STAGE(PG8_SB(0, 1), b2 + hstepB, voffB);
            PG8_WAIT_V(6); PG8_BAR; PG8_MMA(1, 1, At, B1); PG8_BAR;
            PG8_LDB(B0, 1, 0); PG8_SCHED; PG8_LDA(At, 1, 0); PG8_STAGE(PG8_SA(0, 1), a2 + hstep, voffA);
            PG8_WAIT_L(8); PG8_BAR; PG8_WAIT_L(0); PG8_MMA(0, 0, At, B0); PG8_BAR; PG8_SCHED;
            PG8_LDB(B1, 1, 1); PG8_STAGE(PG8_SB(1, 0), b3, voffB);
            PG8_BAR; PG8_WAIT_L(0); PG8_MMA(0, 1, At, B1); PG8_BAR;
            PG8_LDA(At, 1, 1); PG8_STAGE(PG8_SA(1, 0), a3, voffA);
            PG8_BAR; PG8_WAIT_L(0); PG8_MMA(1, 0, At, B0); PG8_BAR; PG8_SCHED;
            PG8_STAGE(PG8_SB(1, 1), b3 + hstepB, voffB);
            PG8_WAIT_V(6); PG8_BAR; PG8_MMA(1, 1, At, B1); PG8_BAR;
            }
        }
        if constexpr (ALIGN_EPI) { if (wr == 0) PG8_BAR; }
        if constexpr (!Epi::AFTER_DRAIN) { E(acc, cur, wr, wc, fr, fq); S.done(cur); }
        if (!has_next) break;
#pragma unroll
        for (int a = 0; a < 2; ++a)
#pragma unroll
            for (int b = 0; b < 2; ++b)
#pragma unroll
                for (int m = 0; m < 4; ++m)
#pragma unroll
                    for (int n = 0; n < 2; ++n) acc[a][b][m][n] = (f32x4){0.f, 0.f, 0.f, 0.f};
        cur = nxt; cA = nA; cB = nB; ++ui;
        if constexpr (ALIGN_EPI) { if (wr == 1) PG8_BAR; }
    }
    PG8_WAIT_V(0);
    if constexpr (!ALIGN_EPI) { if (wr == 0) PG8_BAR; }
    PG8_BAR;
    if constexpr (Epi::AFTER_DRAIN) { E.fused(acc, cur, wr, wc, fr, fq, lds, wid, lane); S.done(cur); }
#undef PG8_SA
#undef PG8_SB
#undef PG8_STAGE
#undef PG8_LDA
#undef PG8_LDB
#undef PG8_MMA
#undef PG8_WAIT_V
#undef PG8_WAIT_L
#undef PG8_BAR
#undef PG8_SCHED
}
}

constexpr int NWAVES = 8, NTHR = NWAVES * 64;
constexpr int BATCH = 4, SEQ = 2048, DM = 2048, MTOK = BATCH * SEQ;
constexpr int A_IN = 20480, B_IN = 6144, NA1 = 14336;
constexpr float RMS_EPS = 1e-6f, LN_EPS = 1e-5f;
constexpr size_t MiB = 1u << 20;
constexpr size_t SZ_ACT = (size_t)MTOK * DM * 2;
constexpr size_t WS_WAIN = 2 * MiB;
constexpr size_t WS_WAOUT = WS_WAIN + 2 * (size_t)A_IN * DM * 2;
constexpr size_t WS_WBIN = WS_WAOUT + 2 * (size_t)DM * DM * 2;
constexpr size_t WS_WBOUT = WS_WBIN + 2 * (size_t)B_IN * DM * 2;
constexpr size_t WS_WM = WS_WBOUT + 2 * (size_t)DM * DM * 2;
constexpr size_t WS_COS = WS_WM + 2 * 16 * 128 * 128 * 2;
constexpr size_t WS_SIN = WS_COS + (size_t)MTOK * 16 * 4;
constexpr size_t WS_STATS = WS_SIN + (size_t)MTOK * 16 * 4;
constexpr size_t WS_LSE = WS_STATS + 2 * (size_t)MTOK * 2 * 4;
constexpr size_t WS_X = WS_LSE + 3 * (size_t)MTOK * 16 * 4;
constexpr size_t WS_XN = WS_X + 2 * SZ_ACT;
constexpr size_t WS_QK = WS_XN + SZ_ACT;
constexpr size_t WS_VT = WS_QK + 6 * SZ_ACT;
constexpr size_t WS_GATE = WS_VT + 3 * SZ_ACT;
constexpr size_t WS_OG = WS_GATE + SZ_ACT;
constexpr size_t WS_Y = WS_OG + 3 * SZ_ACT;
constexpr size_t WS_END = WS_Y + SZ_ACT;
constexpr int LDS_BYTES = 147456;

typedef unsigned short bf16;
typedef unsigned v4u __attribute__((ext_vector_type(4)));
typedef unsigned v2u __attribute__((ext_vector_type(2)));
typedef float f32x4 __attribute__((ext_vector_type(4)));
typedef float f32x2v __attribute__((ext_vector_type(2)));
typedef float f32x16 __attribute__((ext_vector_type(16)));
typedef short bf16x8 __attribute__((ext_vector_type(8)));
typedef __bf16 bf16x2_t __attribute__((ext_vector_type(2)));
#define LAS __attribute__((address_space(3)))
#define MFMA32(a, b, c) __builtin_amdgcn_mfma_f32_32x32x16_bf16((a), (b), (c), 0, 0, 0)
__device__ __forceinline__ unsigned pk2(float lo, float hi) { f32x2v v = {lo, hi}; bf16x2_t b = __builtin_convertvector(v, bf16x2_t); return __builtin_bit_cast(unsigned, b); }
__device__ __forceinline__ float bflo(unsigned w) { return __builtin_bit_cast(float, w << 16); }
__device__ __forceinline__ float bfhi(unsigned w) { return __builtin_bit_cast(float, w & 0xffff0000u); }
__device__ __forceinline__ float wave_sum(float v) {
#pragma unroll
    for (int o = 1; o < 64; o <<= 1) v += __shfl_xor(v, o);
    return v;
}

__device__ __forceinline__ int launder(int v) { asm volatile("" : "+v"(v)); return v; }
struct Args {
    const float* x; const int* pos; const float* a_norm_g; const float* a_w_in; const float* a_w_out; const float* b_norm_g; const float* b_w_in;
    const float* b_ln_g; const float* b_ln_b; const float* b_w_s; const float* b_b_s; const float* b_w_out; const float* final_g;
    float* out; unsigned char* ws; double invf[16];
    int ph_lo, ph_hi;
};

__device__ __forceinline__ void p0_transpose_item(const float* W, int K, int N, bf16* WT, int row_off, LAS float* scr, int kb, int nb, int lane) {
    const int k0 = 64 * kb, n0 = 32 * nb;
#pragma unroll 8
    for (int i = 0; i < 32; ++i) { const int kk = 2 * i + (lane >> 5); scr[kk * 33 + (lane & 31)] = W[(size_t)(k0 + kk) * N + n0 + (lane & 31)]; }
    asm volatile("s_waitcnt lgkmcnt(0)" ::: "memory");
    const int c = lane & 7;
#pragma unroll
    for (int j = 0; j < 4; ++j) { const int n = (lane >> 3) + 8 * j; const LAS float* s = scr + (8 * c) * 33 + n;
        v4u o; o.x = pk2(s[0 * 33], s[1 * 33]); o.y = pk2(s[2 * 33], s[3 * 33]); o.z = pk2(s[4 * 33], s[5 * 33]); o.w = pk2(s[6 * 33], s[7 * 33]);
        *(v4u*)(WT + (size_t)(row_off + n0 + n) * K + k0 + 8 * c) = o; }
    asm volatile("s_waitcnt lgkmcnt(0)" ::: "memory");
}
template <bool F32OUT> __device__ __forceinline__ void rms_row(const float* xrow, const float* g, void* orow, int lane) {
    const f32x4* xr = (const f32x4*)xrow + lane; const f32x4* gr = (const f32x4*)g + lane;
    f32x4 v[8]; float s = 0.f;
#pragma unroll
    for (int j = 0; j < 8; ++j) { v[j] = xr[64 * j]; s += (v[j].x * v[j].x + v[j].y * v[j].y) + (v[j].z * v[j].z + v[j].w * v[j].w); }
    const float rstd = 1.0f / sqrtf(wave_sum(s) * (1.0f / DM) + RMS_EPS);
#pragma unroll
    for (int j = 0; j < 8; ++j) { const f32x4 gg = gr[64 * j]; const f32x4 y = v[j] * rstd * gg;
        if (F32OUT) ((f32x4*)orow + lane)[64 * j] = y;
        else { v2u w; w.x = pk2(y.x, y.y); w.y = pk2(y.z, y.w); ((v2u*)orow + lane)[64 * j] = w; } }
}

__device__ __forceinline__ void attn_phase(const bf16* QK, const bf16* VT, bf16* OG, float* LSE, int gw, int NGW, int lane) {
    const int q = lane & 31, hh = lane >> 5;
    const int kperm = (q & 0x13) | ((q & 4) << 1) | ((q & 8) >> 1);
    for (int wu = gw; wu < 3 * 4096; wu += NGW) {
        const int g = wu >> 12, rest = wu & 4095, qw = rest & 3, blk = (rest >> 2) & 15, h = (rest >> 6) & 15, b = rest >> 10;
        const int dsh = 2 * g; const bool has_prev = (blk & ((16 >> dsh) - 1)) != 0;
        const bf16* Qp = QK + ((size_t)((g * 2 + 0) * 4 + b) * 16 + h) * (2048 * 128) + (size_t)(blk * 128 + qw * 32 + q) * 128 + 8 * hh;
        const bf16* Kb = QK + ((size_t)((g * 2 + 1) * 4 + b) * 16 + h) * (2048 * 128) + 8 * hh;
        const bf16* Vb = VT + (size_t)g * 2048 * 8192 + (size_t)(h * 128 + q) * 8192 + b * 2048 + 8 * hh;
        bf16x8 qf[8];
#pragma unroll
        for (int c = 0; c < 8; ++c) qf[c] = *(const bf16x8*)(Qp + 16 * c);
        f32x16 O[4];
#pragma unroll
        for (int db = 0; db < 4; ++db)
#pragma unroll
            for (int i = 0; i < 16; ++i) O[db][i] = 0.f;
        float m = -INFINITY, l = 0.f;
        const int t0 = has_prev ? 0 : 4 - qw;
        for (int t = t0; t < 5; ++t) {
            const int p0 = blk * 128 - 128 + qw * 32 + 32 * t;
            const bf16* Kp = Kb + (size_t)(p0 + kperm) * 128;
            bf16x8 kf[8];
#pragma unroll
            for (int c = 0; c < 8; ++c) kf[c] = *(const bf16x8*)(Kp + 16 * c);
            bf16x8 vf[4][2];
#pragma unroll
            for (int db = 0; db < 4; ++db) { vf[db][0] = *(const bf16x8*)(Vb + (size_t)db * 32 * 8192 + p0); vf[db][1] = *(const bf16x8*)(Vb + (size_t)db * 32 * 8192 + p0 + 16); }
            f32x16 S;
#pragma unroll
            for (int i = 0; i < 16; ++i) S[i] = 0.f;
#pragma unroll
            for (int c = 0; c < 8; ++c) S = MFMA32(kf[c], qf[c], S);
            if (t == 0) {
#pragma unroll
                for (int i = 0; i < 16; ++i) { const int kt = 16 * (i >> 3) + 8 * hh + (i & 7); if (kt < q) S[i] = -INFINITY; }
            }
            if (t == 4) {
#pragma unroll
                for (int i = 0; i < 16; ++i) { const int kt = 16 * (i >> 3) + 8 * hh + (i & 7); if (kt > q) S[i] = -INFINITY; }
            }
            float mx = S[0];
#pragma unroll
            for (int i = 1; i < 16; ++i) mx = fmaxf(mx, S[i]);
            mx = fmaxf(mx, __shfl_xor(mx, 32));
            const float mn = fmaxf(m, mx), alpha = __builtin_amdgcn_exp2f(m - mn);
            float rs = 0.f;
#pragma unroll
            for (int i = 0; i < 16; ++i) { S[i] = __builtin_amdgcn_exp2f(S[i] - mn); rs += S[i]; }
            l = l * alpha + rs; m = mn;
#pragma unroll
            for (int db = 0; db < 4; ++db)
#pragma unroll
                for (int i = 0; i < 16; ++i) O[db][i] *= alpha;
            v4u w0, w1;
            w0.x = pk2(S[0], S[1]); w0.y = pk2(S[2], S[3]); w0.z = pk2(S[4], S[5]); w0.w = pk2(S[6], S[7]);
            w1.x = pk2(S[8], S[9]); w1.y = pk2(S[10], S[11]); w1.z = pk2(S[12], S[13]); w1.w = pk2(S[14], S[15]);
            const bf16x8 ps0 = __builtin_bit_cast(bf16x8, w0), ps1 = __builtin_bit_cast(bf16x8, w1);
#pragma unroll
            for (int db = 0; db < 4; ++db) { O[db] = MFMA32(vf[db][0], ps0, O[db]); O[db] = MFMA32(vf[db][1], ps1, O[db]); }
        }
        l += __shfl_xor(l, 32);
        const float inv = 1.0f / l, lse2 = m + __builtin_amdgcn_logf(l);
        const int p = blk * 128 + qw * 32 + q, Lm1 = (2048 >> dsh) - 1, s = ((p & Lm1) << dsh) | (p >> (11 - dsh));
        const size_t tok = (size_t)b * 2048 + s;
        bf16* op = OG + ((size_t)g * MTOK + tok) * 2048 + h * 128 + 4 * hh;
#pragma unroll
        for (int db = 0; db < 4; ++db)
#pragma unroll
            for (int i4 = 0; i4 < 4; ++i4) { v2u w; w.x = pk2(O[db][4 * i4] * inv, O[db][4 * i4 + 1] * inv); w.y = pk2(O[db][4 * i4 + 2] * inv, O[db][4 * i4 + 3] * inv);
                *(v2u*)(op + db * 32 + 8 * i4) = w; }
        if (hh == 0) LSE[((size_t)g * MTOK + tok) * 16 + h] = lse2;
    }
}
__device__ __forceinline__ void merge_phase(const bf16* OG, const float* LSE, const bf16* GATE, bf16* Y, int gw, int NGW, int lane) {
    for (int row = gw; row < MTOK; row += NGW) {
#pragma unroll
        for (int j = 0; j < 4; ++j) { const int col = lane * 8 + 512 * j, h = col >> 7;
            const float l0 = LSE[((size_t)0 * MTOK + row) * 16 + h], l1 = LSE[((size_t)1 * MTOK + row) * 16 + h], l2 = LSE[((size_t)2 * MTOK + row) * 16 + h];
            const float mx = fmaxf(l0, fmaxf(l1, l2));
            float w0 = __builtin_amdgcn_exp2f(l0 - mx), w1 = __builtin_amdgcn_exp2f(l1 - mx), w2 = __builtin_amdgcn_exp2f(l2 - mx);
            const float inv = 1.0f / (w0 + w1 + w2); w0 *= inv; w1 *= inv; w2 *= inv;
            const size_t off = (size_t)row * 2048 + col;
            const v4u a = *(const v4u*)(OG + off), bb = *(const v4u*)(OG + (size_t)MTOK * 2048 + off), c = *(const v4u*)(OG + 2 * (size_t)MTOK * 2048 + off), gt = *(const v4u*)(GATE + off);
            v4u o;
#pragma unroll
            for (int k = 0; k < 4; ++k) {
                const float ylo = (w0 * bflo(a[k]) + w1 * bflo(bb[k]) + w2 * bflo(c[k])) * bflo(gt[k]);
                const float yhi = (w0 * bfhi(a[k]) + w1 * bfhi(bb[k]) + w2 * bfhi(c[k])) * bfhi(gt[k]);
                o[k] = pk2(ylo, yhi); }
            *(v4u*)(Y + off) = o; }
    }
}
__device__ __forceinline__ void sgu_phase(const bf16* VTB, const float* STATS, const float* LNG, const float* LNB, const bf16* WM, const float* BS, const bf16* U, const bf16* ZS, bf16* Y,
                                          int gw, int NGW, int lane) {
    const int r = lane & 31, hh = lane >> 5;
    for (int wu = gw; wu < 4096; wu += NGW) {
        const int cblk = wu & 3, g = (wu >> 2) & 15, chunk = (wu >> 6) & 15, b = wu >> 10;
        const int ch = g * 128 + cblk * 32 + r, tok0 = b * 2048 + chunk * 128;
        const float lng = LNG[ch], lnb = LNB[ch];
        bf16x8 af[8];
#pragma unroll
        for (int ks = 0; ks < 8; ++ks) { const int s0 = 16 * ks + 8 * hh;
            const v4u raw = *(const v4u*)(VTB + (size_t)ch * 8192 + tok0 + s0);
            const f32x4* st = (const f32x4*)(STATS + 2 * (size_t)(tok0 + s0));
            v4u o;
#pragma unroll
            for (int k = 0; k < 4; ++k) { const f32x4 sv = st[k];
                const float mu0 = sv.x * (1.0f / 2048), mu1 = sv.z * (1.0f / 2048);
                const float a0 = lng / sqrtf(fmaxf(sv.y * (1.0f / 2048) - mu0 * mu0, 0.f) + LN_EPS), a1 = lng / sqrtf(fmaxf(sv.w * (1.0f / 2048) - mu1 * mu1, 0.f) + LN_EPS);
                o[k] = pk2(bflo(raw[k]) * a0 + (lnb - mu0 * a0), bfhi(raw[k]) * a1 + (lnb - mu1 * a1)); }
            af[ks] = __builtin_bit_cast(bf16x8, o); }
#pragma unroll
        for (int tb = 0; tb < 4; ++tb) {
            f32x16 D;
#pragma unroll
            for (int i = 0; i < 16; ++i) D[i] = 0.f;
            const bf16* wp = WM + (size_t)(g * 128 + tb * 32 + r) * 128 + 8 * hh;
#pragma unroll
            for (int ks = 0; ks < 2 * tb + 2; ++ks) { const bf16x8 bfr = *(const bf16x8*)(wp + 16 * ks); D = MFMA32(af[ks], bfr, D); }
            const int t = tb * 32 + r; const float bs = BS[g * 128 + t];
            const size_t rowoff = (size_t)(tok0 + t) * 2048 + g * 128 + cblk * 32 + 4 * hh;
#pragma unroll
            for (int i4 = 0; i4 < 4; ++i4) { const v2u uu = *(const v2u*)(U + rowoff + 8 * i4), zz = *(const v2u*)(ZS + rowoff + 8 * i4);
                v2u w; w.x = pk2(bflo(uu.x) * (D[4 * i4] + bs) * bflo(zz.x), bfhi(uu.x) * (D[4 * i4 + 1] + bs) * bfhi(zz.x));
                w.y = pk2(bflo(uu.y) * (D[4 * i4 + 2] + bs) * bflo(zz.y), bfhi(uu.y) * (D[4 * i4 + 3] + bs) * bfhi(zz.y));
                *(v2u*)(Y + rowoff + 8 * i4) = w; }
        }
    }
}

constexpr int N_PHASES = 19;
__global__ void __launch_bounds__(NTHR) trunk_fwd(Args args) {
    extern __shared__ __attribute__((aligned(16))) unsigned char lds[];
    const int tid = threadIdx.x, lane = tid & 63, wave = __builtin_amdgcn_readfirstlane(tid >> 6);
    const int G = gridDim.x, bx = blockIdx.x;
    const int gw = bx * NWAVES + wave, NGW = G * NWAVES;
    unsigned char* ws = args.ws;
    bf16* WAin = (bf16*)(ws + WS_WAIN); bf16* WAout = (bf16*)(ws + WS_WAOUT); bf16* WBin = (bf16*)(ws + WS_WBIN); bf16* WBout = (bf16*)(ws + WS_WBOUT); bf16* WM = (bf16*)(ws + WS_WM);
    float* COS = (float*)(ws + WS_COS); float* SIN = (float*)(ws + WS_SIN); float* STATS = (float*)(ws + WS_STATS); float* LSE = (float*)(ws + WS_LSE);
    float* X = (float*)(ws + WS_X); bf16* XN = (bf16*)(ws + WS_XN); bf16* QK = (bf16*)(ws + WS_QK); bf16* VT = (bf16*)(ws + WS_VT); bf16* GATE = (bf16*)(ws + WS_GATE);
    bf16* OG = (bf16*)(ws + WS_OG); bf16* Y = (bf16*)(ws + WS_Y);
    bf16* U = OG; bf16* ZS = OG + (size_t)MTOK * 2048;
    const int lo = args.ph_lo, hi = args.ph_hi;
#define IN(k) (lo <= (k) && (k) < hi)
#if MK_PER_PHASE
#define SEAM(k) do { } while (0)
#else
#define SEAM(k) do { if (IN(k) && IN((k) + 1)) cg::this_grid().sync(); } while (0)
#endif
    if (IN(0)) {
        LAS float* scr = (LAS float*)((LAS unsigned char*)lds + wave * 16384);
        constexpr int I_AIN = 32 * (A_IN / 32), I_SQ = 32 * (DM / 32), I_BIN = 32 * (B_IN / 32);
        constexpr int NITEMS = 2 * (I_AIN + I_SQ + I_BIN + I_SQ);
        for (int it = gw; it < NITEMS; it += NGW) {
            int r = it; const int j = r / (NITEMS / 2); r -= j * (NITEMS / 2);
            if (r < I_AIN) { const int nblk = A_IN / 32, kb = r / nblk, nb = r % nblk, sb = (nb * 32) / 2048;
                const int db = sb == 9 ? 6 : ((sb % 3) == 2 ? 7 + sb / 3 : 2 * (sb / 3) + (sb % 3));
                p0_transpose_item(args.a_w_in + (size_t)j * DM * A_IN, DM, A_IN, WAin + (size_t)j * A_IN * DM, (db - sb) * 2048, scr, kb, nb, lane); continue; } r -= I_AIN;
            if (r < I_SQ) { p0_transpose_item(args.a_w_out + (size_t)j * DM * DM, DM, DM, WAout + (size_t)j * DM * DM, 0, scr, r / (DM / 32), r % (DM / 32), lane); continue; } r -= I_SQ;
            if (r < I_BIN) { const int nblk = B_IN / 32, kb = r / nblk, nb = r % nblk, sb = (nb * 32) / 2048;
                const int db = sb == 0 ? 0 : (sb == 1 ? 2 : 1);
                p0_transpose_item(args.b_w_in + (size_t)j * DM * B_IN, DM, B_IN, WBin + (size_t)j * B_IN * DM, (db - sb) * 2048, scr, kb, nb, lane); continue; } r -= I_BIN;
            p0_transpose_item(args.b_w_out + (size_t)j * DM * DM, DM, DM, WBout + (size_t)j * DM * DM, 0, scr, r / (DM / 32), r % (DM / 32), lane);
        }
        const int gt = bx * NTHR + tid, NGT = G * NTHR;
        for (int i = gt; i < 2 * 16 * 128 * 128 / 2; i += NGT) { const int e = 2 * i, s = e & 127, t = (e >> 7) & 127;
            const f32x2v w = *(const f32x2v*)(args.b_w_s + e); ((unsigned*)WM)[i] = pk2(s <= t ? w.x : 0.f, s + 1 <= t ? w.y : 0.f); }
        for (int i = gt; i < MTOK * 16; i += NGT) { const int tok = i >> 4, f = i & 15; const double rev = (double)args.pos[tok] * args.invf[f]; const float fr = (float)(rev - floor(rev));
            COS[i] = __builtin_amdgcn_cosf(fr); SIN[i] = __builtin_amdgcn_sinf(fr); }
        for (int i = gt; i < 2 * MTOK * 2; i += NGT) STATS[i] = 0.f;
        for (int m = gw; m < MTOK; m += NGW) rms_row<false>(args.x + (size_t)m * DM, args.a_norm_g, XN + (size_t)m * DM, lane);
    }
    SEAM(0);
    for (int rep = 0; rep < 2; ++rep) {
        const int P = 1 + 9 * rep;
        if (IN(P)) {
            const bf16* W = WAin + (size_t)rep * A_IN * DM;
            { pg8::Gemm g{XN, W, MTOK, NA1, DM, 1}; pg8::StaticOrder S; S.init(MTOK, NA1, G, bx); pg8::EpiA1 E{QK, GATE, COS, SIN};
              pg8::gemm_phase<pg8::EpiA1, pg8::StaticOrder, true, true>((LAS unsigned char*)lds, g, S, E); }
            for (int grp = 0; grp < 3; ++grp) {
                pg8::Gemm g{W + (size_t)(NA1 + grp * 2048) * DM, XN, 2048, MTOK, DM, 1 << (2 * grp)}; pg8::StaticOrder S; S.init(2048, MTOK, G, bx);
                pg8::EpiPlain E{VT + (size_t)grp * 2048 * 8192, 8192};
                pg8::gemm_phase<pg8::EpiPlain, pg8::StaticOrder, true, true>((LAS unsigned char*)lds, g, S, E); }
        }
        SEAM(P);
        if (IN(P + 1)) attn_phase(QK, VT, OG, LSE, gw, NGW, launder(lane));
        SEAM(P + 1);
        if (IN(P + 2)) merge_phase(OG, LSE, GATE, Y, gw, NGW, launder(lane));
        SEAM(P + 2);
        if (IN(P + 3)) { pg8::Gemm g{Y, WAout + (size_t)rep * DM * DM, MTOK, DM, DM, 1}; pg8::StaticOrder S; S.init(MTOK, DM, G, bx); pg8::EpiOut E{rep == 0 ? args.x : X, X};
            pg8::gemm_phase<pg8::EpiOut, pg8::StaticOrder, true, true>((LAS unsigned char*)lds, g, S, E); }
        SEAM(P + 3);
        if (IN(P + 4)) { const int ln = launder(lane); const float* gn = args.b_norm_g + (size_t)rep * DM; for (int m = gw; m < MTOK; m += NGW) rms_row<false>(X + (size_t)m * DM, gn, XN + (size_t)m * DM, ln); }
        SEAM(P + 4);
        if (IN(P + 5)) {
            const bf16* W = WBin + (size_t)rep * B_IN * DM;
            { pg8::Gemm g{XN, W, MTOK, 4096, DM, 1}; pg8::StaticOrder S; S.init(MTOK, 4096, G, bx); pg8::EpiB1 E{U, ZS};
              pg8::gemm_phase<pg8::EpiB1, pg8::StaticOrder, true, true>((LAS unsigned char*)lds, g, S, E); }
            { pg8::Gemm g{W + (size_t)4096 * DM, XN, 2048, MTOK, DM, 1}; pg8::StaticOrder S; S.init(2048, MTOK, G, bx); pg8::EpiB2 E{VT, STATS + (size_t)rep * MTOK * 2};
              pg8::gemm_phase<pg8::EpiB2, pg8::StaticOrder, true, true>((LAS unsigned char*)lds, g, S, E); }
        }
        SEAM(P + 5);
        if (IN(P + 6)) sgu_phase(VT, STATS + (size_t)rep * MTOK * 2, args.b_ln_g + (size_t)rep * DM, args.b_ln_b + (size_t)rep * DM, WM + (size_t)rep * 16 * 128 * 128, args.b_b_s + (size_t)rep * 16 * 128, U, ZS, Y, gw, NGW, launder(lane));
        SEAM(P + 6);
        if (IN(P + 7)) { pg8::Gemm g{Y, WBout + (size_t)rep * DM * DM, MTOK, DM, DM, 1}; pg8::StaticOrder S; S.init(MTOK, DM, G, bx); pg8::EpiOut E{X, X};
            pg8::gemm_phase<pg8::EpiOut, pg8::StaticOrder, true, true>((LAS unsigned char*)lds, g, S, E); }
        SEAM(P + 7);
        if (IN(P + 8)) { const int ln = launder(lane);
            if (rep == 0) { const float* gn = args.a_norm_g + DM; for (int m = gw; m < MTOK; m += NGW) rms_row<false>(X + (size_t)m * DM, gn, XN + (size_t)m * DM, ln); }
            else { for (int m = gw; m < MTOK; m += NGW) rms_row<true>(X + (size_t)m * DM, args.final_g, args.out + (size_t)m * DM, ln); }
        }
        if (rep == 0) SEAM(P + 8);
    }
#undef IN
#undef SEAM
}

extern "C" void kernel_launch(void* const* d_in, const int* in_sizes, int n_in, void* d_out, int out_size, void* d_ws, size_t ws_size, hipStream_t stream) {
    static int grid = 0;
    if (grid == 0) {
        if (n_in != 13 || in_sizes[0] != MTOK * DM || out_size != MTOK * DM || ws_size < WS_END) { fprintf(stderr, "kernel_launch: unexpected shapes / workspace (n_in %d, in0 %d, out %d, ws %zu, need %zu)\n", n_in, n_in > 0 ? in_sizes[0] : -1, out_size, ws_size, (size_t)WS_END); grid = -1; return; }
        int dev = 0, cus = 0, per_cu = 0;
        if (hipGetDevice(&dev) != hipSuccess || hipDeviceGetAttribute(&cus, hipDeviceAttributeMultiprocessorCount, dev) != hipSuccess) { grid = -1; return; }
        if (hipFuncSetAttribute((const void*)trunk_fwd, hipFuncAttributeMaxDynamicSharedMemorySize, LDS_BYTES) != hipSuccess) { fprintf(stderr, "kernel_launch: hipFuncSetAttribute failed\n"); grid = -1; return; }
        if (hipOccupancyMaxActiveBlocksPerMultiprocessor(&per_cu, (const void*)trunk_fwd, NTHR, LDS_BYTES) != hipSuccess || per_cu < 1) { fprintf(stderr, "kernel_launch: occupancy query failed (%d)\n", per_cu); (void)hipGetLastError(); grid = -1; return; }
        grid = cus * per_cu;
    }
    if (grid < 0) return;
    Args a{};
    a.x = (const float*)d_in[0]; a.pos = (const int*)d_in[1]; a.a_norm_g = (const float*)d_in[2]; a.a_w_in = (const float*)d_in[3]; a.a_w_out = (const float*)d_in[4];
    a.b_norm_g = (const float*)d_in[5]; a.b_w_in = (const float*)d_in[6]; a.b_ln_g = (const float*)d_in[7]; a.b_ln_b = (const float*)d_in[8]; a.b_w_s = (const float*)d_in[9];
    a.b_b_s = (const float*)d_in[10]; a.b_w_out = (const float*)d_in[11]; a.final_g = (const float*)d_in[12];
    a.out = (float*)d_out; a.ws = (unsigned char*)d_ws;
    for (int i = 0; i < 16; ++i) a.invf[i] = pow(500000.0, -(double)i / 16.0) / 6.283185307179586476925;
#if MK_PER_PHASE
    for (int p = 0; p < N_PHASES; ++p) { a.ph_lo = p; a.ph_hi = p + 1; hipLaunchKernelGGL(trunk_fwd, dim3(grid), dim3(NTHR), LDS_BYTES, stream, a); }
#else
    a.ph_lo = 0; a.ph_hi = N_PHASES;
    void* kargs[] = {&a};
    const hipError_t e = hipLaunchCooperativeKernel((const void*)trunk_fwd, dim3(grid), dim3(NTHR), kargs, LDS_BYTES, stream);
    if (e != hipSuccess) fprintf(stderr, "kernel_launch: cooperative launch failed: %s (grid %d)\n", hipGetErrorString(e), grid);
#endif
}
```

```cpp
#include <hip/hip_runtime.h>
#include <hip/hip_cooperative_groups.h>
#include <cstdio>
#include <cstdint>
#include <cmath>
namespace cg = cooperative_groups;
#ifndef MK_PER_PHASE
#define MK_PER_PHASE 0
#endif
namespace pg8 {
#define PG8_LAS __attribute__((address_space(3)))
typedef unsigned short bf16_t;
typedef short bf16x8 __attribute__((ext_vector_type(8)));
typedef float f32x4 __attribute__((ext_vector_type(4)));
typedef unsigned u32x4 __attribute__((ext_vector_type(4)));
constexpr int BM = 256, BK = 64, HALF = 128, HTB = HALF * BK * 2  , STAGE_BYTES = 8 * HTB, NXCD = 8, WGM = 8;

__host__ __device__ __forceinline__ int lds_byte(int r, int c) { const int st = (r >> 4) * 2 + (c >> 5), rr = r & 15, cc = c & 31, ob = rr * 64 + cc * 2; return st * 1024 + (ob ^ (((ob >> 9) & 1) << 5)); }
__host__ __device__ __forceinline__ void stage_rc(int b, int& R, int& C) { const int st = b / 1024, sb = b % 1024, swz = sb ^ (((sb >> 9) & 1) << 5); R = (st >> 1) * 16 + swz / 64; C = (st & 1) * 32 + (swz % 64) / 2; }
__host__ __device__ __forceinline__ int perm32(int rho) { const int n = rho >> 4, i = rho & 15; return 8 * (i >> 2) + 4 * n + (i & 3); }

struct Unit { int pm, pn; };
struct Gemm { const bf16_t* A; const bf16_t* Bt; int M, N, K; int bdil; };
__device__ __forceinline__ size_t b_tile_off(const Gemm& g, int pn) { const int t8 = pn & 7; const int r = (pn >> 3) * 2048 + (g.bdil == 1 ? 256 * t8 : (g.bdil == 4 ? 1024 * (t8 & 1) + (t8 >> 1) : 2 * t8)); return (size_t)r * g.K * 2; }

struct StaticOrder {
    int nM, nN, nwg, G, c;
    __host__ __device__ void init(int M, int N, int G_, int c_) { nM = M / BM; nN = N / BM; nwg = nM * nN; G = G_; c = c_; }
    __host__ __device__ bool next(int i, Unit& u) const {
        const long L = (long)i * G + c; if (L >= nwg) return false;
        int wgid = (int)L; { const int q = nwg / NXCD, r = nwg % NXCD, xcd = wgid % NXCD, off = wgid / NXCD; wgid = (xcd < r ? xcd * (q + 1) : r * (q + 1) + (xcd - r) * q) + off; }
        const int nig = WGM * nN, gid = wgid / nig, fm = gid * WGM, gsz = (nM - fm) < WGM ? (nM - fm) : WGM;
        u.pm = fm + ((wgid % nig) % gsz); u.pn = (wgid % nig) / gsz; return true;
    }
    __device__ __forceinline__ void a_ready(const Unit&) const {}
    __device__ __forceinline__ void done(const Unit&) const {}
};

__device__ __forceinline__ unsigned cvt_pk_bf16(float lo, float hi) { unsigned r; asm volatile("v_cvt_pk_bf16_f32 %0, %1, %2" : "=v"(r) : "v"(lo), "v"(hi)); return r; }
typedef float f32x2 __attribute__((ext_vector_type(2)));
__device__ __forceinline__ f32x2 gelu_pk(f32x2 v) {
    const f32x2 av = __builtin_elementwise_abs(v), d = av * 0.2316418882f + 1.0f;
    f32x2 t; t.x = __builtin_amdgcn_rcpf(d.x); t.y = __builtin_amdgcn_rcpf(d.y);
    f32x2 q = t * 0.5307027145f + (-0.7265760135f); q = q * t + 0.7107068705f; q = q * t + (-0.142248368f); q = q * t + 0.127414796f; q = q * t;
    const f32x2 s = (v * v) * (-0.72134752044f);
    f32x2 e; e.x = __builtin_amdgcn_exp2f(s.x); e.y = __builtin_amdgcn_exp2f(s.y);
    const f32x2 m = v * (q * e), r = v - m;
    f32x2 o; o.x = v.x < 0.f ? m.x : r.x; o.y = v.y < 0.f ? m.y : r.y; return o;
}

constexpr float C2 = 0.08838834764831845f * 1.4426950408889634f;
__device__ __forceinline__ float silu_f(float x) { return x * __builtin_amdgcn_rcpf(1.0f + __builtin_amdgcn_exp2f(-1.4426950408889634f * x)); }
__device__ __forceinline__ u32x4 pack8(const f32x4& v0, const f32x4& v1) { u32x4 w; w.x = cvt_pk_bf16(v0[0], v0[1]); w.y = cvt_pk_bf16(v0[2], v0[3]); w.z = cvt_pk_bf16(v1[0], v1[1]); w.w = cvt_pk_bf16(v1[2], v1[3]); return w; }
__device__ __forceinline__ void gelu8(f32x4& v0, f32x4& v1) { f32x2 a = gelu_pk((f32x2){v0[0], v0[1]}), b = gelu_pk((f32x2){v0[2], v0[3]}), c = gelu_pk((f32x2){v1[0], v1[1]}), d = gelu_pk((f32x2){v1[2], v1[3]});
    v0 = (f32x4){a.x, a.y, b.x, b.y}; v1 = (f32x4){c.x, c.y, d.x, d.y}; }

struct EpiA1 {
    static constexpr bool PERM = true, AFTER_DRAIN = false;
    bf16_t* QK; bf16_t* GATE; const float* COS; const float* SIN;
    __device__ __forceinline__ void operator()(const f32x4 (&acc)[2][2][4][2], const Unit& u, int wr, int wc, int fr, int fq) const {
        const int pn = u.pn; const int rowb = u.pm * BM + wr * 64 + fr;
        if (pn >= 48) {
            const int col0 = (pn - 48) * 256 + wc * 32 + 8 * fq;
#pragma unroll
            for (int ai = 0; ai < 2; ++ai)
#pragma unroll
                for (int m = 0; m < 4; ++m) { bf16_t* rowp = GATE + (size_t)(rowb + ai * HALF + m * 16) * 2048 + col0;
#pragma unroll
                    for (int bj = 0; bj < 2; ++bj) { f32x4 v0 = acc[ai][bj][m][0], v1 = acc[ai][bj][m][1];
#pragma unroll
                        for (int i = 0; i < 4; ++i) { v0[i] = silu_f(v0[i]); v1[i] = silu_f(v1[i]); }
                        *(u32x4*)(rowp + bj * HALF) = pack8(v0, v1); } }
        } else {
            const int g = pn >> 4, qk = (pn >> 3) & 1, hp = pn & 7, dsh = 2 * g, dm1 = (1 << dsh) - 1;
            const float sc = qk == 0 ? C2 : 1.0f; const float sgn = fq < 2 ? -1.0f : 1.0f; const int e0 = wc * 32 + 8 * fq;
#pragma unroll
            for (int ai = 0; ai < 2; ++ai)
#pragma unroll
                for (int m = 0; m < 4; ++m) { const int row = rowb + ai * HALF + m * 16, b = row >> 11, s = row & 2047, p = ((s & dm1) << (11 - dsh)) | (s >> dsh);
                    f32x4 c0, c1, s0, s1;
                    if (wc == 0) { const float* cp = COS + (size_t)row * 16 + 8 * (fq & 1); const float* sp = SIN + (size_t)row * 16 + 8 * (fq & 1);
                        c0 = *(const f32x4*)cp; c1 = *(const f32x4*)(cp + 4); s0 = *(const f32x4*)sp; s1 = *(const f32x4*)(sp + 4); }
#pragma unroll
                    for (int bj = 0; bj < 2; ++bj) { f32x4 v0 = acc[ai][bj][m][0], v1 = acc[ai][bj][m][1];
                        if (wc == 0) {
#pragma unroll
                            for (int i = 0; i < 4; ++i) { const float p0 = __shfl_xor(v0[i], 32), p1 = __shfl_xor(v1[i], 32);
                                v0[i] = v0[i] * c0[i] + sgn * p0 * s0[i]; v1[i] = v1[i] * c1[i] + sgn * p1 * s1[i]; } }
                        v0 = v0 * sc; v1 = v1 * sc;
                        bf16_t* dst = QK + ((((size_t)((g * 2 + qk) * 4 + b) * 16 + (2 * hp + bj)) * 2048 + p) * 128 + e0);
                        *(u32x4*)dst = pack8(v0, v1); } }
        }
    }
};
struct EpiB1 {
    static constexpr bool PERM = true, AFTER_DRAIN = false;
    bf16_t* U; bf16_t* ZS;
    __device__ __forceinline__ void operator()(const f32x4 (&acc)[2][2][4][2], const Unit& u, int wr, int wc, int fr, int fq) const {
        const int pn = u.pn; const int rowb = u.pm * BM + wr * 64 + fr; const bool isz = pn >= 8;
        bf16_t* base = isz ? ZS : U; const int col0 = (pn & 7) * 256 + wc * 32 + 8 * fq;
#pragma unroll
        for (int ai = 0; ai < 2; ++ai)
#pragma unroll
            for (int m = 0; m < 4; ++m) { bf16_t* rowp = base + (size_t)(rowb + ai * HALF + m * 16) * 2048 + col0;
#pragma unroll
                for (int bj = 0; bj < 2; ++bj) { f32x4 v0 = acc[ai][bj][m][0], v1 = acc[ai][bj][m][1];
                    if (isz) {
#pragma unroll
                        for (int i = 0; i < 4; ++i) { v0[i] = silu_f(v0[i]); v1[i] = silu_f(v1[i]); }
                    } else gelu8(v0, v1);
                    *(u32x4*)(rowp + bj * HALF) = pack8(v0, v1); } }
    }
};
struct EpiPlain {
    static constexpr bool PERM = true, AFTER_DRAIN = false;
    bf16_t* O; int ldc;
    __device__ __forceinline__ void operator()(const f32x4 (&acc)[2][2][4][2], const Unit& u, int wr, int wc, int fr, int fq) const {
        const int rowb = u.pm * BM + wr * 64 + fr; const int col0 = u.pn * BM + wc * 32 + 8 * fq;
#pragma unroll
        for (int ai = 0; ai < 2; ++ai)
#pragma unroll
            for (int m = 0; m < 4; ++m) { bf16_t* rowp = O + (size_t)(rowb + ai * HALF + m * 16) * ldc + col0;
#pragma unroll
                for (int bj = 0; bj < 2; ++bj) *(u32x4*)(rowp + bj * HALF) = pack8(acc[ai][bj][m][0], acc[ai][bj][m][1]); }
    }
};
struct EpiB2 {
    static constexpr bool PERM = true, AFTER_DRAIN = false;
    bf16_t* VT; float* STATS;
    __device__ __forceinline__ void operator()(const f32x4 (&acc)[2][2][4][2], const Unit& u, int wr, int wc, int fr, int fq) const {
        const int rowb = u.pm * BM + wr * 64 + fr; const int col0 = u.pn * BM + wc * 32 + 8 * fq;
        float s1[2][8], s2[2][8];
#pragma unroll
        for (int bj = 0; bj < 2; ++bj)
#pragma unroll
            for (int k = 0; k < 8; ++k) { s1[bj][k] = 0.f; s2[bj][k] = 0.f; }
#pragma unroll
        for (int ai = 0; ai < 2; ++ai)
#pragma unroll
            for (int m = 0; m < 4; ++m) { bf16_t* rowp = VT + (size_t)(rowb + ai * HALF + m * 16) * 8192 + col0;
#pragma unroll
                for (int bj = 0; bj < 2; ++bj) { f32x4 v0 = acc[ai][bj][m][0], v1 = acc[ai][bj][m][1]; gelu8(v0, v1);
#pragma unroll
                    for (int i = 0; i < 4; ++i) { s1[bj][i] += v0[i]; s2[bj][i] += v0[i] * v0[i]; s1[bj][4 + i] += v1[i]; s2[bj][4 + i] += v1[i] * v1[i]; }
                    *(u32x4*)(rowp + bj * HALF) = pack8(v0, v1); } }
#pragma unroll
        for (int bj = 0; bj < 2; ++bj)
#pragma unroll
            for (int k = 0; k < 8; ++k) {
#pragma unroll
                for (int o = 1; o < 16; o <<= 1) { s1[bj][k] += __shfl_xor(s1[bj][k], o); s2[bj][k] += __shfl_xor(s2[bj][k], o); }
                if (fr == 0) { float* sp = STATS + 2 * (size_t)(col0 + bj * HALF + k); atomicAdd(sp, s1[bj][k]); atomicAdd(sp + 1, s2[bj][k]); } }
    }
};
struct EpiOut {
    static constexpr bool PERM = false, AFTER_DRAIN = false;
    const float* base; float* out;
    __device__ __forceinline__ void operator()(const f32x4 (&acc)[2][2][4][2], const Unit& u, int wr, int wc, int fr, int fq) const {
        const int rowb = u.pm * BM + wr * 64 + fr; const int col0 = u.pn * BM + wc * 32 + 4 * fq;
#pragma unroll
        for (int ai = 0; ai < 2; ++ai)
#pragma unroll
            for (int m = 0; m < 4; ++m) { const size_t off = (size_t)(rowb + ai * HALF + m * 16) * 2048 + col0;
#pragma unroll
                for (int bj = 0; bj < 2; ++bj)
#pragma unroll
                    for (int n = 0; n < 2; ++n) { const f32x4 bs = *(const f32x4*)(base + off + bj * HALF + n * 16); *(f32x4*)(out + off + bj * HALF + n * 16) = bs + acc[ai][bj][m][n]; } }
    }
};
template <class Epi, class Sched, bool ALIGN_EPI = false, bool SP2 = false>
__device__ __forceinline__ void gemm_phase(PG8_LAS unsigned char* lds, const Gemm g, const Sched& S, const Epi& E) {
    int tid = threadIdx.x; asm volatile("" : "+v"(tid)); const int wid = __builtin_amdgcn_readfirstlane(tid >> 6), lane = tid & 63, wr = wid >> 2, wc = wid & 3, fr = lane & 15, fq = lane >> 4;
    const int K = g.K, nt = K / BK;
    unsigned voffA[2], voffB[2];
#pragma unroll
    for (int i = 0; i < 2; ++i) { int R, C; stage_rc(tid * 16 + i * 8192, R, C); const int Rb = Epi::PERM ? ((R & ~31) + perm32(R & 31)) : R;
        voffA[i] = (unsigned)(R * K + C) * 2u; voffB[i] = (unsigned)(Rb * g.bdil * K + C) * 2u; }
    const size_t kstep = (size_t)(BK * 2);
    const size_t hstep = (size_t)HALF * K * 2;
    const size_t tstep = 2 * hstep;
    const size_t hstepB = (g.bdil == 16) ? (size_t)K * 2 : (size_t)HALF * g.bdil * K * 2;
    const unsigned ldsw = (unsigned)wid * 1024u;
    const int aoff = lds_byte(wr * 64 + fr, fq * 8), boff = lds_byte(wc * 32 + fr, fq * 8);
#define PG8_SA(b, h) (((b) * 2 + (h)) * HTB)
#define PG8_SB(b, h) ((4 + (b) * 2 + (h)) * HTB)
#define PG8_STAGE(bufoff, gbase, voff) do { _Pragma("unroll") for (int _i = 0; _i < 2; ++_i) \
        __builtin_amdgcn_global_load_lds((const unsigned*)((const char*)(gbase) + (voff)[_i]), (PG8_LAS unsigned*)(lds + (bufoff) + ldsw + _i * 8192), 16, 0, 0); } while (0)
#define PG8_LDA(dst, b, h) do { _Pragma("unroll") for (int m = 0; m < 4; ++m) _Pragma("unroll") for (int k = 0; k < 2; ++k) dst[m][k] = *(const PG8_LAS bf16x8*)(lds + PG8_SA(b, h) + aoff + m * 2048 + k * 1024); } while (0)
#define PG8_LDB(dst, b, h) do { _Pragma("unroll") for (int n = 0; n < 2; ++n) _Pragma("unroll") for (int k = 0; k < 2; ++k) dst[n][k] = *(const PG8_LAS bf16x8*)(lds + PG8_SB(b, h) + boff + n * 2048 + k * 1024); } while (0)
#define PG8_MMA(ai, bj, At, Bt) do { __builtin_amdgcn_s_setprio(1); _Pragma("unroll") for (int m = 0; m < 4; ++m) _Pragma("unroll") for (int n = 0; n < 2; ++n) _Pragma("unroll") for (int k = 0; k < 2; ++k) \
        acc[ai][bj][m][n] = __builtin_amdgcn_mfma_f32_16x16x32_bf16(Bt[n][k], At[m][k], acc[ai][bj][m][n], 0, 0, 0); __builtin_amdgcn_s_setprio(0); } while (0)
#define PG8_WAIT_V(n) asm volatile("s_waitcnt vmcnt(" #n ")" ::: "memory")
#define PG8_WAIT_L(n) asm volatile("s_waitcnt lgkmcnt(" #n ")" ::: "memory")
#define PG8_BAR __builtin_amdgcn_s_barrier()
#define PG8_SCHED __builtin_amdgcn_sched_barrier(0)
    Unit cur, nxt; int ui = 0;
    if (!S.next(0, cur)) return;
    f32x4 acc[2][2][4][2];
#pragma unroll
    for (int a = 0; a < 2; ++a)
#pragma unroll
        for (int b = 0; b < 2; ++b)
#pragma unroll
            for (int m = 0; m < 4; ++m)
#pragma unroll
                for (int n = 0; n < 2; ++n) acc[a][b][m][n] = (f32x4){0.f, 0.f, 0.f, 0.f};
    bf16x8 At[4][2], B0[2][2], B1[2][2];
    const char* cA = (const char*)g.A + (size_t)cur.pm * tstep; const char* cB = (const char*)g.Bt + b_tile_off(g, cur.pn);
    S.a_ready(cur);
    if constexpr (SP2) {
        PG8_STAGE(PG8_SB(0, 0), cB, voffB); PG8_STAGE(PG8_SB(0, 1), cB + hstepB, voffB); PG8_STAGE(PG8_SA(0, 0), cA, voffA); PG8_STAGE(PG8_SA(0, 1), cA + hstep, voffA);
        if (wr == 1) PG8_BAR;
        PG8_WAIT_V(2); PG8_BAR;
        PG8_STAGE(PG8_SB(1, 0), cB + kstep, voffB); PG8_STAGE(PG8_SA(1, 0), cA + kstep, voffA); PG8_STAGE(PG8_SB(1, 1), cB + hstepB + kstep, voffB);
        PG8_WAIT_V(6); PG8_BAR;
    } else {
        PG8_STAGE(PG8_SB(0, 0), cB, voffB); PG8_STAGE(PG8_SA(0, 0), cA, voffA); PG8_STAGE(PG8_SB(0, 1), cB + hstepB, voffB); PG8_STAGE(PG8_SA(0, 1), cA + hstep, voffA);
        if (wr == 1) PG8_BAR;
        PG8_WAIT_V(4); PG8_BAR;
        PG8_STAGE(PG8_SB(1, 0), cB + kstep, voffB); PG8_STAGE(PG8_SA(1, 0), cA + kstep, voffA); PG8_STAGE(PG8_SB(1, 1), cB + hstepB + kstep, voffB);
        PG8_WAIT_V(6); PG8_BAR;
    }
    for (;;) {
        const bool has_next = S.next(ui + 1, nxt);
        const char* nA = has_next ? (const char*)g.A + (size_t)nxt.pm * tstep : cA; const char* nB = has_next ? (const char*)g.Bt + b_tile_off(g, nxt.pn) : cB;
        for (int t = 0; t < nt; t += 2) {
            const bool last = (t == nt - 2);
            const char* a1 = cA + (size_t)(t + 1) * kstep;
            const char* a2 = last ? nA : cA + (size_t)(t + 2) * kstep; const char* b2 = last ? nB : cB + (size_t)(t + 2) * kstep;
            const char* a3 = a2 + kstep; const char* b3 = b2 + kstep;
            if (last && has_next) S.a_ready(nxt);
            if constexpr (SP2) {
            PG8_LDB(B0, 0, 0); PG8_LDB(B1, 0, 1); PG8_SCHED; PG8_LDA(At, 0, 0); PG8_STAGE(PG8_SA(1, 1), a1 + hstep, voffA);
            PG8_WAIT_V(8); PG8_WAIT_L(0); PG8_BAR; PG8_MMA(0, 0, At, B0); PG8_MMA(0, 1, At, B1); PG8_BAR; PG8_SCHED;
            PG8_LDA(At, 0, 1); PG8_STAGE(PG8_SB(0, 0), b2, voffB); PG8_STAGE(PG8_SB(0, 1), b2 + hstepB, voffB); PG8_STAGE(PG8_SA(0, 0), a2, voffA);
            PG8_WAIT_V(8); PG8_WAIT_L(0); PG8_BAR; PG8_MMA(1, 0, At, B0); PG8_MMA(1, 1, At, B1); PG8_BAR; PG8_SCHED;
            PG8_LDB(B0, 1, 0); PG8_LDB(B1, 1, 1); PG8_SCHED; PG8_LDA(At, 1, 0); PG8_STAGE(PG8_SA(0, 1), a2 + hstep, voffA);
            PG8_WAIT_V(8); PG8_WAIT_L(0); PG8_BAR; PG8_MMA(0, 0, At, B0); PG8_MMA(0, 1, At, B1); PG8_BAR; PG8_SCHED;
            PG8_LDA(At, 1, 1); PG8_STAGE(PG8_SB(1, 0), b3, voffB); PG8_STAGE(PG8_SB(1, 1), b3 + hstepB, voffB); PG8_STAGE(PG8_SA(1, 0), a3, voffA);
            PG8_WAIT_V(8); PG8_WAIT_L(0); PG8_BAR; PG8_MMA(1, 0, At, B0); PG8_MMA(1, 1, At, B1); PG8_BAR; PG8_SCHED;
            } else {
            PG8_LDB(B0, 0, 0); PG8_SCHED; PG8_LDA(At, 0, 0); PG8_STAGE(PG8_SA(1, 1), a1 + hstep, voffA);
            PG8_WAIT_L(8); PG8_BAR; PG8_WAIT_L(0); PG8_MMA(0, 0, At, B0); PG8_BAR; PG8_SCHED;
            PG8_LDB(B1, 0, 1); PG8_STAGE(PG8_SB(0, 0), b2, voffB);
            PG8_BAR; PG8_WAIT_L(0); PG8_MMA(0, 1, At, B1); PG8_BAR;
            PG8_LDA(At, 0, 1); PG8_STAGE(PG8_SA(0, 0), a2, voffA);
            PG8_BAR; PG8_WAIT_L(0); PG8_MMA(1, 0, At, B0); PG8_BAR; PG8_SCHED;
            PG8_STAGE(PG8_SB(0, 1), b2 + hstepB, voffB);
            PG8_WAIT_V(6); PG8_BAR; PG8_MMA(1, 1, At, B1); PG8_BAR;
            PG8_LDB(B0, 1, 0); PG8_SCHED; PG8_LDA(At, 1, 0); PG8_STAGE(PG8_SA(0, 1), a2 + hstep, voffA);
            PG8_WAIT_L(8); PG8_BAR; PG8_WAIT_L(0); PG8_MMA(0, 0, At, B0); PG8_BAR; PG8_SCHED;
            PG8_LDB(B1, 1, 1); PG8_STAGE(PG8_SB(1, 0), b3, voffB);
            PG8_BAR; PG8_WAIT_L(0); PG8_MMA(0, 1, At, B1); PG8_BAR;
            PG8_LDA(At, 1, 1); PG8_STAGE(PG8_SA(1, 0), a3, voffA);
            PG8_BAR; PG8_WAIT_L(0); PG8_MMA(1, 0, At, B0); PG8_BAR; PG8_SCHED;
            PG8_STAGE(PG8_SB(1, 1), b3 + hstepB, voffB);
            PG8_WAIT_V(6); PG8_BAR; PG8_MMA(1, 1, At, B1); PG8_BAR;
            }
        }
        if constexpr (ALIGN_EPI) { if (wr == 0) PG8_BAR; }
        if constexpr (!Epi::AFTER_DRAIN) { E(acc, cur, wr, wc, fr, fq); S.done(cur); }
        if (!has_next) break;
#pragma unroll
        for (int a = 0; a < 2; ++a)
#pragma unroll
            for (int b = 0; b < 2; ++b)
#pragma unroll
                for (int m = 0; m < 4; ++m)
#pragma unroll
                    for (int n = 0; n < 2; ++n) acc[a][b][m][n] = (f32x4){0.f, 0.f, 0.f, 0.f};
        cur = nxt; cA = nA; cB = nB; ++ui;
        if constexpr (ALIGN_EPI) { if (wr == 1) PG8_BAR; }
    }
    PG8_WAIT_V(0);
    if constexpr (!ALIGN_EPI) { if (wr == 0) PG8_BAR; }
    PG8_BAR;
    if constexpr (Epi::AFTER_DRAIN) { E.fused(acc, cur, wr, wc, fr, fq, lds, wid, lane); S.done(cur); }
#undef PG8_SA
#undef PG8_SB
#undef PG8_STAGE
#undef PG8_LDA
#undef PG8_LDB
#undef PG8_MMA
#undef PG8_WAIT_V
#undef PG8_WAIT_L
#undef PG8_BAR
#undef PG8_SCHED
}
}

constexpr int NWAVES = 8, NTHR = NWAVES * 64;
constexpr int BATCH = 4, SEQ = 2048, DM = 2048, MTOK = BATCH * SEQ;
constexpr int A_IN = 20480, B_IN = 6144, NA1 = 14336;
constexpr float RMS_EPS = 1e-6f, LN_EPS = 1e-5f;
constexpr size_t MiB = 1u << 20;
constexpr size_t SZ_ACT = (size_t)MTOK * DM * 2;
constexpr size_t WS_WAIN = 2 * MiB;
constexpr size_t WS_WAOUT = WS_WAIN + 2 * (size_t)A_IN * DM * 2;
constexpr size_t WS_WBIN = WS_WAOUT + 2 * (size_t)DM * DM * 2;
constexpr size_t WS_WBOUT = WS_WBIN + 2 * (size_t)B_IN * DM * 2;
constexpr size_t WS_WM = WS_WBOUT + 2 * (size_t)DM * DM * 2;
constexpr size_t WS_COS = WS_WM + 2 * 16 * 128 * 128 * 2;
constexpr size_t WS_SIN = WS_COS + (size_t)MTOK * 16 * 4;
constexpr size_t WS_STATS = WS_SIN + (size_t)MTOK * 16 * 4;
constexpr size_t WS_LSE = WS_STATS + 2 * (size_t)MTOK * 2 * 4;
constexpr size_t WS_X = WS_LSE + 3 * (size_t)MTOK * 16 * 4;
constexpr size_t WS_XN = WS_X + 2 * SZ_ACT;
constexpr size_t WS_QK = WS_XN + SZ_ACT;
constexpr size_t WS_VT = WS_QK + 6 * SZ_ACT;
constexpr size_t WS_GATE = WS_VT + 3 * SZ_ACT;
constexpr size_t WS_OG = WS_GATE + SZ_ACT;
constexpr size_t WS_Y = WS_OG + 3 * SZ_ACT;
constexpr size_t WS_END = WS_Y + SZ_ACT;
constexpr size_t WS_BAR = 65536;
constexpr int LDS_BYTES = 147456;

typedef unsigned short bf16;
typedef unsigned v4u __attribute__((ext_vector_type(4)));
typedef unsigned v2u __attribute__((ext_vector_type(2)));
typedef float f32x4 __attribute__((ext_vector_type(4)));
typedef float f32x2v __attribute__((ext_vector_type(2)));
typedef float f32x16 __attribute__((ext_vector_type(16)));
typedef short bf16x8 __attribute__((ext_vector_type(8)));
typedef __bf16 bf16x2_t __attribute__((ext_vector_type(2)));
#define LAS __attribute__((address_space(3)))
#define MFMA32(a, b, c) __builtin_amdgcn_mfma_f32_32x32x16_bf16((a), (b), (c), 0, 0, 0)
__device__ __forceinline__ unsigned pk2(float lo, float hi) { f32x2v v = {lo, hi}; bf16x2_t b = __builtin_convertvector(v, bf16x2_t); return __builtin_bit_cast(unsigned, b); }
__device__ __forceinline__ float bflo(unsigned w) { return __builtin_bit_cast(float, w << 16); }
__device__ __forceinline__ float bfhi(unsigned w) { return __builtin_bit_cast(float, w & 0xffff0000u); }
__device__ __forceinline__ float wave_sum(float v) {
#pragma unroll
    for (int o = 1; o < 64; o <<= 1) v += __shfl_xor(v, o);
    return v;
}

#define XB_TMO      128
#define XB_XCNT(j)  (256  + 64 * (j))
#define XB_XSUB(j)  (1280 + 64 * (j))
#define XB_XGEN(j)  (2304 + 64 * (j))
#define XB_TOP      3328
#define XB_TOPGEN   3392
#define XCD_BAR_WORDS 3456
#define XB_SPIN_CAP (1u << 18)

__device__ __forceinline__ unsigned xb_ld(unsigned* p)              { return __hip_atomic_load(p, __ATOMIC_RELAXED, __HIP_MEMORY_SCOPE_AGENT); }
__device__ __forceinline__ unsigned xb_add(unsigned* p, unsigned v) { return __hip_atomic_fetch_add(p, v, __ATOMIC_RELAXED, __HIP_MEMORY_SCOPE_AGENT); }
__device__ __forceinline__ unsigned xb_xcc_id() { return (unsigned)__builtin_amdgcn_s_getreg((3 << 11) | 20) & 0xFu; }
#define XB_SPIN(cond, bar) do { unsigned _sp = 0; while (cond) { __builtin_amdgcn_s_sleep(1); \
    if ((++_sp & 255u) == 0u) { if (xb_ld(&(bar)[XB_TMO])) break; if (_sp > XB_SPIN_CAP) { atomicAdd(&(bar)[XB_TMO], 1u); break; } } } } while (0)

struct XcdBarrier {
    unsigned* bar; unsigned x;
    volatile LAS unsigned* st;
};

__device__ __forceinline__ XcdBarrier xcd_barrier_post(unsigned* bar, volatile LAS unsigned* st) {
    XcdBarrier b; b.bar = bar; b.x = xb_xcc_id(); b.st = st;
    if (threadIdx.x == 0) (void)xb_add(&bar[XB_XCNT(b.x)], 1u);
    return b;
}
__device__ __forceinline__ void xcd_barrier_complete(unsigned* bar, unsigned x, unsigned& nloc, unsigned& nx) {
    const unsigned G = gridDim.x * gridDim.y * gridDim.z;
    unsigned sum, cnt, mine, sp = 0u;
    for (;;) {
        sum = 0u; cnt = 0u; mine = 0u;
#pragma unroll
        for (unsigned j = 0; j < 16; ++j) { const unsigned c = xb_ld(&bar[XB_XCNT(j)]); sum += c; cnt += (c > 0u) ? 1u : 0u; mine = (j == x) ? c : mine; }
        if (sum == G) break;
        __builtin_amdgcn_s_sleep(1);
        if ((++sp & 255u) == 0u) { if (xb_ld(&bar[XB_TMO])) break; if (sp > XB_SPIN_CAP) { atomicAdd(&bar[XB_TMO], 1u); break; } }
    }
    nloc = mine > 0u ? mine : 1u; nx = cnt > 0u ? cnt : 1u;
}

__device__ __forceinline__ void xcd_barrier(const XcdBarrier& b) {
    asm volatile("s_waitcnt vmcnt(0)" ::: "memory");
    __syncthreads();
    if (threadIdx.x == 0) {
        unsigned* bar = b.bar;
        __builtin_amdgcn_s_waitcnt(0);
        unsigned nloc = b.st[0], nx = b.st[1];
        if (nloc == 0u) { xcd_barrier_complete(bar, b.x, nloc, nx); b.st[0] = nloc; b.st[1] = nx; }
        const unsigned old = xb_add(&bar[XB_XSUB(b.x)], 1u);
        const unsigned gen = old / nloc;
        if (old + 1u == (gen + 1u) * nloc) {
            __builtin_amdgcn_fence(__ATOMIC_RELEASE, "agent");
            asm volatile("s_waitcnt vmcnt(0)" ::: "memory");
            const unsigned og = xb_add(&bar[XB_TOP], 1u);
            const unsigned tg = og / nx;
            if (og + 1u == (tg + 1u) * nx) xb_add(&bar[XB_TOPGEN], 1u);
            else XB_SPIN(xb_ld(&bar[XB_TOPGEN]) == tg, bar);
            __builtin_amdgcn_fence(__ATOMIC_ACQUIRE, "agent");
            xb_add(&bar[XB_XGEN(b.x)], 1u);
            asm volatile("s_waitcnt vmcnt(0)" ::: "memory");
        } else {
            XB_SPIN(xb_ld(&bar[XB_XGEN(b.x)]) == gen, bar);
            __builtin_amdgcn_fence(__ATOMIC_ACQUIRE, "agent");
            asm volatile("s_waitcnt vmcnt(0)" ::: "memory");
        }
    }
    __syncthreads();
}

__device__ __forceinline__ int launder(int v) { asm volatile("" : "+v"(v)); return v; }
struct Args {
    const float* x; const int* pos; const float* a_norm_g; const float* a_w_in; const float* a_w_out; const float* b_norm_g; const float* b_w_in;
    const float* b_ln_g; const float* b_ln_b; const float* b_w_s; const float* b_b_s; const float* b_w_out; const float* final_g;
    float* out; unsigned char* ws; double invf[16];
    int ph_lo, ph_hi;
};

__device__ __forceinline__ void p0_transpose_item(const float* W, int K, int N, bf16* WT, int row_off, LAS float* scr, int kb, int nb, int lane) {
    const int k0 = 64 * kb, n0 = 32 * nb;
#pragma unroll 8
    for (int i = 0; i < 32; ++i) { const int kk = 2 * i + (lane >> 5); scr[kk * 33 + (lane & 31)] = W[(size_t)(k0 + kk) * N + n0 + (lane & 31)]; }
    asm volatile("s_waitcnt lgkmcnt(0)" ::: "memory");
    const int c = lane & 7;
#pragma unroll
    for (int j = 0; j < 4; ++j) { const int n = (lane >> 3) + 8 * j; const LAS float* s = scr + (8 * c) * 33 + n;
        v4u o; o.x = pk2(s[0 * 33], s[1 * 33]); o.y = pk2(s[2 * 33], s[3 * 33]); o.z = pk2(s[4 * 33], s[5 * 33]); o.w = pk2(s[6 * 33], s[7 * 33]);
        *(v4u*)(WT + (size_t)(row_off + n0 + n) * K + k0 + 8 * c) = o; }
    asm volatile("s_waitcnt lgkmcnt(0)" ::: "memory");
}
template <bool F32OUT> __device__ __forceinline__ void rms_row(const float* xrow, const float* g, void* orow, int lane) {
    const f32x4* xr = (const f32x4*)xrow + lane; const f32x4* gr = (const f32x4*)g + lane;
    f32x4 v[8]; float s = 0.f;
#pragma unroll
    for (int j = 0; j < 8; ++j) { v[j] = xr[64 * j]; s += (v[j].x * v[j].x + v[j].y * v[j].y) + (v[j].z * v[j].z + v[j].w * v[j].w); }
    const float rstd = 1.0f / sqrtf(wave_sum(s) * (1.0f / DM) + RMS_EPS);
#pragma unroll
    for (int j = 0; j < 8; ++j) { const f32x4 gg = gr[64 * j]; const f32x4 y = v[j] * rstd * gg;
        if (F32OUT) ((f32x4*)orow + lane)[64 * j] = y;
        else { v2u w; w.x = pk2(y.x, y.y); w.y = pk2(y.z, y.w); ((v2u*)orow + lane)[64 * j] = w; } }
}

__device__ __forceinline__ void attn_phase(const bf16* QK, const bf16* VT, bf16* OG, float* LSE, int gw, int NGW, int lane) {
    const int q = lane & 31, hh = lane >> 5;
    const int kperm = (q & 0x13) | ((q & 4) << 1) | ((q & 8) >> 1);
    for (int wu = gw; wu < 3 * 4096; wu += NGW) {
        const int g = wu >> 12, rest = wu & 4095, qw = rest & 3, blk = (rest >> 2) & 15, h = (rest >> 6) & 15, b = rest >> 10;
        const int dsh = 2 * g; const bool has_prev = (blk & ((16 >> dsh) - 1)) != 0;
        const bf16* Qp = QK + ((size_t)((g * 2 + 0) * 4 + b) * 16 + h) * (2048 * 128) + (size_t)(blk * 128 + qw * 32 + q) * 128 + 8 * hh;
        const bf16* Kb = QK + ((size_t)((g * 2 + 1) * 4 + b) * 16 + h) * (2048 * 128) + 8 * hh;
        const bf16* Vb = VT + (size_t)g * 2048 * 8192 + (size_t)(h * 128 + q) * 8192 + b * 2048 + 8 * hh;
        bf16x8 qf[8];
#pragma unroll
        for (int c = 0; c < 8; ++c) qf[c] = *(const bf16x8*)(Qp + 16 * c);
        f32x16 O[4];
#pragma unroll
        for (int db = 0; db < 4; ++db)
#pragma unroll
            for (int i = 0; i < 16; ++i) O[db][i] = 0.f;
        float m = -INFINITY, l = 0.f;
        const int t0 = has_prev ? 0 : 4 - qw;
        for (int t = t0; t < 5; ++t) {
            const int p0 = blk * 128 - 128 + qw * 32 + 32 * t;
            const bf16* Kp = Kb + (size_t)(p0 + kperm) * 128;
            bf16x8 kf[8];
#pragma unroll
            for (int c = 0; c < 8; ++c) kf[c] = *(const bf16x8*)(Kp + 16 * c);
            bf16x8 vf[4][2];
#pragma unroll
            for (int db = 0; db < 4; ++db) { vf[db][0] = *(const bf16x8*)(Vb + (size_t)db * 32 * 8192 + p0); vf[db][1] = *(const bf16x8*)(Vb + (size_t)db * 32 * 8192 + p0 + 16); }
            f32x16 S;
#pragma unroll
            for (int i = 0; i < 16; ++i) S[i] = 0.f;
#pragma unroll
            for (int c = 0; c < 8; ++c) S = MFMA32(kf[c], qf[c], S);
            if (t == 0) {
#pragma unroll
                for (int i = 0; i < 16; ++i) { const int kt = 16 * (i >> 3) + 8 * hh + (i & 7); if (kt < q) S[i] = -INFINITY; }
            }
            if (t == 4) {
#pragma unroll
                for (int i = 0; i < 16; ++i) { const int kt = 16 * (i >> 3) + 8 * hh + (i & 7); if (kt > q) S[i] = -INFINITY; }
            }
            float mx = S[0];
#pragma unroll
            for (int i = 1; i < 16; ++i) mx = fmaxf(mx, S[i]);
            mx = fmaxf(mx, __shfl_xor(mx, 32));
            const float mn = fmaxf(m, mx), alpha = __builtin_amdgcn_exp2f(m - mn);
            float rs = 0.f;
#pragma unroll
            for (int i = 0; i < 16; ++i) { S[i] = __builtin_amdgcn_exp2f(S[i] - mn); rs += S[i]; }
            l = l * alpha + rs; m = mn;
#pragma unroll
            for (int db = 0; db < 4; ++db)
#pragma unroll
                for (int i = 0; i < 16; ++i) O[db][i] *= alpha;
            v4u w0, w1;
            w0.x = pk2(S[0], S[1]); w0.y = pk2(S[2], S[3]); w0.z = pk2(S[4], S[5]); w0.w = pk2(S[6], S[7]);
            w1.x = pk2(S[8], S[9]); w1.y = pk2(S[10], S[11]); w1.z = pk2(S[12], S[13]); w1.w = pk2(S[14], S[15]);
            const bf16x8 ps0 = __builtin_bit_cast(bf16x8, w0), ps1 = __builtin_bit_cast(bf16x8, w1);
#pragma unroll
            for (int db = 0; db < 4; ++db) { O[db] = MFMA32(vf[db][0], ps0, O[db]); O[db] = MFMA32(vf[db][1], ps1, O[db]); }
        }
        l += __shfl_xor(l, 32);
        const float inv = 1.0f / l, lse2 = m + __builtin_amdgcn_logf(l);
        const int p = blk * 128 + qw * 32 + q, Lm1 = (2048 >> dsh) - 1, s = ((p & Lm1) << dsh) | (p >> (11 - dsh));
        const size_t tok = (size_t)b * 2048 + s;
        bf16* op = OG + ((size_t)g * MTOK + tok) * 2048 + h * 128 + 4 * hh;
#pragma unroll
        for (int db = 0; db < 4; ++db)
#pragma unroll
            for (int i4 = 0; i4 < 4; ++i4) { v2u w; w.x = pk2(O[db][4 * i4] * inv, O[db][4 * i4 + 1] * inv); w.y = pk2(O[db][4 * i4 + 2] * inv, O[db][4 * i4 + 3] * inv);
                *(v2u*)(op + db * 32 + 8 * i4) = w; }
        if (hh == 0) LSE[((size_t)g * MTOK + tok) * 16 + h] = lse2;
    }
}
__device__ __forceinline__ void merge_phase(const bf16* OG, const float* LSE, const bf16* GATE, bf16* Y, int gw, int NGW, int lane) {
    for (int row = gw; row < MTOK; row += NGW) {
#pragma unroll
        for (int j = 0; j < 4; ++j) { const int col = lane * 8 + 512 * j, h = col >> 7;
            const float l0 = LSE[((size_t)0 * MTOK + row) * 16 + h], l1 = LSE[((size_t)1 * MTOK + row) * 16 + h], l2 = LSE[((size_t)2 * MTOK + row) * 16 + h];
            const float mx = fmaxf(l0, fmaxf(l1, l2));
            float w0 = __builtin_amdgcn_exp2f(l0 - mx), w1 = __builtin_amdgcn_exp2f(l1 - mx), w2 = __builtin_amdgcn_exp2f(l2 - mx);
            const float inv = 1.0f / (w0 + w1 + w2); w0 *= inv; w1 *= inv; w2 *= inv;
            const size_t off = (size_t)row * 2048 + col;
            const v4u a = *(const v4u*)(OG + off), bb = *(const v4u*)(OG + (size_t)MTOK * 2048 + off), c = *(const v4u*)(OG + 2 * (size_t)MTOK * 2048 + off), gt = *(const v4u*)(GATE + off);
            v4u o;
#pragma unroll
            for (int k = 0; k < 4; ++k) {
                const float ylo = (w0 * bflo(a[k]) + w1 * bflo(bb[k]) + w2 * bflo(c[k])) * bflo(gt[k]);
                const float yhi = (w0 * bfhi(a[k]) + w1 * bfhi(bb[k]) + w2 * bfhi(c[k])) * bfhi(gt[k]);
                o[k] = pk2(ylo, yhi); }
            *(v4u*)(Y + off) = o; }
    }
}
__device__ __forceinline__ void sgu_phase(const bf16* VTB, const float* STATS, const float* LNG, const float* LNB, const bf16* WM, const float* BS, const bf16* U, const bf16* ZS, bf16* Y,
                                          int gw, int NGW, int lane) {
    const int r = lane & 31, hh = lane >> 5;
    for (int wu = gw; wu < 4096; wu += NGW) {
        const int cblk = wu & 3, g = (wu >> 2) & 15, chunk = (wu >> 6) & 15, b = wu >> 10;
        const int ch = g * 128 + cblk * 32 + r, tok0 = b * 2048 + chunk * 128;
        const float lng = LNG[ch], lnb = LNB[ch];
        bf16x8 af[8];
#pragma unroll
        for (int ks = 0; ks < 8; ++ks) { const int s0 = 16 * ks + 8 * hh;
            const v4u raw = *(const v4u*)(VTB + (size_t)ch * 8192 + tok0 + s0);
            const f32x4* st = (const f32x4*)(STATS + 2 * (size_t)(tok0 + s0));
            v4u o;
#pragma unroll
            for (int k = 0; k < 4; ++k) { const f32x4 sv = st[k];
                const float mu0 = sv.x * (1.0f / 2048), mu1 = sv.z * (1.0f / 2048);
                const float a0 = lng / sqrtf(fmaxf(sv.y * (1.0f / 2048) - mu0 * mu0, 0.f) + LN_EPS), a1 = lng / sqrtf(fmaxf(sv.w * (1.0f / 2048) - mu1 * mu1, 0.f) + LN_EPS);
                o[k] = pk2(bflo(raw[k]) * a0 + (lnb - mu0 * a0), bfhi(raw[k]) * a1 + (lnb - mu1 * a1)); }
            af[ks] = __builtin_bit_cast(bf16x8, o); }
#pragma unroll
        for (int tb = 0; tb < 4; ++tb) {
            f32x16 D;
#pragma unroll
            for (int i = 0; i < 16; ++i) D[i] = 0.f;
            const bf16* wp = WM + (size_t)(g * 128 + tb * 32 + r) * 128 + 8 * hh;
#pragma unroll
            for (int ks = 0; ks < 2 * tb + 2; ++ks) { const bf16x8 bfr = *(const bf16x8*)(wp + 16 * ks); D = MFMA32(af[ks], bfr, D); }
            const int t = tb * 32 + r; const float bs = BS[g * 128 + t];
            const size_t rowoff = (size_t)(tok0 + t) * 2048 + g * 128 + cblk * 32 + 4 * hh;
#pragma unroll
            for (int i4 = 0; i4 < 4; ++i4) { const v2u uu = *(const v2u*)(U + rowoff + 8 * i4), zz = *(const v2u*)(ZS + rowoff + 8 * i4);
                v2u w; w.x = pk2(bflo(uu.x) * (D[4 * i4] + bs) * bflo(zz.x), bfhi(uu.x) * (D[4 * i4 + 1] + bs) * bfhi(zz.x));
                w.y = pk2(bflo(uu.y) * (D[4 * i4 + 2] + bs) * bflo(zz.y), bfhi(uu.y) * (D[4 * i4 + 3] + bs) * bfhi(zz.y));
                *(v2u*)(Y + rowoff + 8 * i4) = w; }
        }
    }
}

constexpr int N_PHASES = 19;
__global__ void __launch_bounds__(NTHR) trunk_fwd(Args args) {
    extern __shared__ __attribute__((aligned(16))) unsigned char lds[];
    const int tid = threadIdx.x, lane = tid & 63, wave = __builtin_amdgcn_readfirstlane(tid >> 6);
    const int G = gridDim.x, bx = blockIdx.x;
    const int gw = bx * NWAVES + wave, NGW = G * NWAVES;
    unsigned char* ws = args.ws;
    bf16* WAin = (bf16*)(ws + WS_WAIN); bf16* WAout = (bf16*)(ws + WS_WAOUT); bf16* WBin = (bf16*)(ws + WS_WBIN); bf16* WBout = (bf16*)(ws + WS_WBOUT); bf16* WM = (bf16*)(ws + WS_WM);
    float* COS = (float*)(ws + WS_COS); float* SIN = (float*)(ws + WS_SIN); float* STATS = (float*)(ws + WS_STATS); float* LSE = (float*)(ws + WS_LSE);
    float* X = (float*)(ws + WS_X); bf16* XN = (bf16*)(ws + WS_XN); bf16* QK = (bf16*)(ws + WS_QK); bf16* VT = (bf16*)(ws + WS_VT); bf16* GATE = (bf16*)(ws + WS_GATE);
    bf16* OG = (bf16*)(ws + WS_OG); bf16* Y = (bf16*)(ws + WS_Y);
    bf16* U = OG; bf16* ZS = OG + (size_t)MTOK * 2048;
    const int lo = args.ph_lo, hi = args.ph_hi;
#define IN(k) (lo <= (k) && (k) < hi)
    volatile LAS unsigned* MISC = (volatile LAS unsigned*)((LAS unsigned char*)lds + 131072 + 320);
    if (tid < 32) MISC[tid] = 0u;
    unsigned* barw = (unsigned*)(ws + WS_BAR);
#if !MK_PER_PHASE
    if (bx == 0) for (int i = tid; i < XCD_BAR_WORDS; i += NTHR) __hip_atomic_store(barw + i, 0u, __ATOMIC_RELAXED, __HIP_MEMORY_SCOPE_AGENT);
#endif
    __syncthreads();
    XcdBarrier xbar; xbar.bar = barw; xbar.x = 0; xbar.st = MISC + 8;
#if MK_PER_PHASE
#define SEAM(k) do { } while (0)
#else
#define SEAM(k) do { if (IN(k) && IN((k) + 1)) xcd_barrier(xbar); } while (0)
#endif
    if (IN(0)) {
        LAS float* scr = (LAS float*)((LAS unsigned char*)lds + wave * 16384);
        constexpr int I_AIN = 32 * (A_IN / 32), I_SQ = 32 * (DM / 32), I_BIN = 32 * (B_IN / 32);
        constexpr int NITEMS = 2 * (I_AIN + I_SQ + I_BIN + I_SQ);
        for (int it = gw; it < NITEMS; it += NGW) {
            int r = it; const int j = r / (NITEMS / 2); r -= j * (NITEMS / 2);
            if (r < I_AIN) { const int nblk = A_IN / 32, kb = r / nblk, nb = r % nblk, sb = (nb * 32) / 2048;
                const int db = sb == 9 ? 6 : ((sb % 3) == 2 ? 7 + sb / 3 : 2 * (sb / 3) + (sb % 3));
                p0_transpose_item(args.a_w_in + (size_t)j * DM * A_IN, DM, A_IN, WAin + (size_t)j * A_IN * DM, (db - sb) * 2048, scr, kb, nb, lane); continue; } r -= I_AIN;
            if (r < I_SQ) { p0_transpose_item(args.a_w_out + (size_t)j * DM * DM, DM, DM, WAout + (size_t)j * DM * DM, 0, scr, r / (DM / 32), r % (DM / 32), lane); continue; } r -= I_SQ;
            if (r < I_BIN) { const int nblk = B_IN / 32, kb = r / nblk, nb = r % nblk, sb = (nb * 32) / 2048;
                const int db = sb == 0 ? 0 : (sb == 1 ? 2 : 1);
                p0_transpose_item(args.b_w_in + (size_t)j * DM * B_IN, DM, B_IN, WBin + (size_t)j * B_IN * DM, (db - sb) * 2048, scr, kb, nb, lane); continue; } r -= I_BIN;
            p0_transpose_item(args.b_w_out + (size_t)j * DM * DM, DM, DM, WBout + (size_t)j * DM * DM, 0, scr, r / (DM / 32), r % (DM / 32), lane);
        }
        const int gt = bx * NTHR + tid, NGT = G * NTHR;
        for (int i = gt; i < 2 * 16 * 128 * 128 / 2; i += NGT) { const int e = 2 * i, s = e & 127, t = (e >> 7) & 127;
            const f32x2v w = *(const f32x2v*)(args.b_w_s + e); ((unsigned*)WM)[i] = pk2(s <= t ? w.x : 0.f, s + 1 <= t ? w.y : 0.f); }
        for (int i = gt; i < MTOK * 16; i += NGT) { const int tok = i >> 4, f = i & 15; const double rev = (double)args.pos[tok] * args.invf[f]; const float fr = (float)(rev - floor(rev));
            COS[i] = __builtin_amdgcn_cosf(fr); SIN[i] = __builtin_amdgcn_sinf(fr); }
        for (int i = gt; i < 2 * MTOK * 2; i += NGT) STATS[i] = 0.f;
        for (int m = gw; m < MTOK; m += NGW) rms_row<false>(args.x + (size_t)m * DM, args.a_norm_g, XN + (size_t)m * DM, lane);
    }
#if !MK_PER_PHASE
    cg::this_grid().sync();
    xbar = xcd_barrier_post(barw, MISC + 8);
#endif
    for (int rep = 0; rep < 2; ++rep) {
        const int P = 1 + 9 * rep;
        if (IN(P)) {
            const bf16* W = WAin + (size_t)rep * A_IN * DM;
            { pg8::Gemm g{XN, W, MTOK, NA1, DM, 1}; pg8::StaticOrder S; S.init(MTOK, NA1, G, bx); pg8::EpiA1 E{QK, GATE, COS, SIN};
              pg8::gemm_phase<pg8::EpiA1, pg8::StaticOrder, true, true>((LAS unsigned char*)lds, g, S, E); }
            for (int grp = 0; grp < 3; ++grp) {
                pg8::Gemm g{W + (size_t)(NA1 + grp * 2048) * DM, XN, 2048, MTOK, DM, 1 << (2 * grp)}; pg8::StaticOrder S; S.init(2048, MTOK, G, bx);
                pg8::EpiPlain E{VT + (size_t)grp * 2048 * 8192, 8192};
                pg8::gemm_phase<pg8::EpiPlain, pg8::StaticOrder, true, true>((LAS unsigned char*)lds, g, S, E); }
        }
        SEAM(P);
        if (IN(P + 1)) attn_phase(QK, VT, OG, LSE, gw, NGW, launder(lane));
        SEAM(P + 1);
        if (IN(P + 2)) merge_phase(OG, LSE, GATE, Y, gw, NGW, launder(lane));
        SEAM(P + 2);
        if (IN(P + 3)) { pg8::Gemm g{Y, WAout + (size_t)rep * DM * DM, MTOK, DM, DM, 1}; pg8::StaticOrder S; S.init(MTOK, DM, G, bx); pg8::EpiOut E{rep == 0 ? args.x : X, X};
            pg8::gemm_phase<pg8::EpiOut, pg8::StaticOrder, true, true>((LAS unsigned char*)lds, g, S, E); }
        SEAM(P + 3);
        if (IN(P + 4)) { const int ln = launder(lane); const float* gn = args.b_norm_g + (size_t)rep * DM; for (int m = gw; m < MTOK; m += NGW) rms_row<false>(X + (size_t)m * DM, gn, XN + (size_t)m * DM, ln); }
        SEAM(P + 4);
        if (IN(P + 5)) {
            const bf16* W = WBin + (size_t)rep * B_IN * DM;
            { pg8::Gemm g{XN, W, MTOK, 4096, DM, 1}; pg8::StaticOrder S; S.init(MTOK, 4096, G, bx); pg8::EpiB1 E{U, ZS};
              pg8::gemm_phase<pg8::EpiB1, pg8::StaticOrder, true, true>((LAS unsigned char*)lds, g, S, E); }
            { pg8::Gemm g{W + (size_t)4096 * DM, XN, 2048, MTOK, DM, 1}; pg8::StaticOrder S; S.init(2048, MTOK, G, bx); pg8::EpiB2 E{VT, STATS + (size_t)rep * MTOK * 2};
              pg8::gemm_phase<pg8::EpiB2, pg8::StaticOrder, true, true>((LAS unsigned char*)lds, g, S, E); }
        }
        SEAM(P + 5);
        if (IN(P + 6)) sgu_phase(VT, STATS + (size_t)rep * MTOK * 2, args.b_ln_g + (size_t)rep * DM, args.b_ln_b + (size_t)rep * DM, WM + (size_t)rep * 16 * 128 * 128, args.b_b_s + (size_t)rep * 16 * 128, U, ZS, Y, gw, NGW, launder(lane));
        SEAM(P + 6);
        if (IN(P + 7)) { pg8::Gemm g{Y, WBout + (size_t)rep * DM * DM, MTOK, DM, DM, 1}; pg8::StaticOrder S; S.init(MTOK, DM, G, bx); pg8::EpiOut E{X, X};
            pg8::gemm_phase<pg8::EpiOut, pg8::StaticOrder, true, true>((LAS unsigned char*)lds, g, S, E); }
        SEAM(P + 7);
        if (IN(P + 8)) { const int ln = launder(lane);
            if (rep == 0) { const float* gn = args.a_norm_g + DM; for (int m = gw; m < MTOK; m += NGW) rms_row<false>(X + (size_t)m * DM, gn, XN + (size_t)m * DM, ln); }
            else { for (int m = gw; m < MTOK; m += NGW) rms_row<true>(X + (size_t)m * DM, args.final_g, args.out + (size_t)m * DM, ln); }
        }
        if (rep == 0) SEAM(P + 8);
    }
#undef IN
#undef SEAM
}

extern "C" void kernel_launch(void* const* d_in, const int* in_sizes, int n_in, void* d_out, int out_size, void* d_ws, size_t ws_size, hipStream_t stream) {
    static int grid = 0;
    if (grid == 0) {
        if (n_in != 13 || in_sizes[0] != MTOK * DM || out_size != MTOK * DM || ws_size < WS_END) { fprintf(stderr, "kernel_launch: unexpected shapes / workspace (n_in %d, in0 %d, out %d, ws %zu, need %zu)\n", n_in, n_in > 0 ? in_sizes[0] : -1, out_size, ws_size, (size_t)WS_END); grid = -1; return; }
        int dev = 0, cus = 0, per_cu = 0;
        if (hipGetDevice(&dev) != hipSuccess || hipDeviceGetAttribute(&cus, hipDeviceAttributeMultiprocessorCount, dev) != hipSuccess) { grid = -1; return; }
        if (hipFuncSetAttribute((const void*)trunk_fwd, hipFuncAttributeMaxDynamicSharedMemorySize, LDS_BYTES) != hipSuccess) { fprintf(stderr, "kernel_launch: hipFuncSetAttribute failed\n"); grid = -1; return; }
        if (hipOccupancyMaxActiveBlocksPerMultiprocessor(&per_cu, (const void*)trunk_fwd, NTHR, LDS_BYTES) != hipSuccess || per_cu < 1) { fprintf(stderr, "kernel_launch: occupancy query failed (%d)\n", per_cu); (void)hipGetLastError(); grid = -1; return; }
        grid = cus * per_cu;
    }
    if (grid < 0) return;
    Args a{};
    a.x = (const float*)d_in[0]; a.pos = (const int*)d_in[1]; a.a_norm_g = (const float*)d_in[2]; a.a_w_in = (const float*)d_in[3]; a.a_w_out = (const float*)d_in[4];
    a.b_norm_g = (const float*)d_in[5]; a.b_w_in = (const float*)d_in[6]; a.b_ln_g = (const float*)d_in[7]; a.b_ln_b = (const float*)d_in[8]; a.b_w_s = (const float*)d_in[9];
    a.b_b_s = (const float*)d_in[10]; a.b_w_out = (const float*)d_in[11]; a.final_g = (const float*)d_in[12];
    a.out = (float*)d_out; a.ws = (unsigned char*)d_ws;
    for (int i = 0; i < 16; ++i) a.invf[i] = pow(500000.0, -(double)i / 16.0) / 6.283185307179586476925;
#if MK_PER_PHASE
    for (int p = 0; p < N_PHASES; ++p) { a.ph_lo = p; a.ph_hi = p + 1; hipLaunchKernelGGL(trunk_fwd, dim3(grid), dim3(NTHR), LDS_BYTES, stream, a); }
#else
    a.ph_lo = 0; a.ph_hi = N_PHASES;
    void* kargs[] = {&a};
    const hipError_t e = hipLaunchCooperativeKernel((const void*)trunk_fwd, dim3(grid), dim3(NTHR), kargs, LDS_BYTES, stream);
    if (e != hipSuccess) fprintf(stderr, "kernel_launch: cooperative launch failed: %s (grid %d)\n", hipGetErrorString(e), grid);
#endif
}
```

```cpp
#include <hip/hip_runtime.h>
#include <hip/hip_cooperative_groups.h>
#include <cstdio>
#include <cstdint>
#include <cmath>
namespace cg = cooperative_groups;
#ifndef MK_PER_PHASE
#define MK_PER_PHASE 0
#endif
namespace pg8 {
#define PG8_LAS __attribute__((address_space(3)))
typedef unsigned short bf16_t;
typedef short bf16x8 __attribute__((ext_vector_type(8)));
typedef float f32x4 __attribute__((ext_vector_type(4)));
typedef unsigned u32x4 __attribute__((ext_vector_type(4)));
typedef int i32x4 __attribute__((ext_vector_type(4)));
constexpr int BM = 256, BK = 64, HALF = 128, HTB = HALF * BK * 2  , STAGE_BYTES = 8 * HTB, NXCD = 8, WGM = 8;

__host__ __device__ __forceinline__ int lds_byte(int r, int c) { const int st = (r >> 4) * 2 + (c >> 5), rr = r & 15, cc = c & 31, ob = rr * 64 + cc * 2; return st * 1024 + (ob ^ (((ob >> 9) & 1) << 5)); }
__host__ __device__ __forceinline__ void stage_rc(int b, int& R, int& C) { const int st = b / 1024, sb = b % 1024, swz = sb ^ (((sb >> 9) & 1) << 5); R = (st >> 1) * 16 + swz / 64; C = (st & 1) * 32 + (swz % 64) / 2; }
__host__ __device__ __forceinline__ int perm32(int rho) { const int n = rho >> 4, i = rho & 15; return 8 * (i >> 2) + 4 * n + (i & 3); }

struct Unit { int pm, pn; };
struct Gemm { const bf16_t* A; const bf16_t* Bt; int M, N, K; int bdil; };
__device__ __forceinline__ size_t b_tile_off(const Gemm& g, int pn, int K2) { const int t8 = pn & 7; const int r = (pn >> 3) * 2048 + (g.bdil == 1 ? 256 * t8 : (g.bdil == 4 ? 1024 * (t8 & 1) + (t8 >> 1) : 2 * t8)); return (size_t)r * K2 * 2; }

struct StaticOrder {
    int nM, nN, nwg, G, c;
    __host__ __device__ void init(int M, int N, int G_, int c_) { nM = M / BM; nN = N / BM; nwg = nM * nN; G = G_; c = c_; }
    __host__ __device__ bool next(int i, Unit& u) const {
        const long L = (long)i * G + c; if (L >= nwg) return false;
        int wgid = (int)L; { const int q = nwg / NXCD, r = nwg % NXCD, xcd = wgid % NXCD, off = wgid / NXCD; wgid = (xcd < r ? xcd * (q + 1) : r * (q + 1) + (xcd - r) * q) + off; }
        const int nig = WGM * nN, gid = wgid / nig, fm = gid * WGM, gsz = (nM - fm) < WGM ? (nM - fm) : WGM;
        u.pm = fm + ((wgid % nig) % gsz); u.pn = (wgid % nig) / gsz; return true;
    }
    __device__ __forceinline__ void a_ready(const Unit&) const {}
    __device__ __forceinline__ void done(const Unit&) const {}
};

__device__ __forceinline__ unsigned cvt_pk_bf16(float lo, float hi) { unsigned r; asm volatile("v_cvt_pk_bf16_f32 %0, %1, %2" : "=v"(r) : "v"(lo), "v"(hi)); return r; }
typedef float f32x2 __attribute__((ext_vector_type(2)));
__device__ __forceinline__ f32x2 gelu_pk(f32x2 v) {
    const f32x2 av = __builtin_elementwise_abs(v), d = av * 0.2316418882f + 1.0f;
    f32x2 t; t.x = __builtin_amdgcn_rcpf(d.x); t.y = __builtin_amdgcn_rcpf(d.y);
    f32x2 q = t * 0.5307027145f + (-0.7265760135f); q = q * t + 0.7107068705f; q = q * t + (-0.142248368f); q = q * t + 0.127414796f; q = q * t;
    const f32x2 s = (v * v) * (-0.72134752044f);
    f32x2 e; e.x = __builtin_amdgcn_exp2f(s.x); e.y = __builtin_amdgcn_exp2f(s.y);
    const f32x2 m = v * (q * e), r = v - m;
    f32x2 o; o.x = v.x < 0.f ? m.x : r.x; o.y = v.y < 0.f ? m.y : r.y; return o;
}

constexpr float C2 = 0.08838834764831845f * 1.4426950408889634f;
__device__ __forceinline__ float silu_f(float x) { return x * __builtin_amdgcn_rcpf(1.0f + __builtin_amdgcn_exp2f(-1.4426950408889634f * x)); }
__device__ __forceinline__ u32x4 pack8(const f32x4& v0, const f32x4& v1) { u32x4 w; w.x = cvt_pk_bf16(v0[0], v0[1]); w.y = cvt_pk_bf16(v0[2], v0[3]); w.z = cvt_pk_bf16(v1[0], v1[1]); w.w = cvt_pk_bf16(v1[2], v1[3]); return w; }
__device__ __forceinline__ void gelu8(f32x4& v0, f32x4& v1) { f32x2 a = gelu_pk((f32x2){v0[0], v0[1]}), b = gelu_pk((f32x2){v0[2], v0[3]}), c = gelu_pk((f32x2){v1[0], v1[1]}), d = gelu_pk((f32x2){v1[2], v1[3]});
    v0 = (f32x4){a.x, a.y, b.x, b.y}; v1 = (f32x4){c.x, c.y, d.x, d.y}; }

struct EpiA1 {
    static constexpr bool PERM = true, AFTER_DRAIN = false;
    bf16_t* QK; bf16_t* GATE; const float* COS; const float* SIN; float osc;
    __device__ __forceinline__ void operator()(const f32x4 (&acc)[2][2][4][2], const Unit& u, int wr, int wc, int fr, int fq) const {
        const int pn = u.pn; const int rowb = u.pm * BM + wr * 64 + fr;
        if (pn >= 48) {
            const int col0 = (pn - 48) * 256 + wc * 32 + 8 * fq;
#pragma unroll
            for (int ai = 0; ai < 2; ++ai)
#pragma unroll
                for (int m = 0; m < 4; ++m) { bf16_t* rowp = GATE + (size_t)(rowb + ai * HALF + m * 16) * 2048 + col0;
#pragma unroll
                    for (int bj = 0; bj < 2; ++bj) { f32x4 v0 = acc[ai][bj][m][0] * osc, v1 = acc[ai][bj][m][1] * osc;
#pragma unroll
                        for (int i = 0; i < 4; ++i) { v0[i] = silu_f(v0[i]); v1[i] = silu_f(v1[i]); }
                        *(u32x4*)(rowp + bj * HALF) = pack8(v0, v1); } }
        } else {
            const int g = pn >> 4, qk = (pn >> 3) & 1, hp = pn & 7, dsh = 2 * g, dm1 = (1 << dsh) - 1;
            const float sc = (qk == 0 ? C2 : 1.0f) * osc; const float sgn = fq < 2 ? -1.0f : 1.0f; const int e0 = wc * 32 + 8 * fq;
#pragma unroll
            for (int ai = 0; ai < 2; ++ai)
#pragma unroll
                for (int m = 0; m < 4; ++m) { const int row = rowb + ai * HALF + m * 16, b = row >> 11, s = row & 2047, p = ((s & dm1) << (11 - dsh)) | (s >> dsh);
                    f32x4 c0, c1, s0, s1;
                    if (wc == 0) { const float* cp = COS + (size_t)row * 16 + 8 * (fq & 1); const float* sp = SIN + (size_t)row * 16 + 8 * (fq & 1);
                        c0 = *(const f32x4*)cp; c1 = *(const f32x4*)(cp + 4); s0 = *(const f32x4*)sp; s1 = *(const f32x4*)(sp + 4); }
#pragma unroll
                    for (int bj = 0; bj < 2; ++bj) { f32x4 v0 = acc[ai][bj][m][0], v1 = acc[ai][bj][m][1];
                        if (wc == 0) {
#pragma unroll
                            for (int i = 0; i < 4; ++i) { const float p0 = __shfl_xor(v0[i], 32), p1 = __shfl_xor(v1[i], 32);
                                v0[i] = v0[i] * c0[i] + sgn * p0 * s0[i]; v1[i] = v1[i] * c1[i] + sgn * p1 * s1[i]; } }
                        v0 = v0 * sc; v1 = v1 * sc;
                        bf16_t* dst = QK + ((((size_t)((g * 2 + qk) * 4 + b) * 16 + (2 * hp + bj)) * 2048 + p) * 128 + e0);
                        *(u32x4*)dst = pack8(v0, v1); } }
        }
    }
};
struct EpiB1 {
    static constexpr bool PERM = true, AFTER_DRAIN = false;
    bf16_t* U; bf16_t* ZS;
    __device__ __forceinline__ void operator()(const f32x4 (&acc)[2][2][4][2], const Unit& u, int wr, int wc, int fr, int fq) const {
        const int pn = u.pn; const int rowb = u.pm * BM + wr * 64 + fr; const bool isz = pn >= 8;
        bf16_t* base = isz ? ZS : U; const int col0 = (pn & 7) * 256 + wc * 32 + 8 * fq;
#pragma unroll
        for (int ai = 0; ai < 2; ++ai)
#pragma unroll
            for (int m = 0; m < 4; ++m) { bf16_t* rowp = base + (size_t)(rowb + ai * HALF + m * 16) * 2048 + col0;
#pragma unroll
                for (int bj = 0; bj < 2; ++bj) { f32x4 v0 = acc[ai][bj][m][0], v1 = acc[ai][bj][m][1];
                    if (isz) {
#pragma unroll
                        for (int i = 0; i < 4; ++i) { v0[i] = silu_f(v0[i]); v1[i] = silu_f(v1[i]); }
                    } else gelu8(v0, v1);
                    *(u32x4*)(rowp + bj * HALF) = pack8(v0, v1); } }
    }
};
struct EpiPlain {
    static constexpr bool PERM = true, AFTER_DRAIN = false;
    bf16_t* O; float osc;
    __device__ __forceinline__ void operator()(const f32x4 (&acc)[2][2][4][2], const Unit& u, int wr, int wc, int fr, int fq) const {
        const int rowb = u.pm * BM + wr * 64 + fr; const int col0 = u.pn * BM + wc * 32 + 8 * fq;
#pragma unroll
        for (int ai = 0; ai < 2; ++ai)
#pragma unroll
            for (int m = 0; m < 4; ++m) { bf16_t* rowp = O + (size_t)(col0 >> 5) * 65536 + (size_t)(rowb + ai * HALF + m * 16) * 32 + (col0 & 31);
#pragma unroll
                for (int bj = 0; bj < 2; ++bj) *(u32x4*)(rowp + bj * 4 * 65536) = pack8(acc[ai][bj][m][0] * osc, acc[ai][bj][m][1] * osc); }
    }
};
struct EpiB2 {
    static constexpr bool PERM = true, AFTER_DRAIN = false;
    bf16_t* VT; float* STATS;
    __device__ __forceinline__ void operator()(const f32x4 (&acc)[2][2][4][2], const Unit& u, int wr, int wc, int fr, int fq) const {
        const int rowb = u.pm * BM + wr * 64 + fr; const int col0 = u.pn * BM + wc * 32 + 8 * fq;
        float s1[2][8], s2[2][8];
#pragma unroll
        for (int bj = 0; bj < 2; ++bj)
#pragma unroll
            for (int k = 0; k < 8; ++k) { s1[bj][k] = 0.f; s2[bj][k] = 0.f; }
#pragma unroll
        for (int ai = 0; ai < 2; ++ai)
#pragma unroll
            for (int m = 0; m < 4; ++m) { bf16_t* rowp = VT + (size_t)(col0 >> 5) * 65536 + (size_t)(rowb + ai * HALF + m * 16) * 32 + (col0 & 31);
#pragma unroll
                for (int bj = 0; bj < 2; ++bj) { f32x4 v0 = acc[ai][bj][m][0], v1 = acc[ai][bj][m][1]; gelu8(v0, v1);
#pragma unroll
                    for (int i = 0; i < 4; ++i) { s1[bj][i] += v0[i]; s2[bj][i] += v0[i] * v0[i]; s1[bj][4 + i] += v1[i]; s2[bj][4 + i] += v1[i] * v1[i]; }
                    *(u32x4*)(rowp + bj * 4 * 65536) = pack8(v0, v1); } }
#pragma unroll
        for (int bj = 0; bj < 2; ++bj)
#pragma unroll
            for (int k = 0; k < 8; ++k) {
#pragma unroll
                for (int o = 1; o < 16; o <<= 1) { s1[bj][k] += __shfl_xor(s1[bj][k], o); s2[bj][k] += __shfl_xor(s2[bj][k], o); }
                if (fr == 0) { float* sp = STATS + 2 * (size_t)(col0 + bj * HALF + k); atomicAdd(sp, s1[bj][k]); atomicAdd(sp + 1, s2[bj][k]); } }
    }
};
struct EpiOut {
    static constexpr bool PERM = false, AFTER_DRAIN = false;
    const float* base; float* out;
    __device__ __forceinline__ void operator()(const f32x4 (&acc)[2][2][4][2], const Unit& u, int wr, int wc, int fr, int fq) const {
        const int rowb = u.pm * BM + wr * 64 + fr; const int col0 = u.pn * BM + wc * 32 + 4 * fq;
#pragma unroll
        for (int ai = 0; ai < 2; ++ai)
#pragma unroll
            for (int m = 0; m < 4; ++m) { const size_t off = (size_t)(rowb + ai * HALF + m * 16) * 2048 + col0;
#pragma unroll
                for (int bj = 0; bj < 2; ++bj)
#pragma unroll
                    for (int n = 0; n < 2; ++n) { const f32x4 bs = *(const f32x4*)(base + off + bj * HALF + n * 16); *(f32x4*)(out + off + bj * HALF + n * 16) = bs + acc[ai][bj][m][n]; } }
    }
};
template <class Epi, class Sched, bool ALIGN_EPI = false, bool SP2 = false, bool F8 = false>
__device__ __forceinline__ void gemm_phase(PG8_LAS unsigned char* lds, const Gemm g, const Sched& S, const Epi& E) {
    int tid = threadIdx.x; asm volatile("" : "+v"(tid)); const int wid = __builtin_amdgcn_readfirstlane(tid >> 6), lane = tid & 63, wr = wid >> 2, wc = wid & 3, fr = lane & 15, fq = lane >> 4;
    const int K = F8 ? g.K / 2 : g.K, nt = K / BK;
    unsigned voffA[2], voffB[2];
#pragma unroll
    for (int i = 0; i < 2; ++i) { int R, C; stage_rc(tid * 16 + i * 8192, R, C); const int Rb = Epi::PERM ? ((R & ~31) + perm32(R & 31)) : R;
        voffA[i] = (unsigned)(R * K + C) * 2u; voffB[i] = (unsigned)(Rb * g.bdil * K + C) * 2u; }
    const size_t kstep = (size_t)(BK * 2);
    const size_t hstep = (size_t)HALF * K * 2;
    const size_t tstep = 2 * hstep;
    const size_t hstepB = (g.bdil == 16) ? (size_t)K * 2 : (size_t)HALF * g.bdil * K * 2;
    const unsigned ldsw = (unsigned)wid * 1024u;
    const int aoff = lds_byte(wr * 64 + fr, fq * 8), boff = lds_byte(wc * 32 + fr, fq * 8);
#define PG8_SA(b, h) (((b) * 2 + (h)) * HTB)
#define PG8_SB(b, h) ((4 + (b) * 2 + (h)) * HTB)
#define PG8_STAGE(bufoff, gbase, voff) do { _Pragma("unroll") for (int _i = 0; _i < 2; ++_i) \
        __builtin_amdgcn_global_load_lds((const unsigned*)((const char*)(gbase) + (voff)[_i]), (PG8_LAS unsigned*)(lds + (bufoff) + ldsw + _i * 8192), 16, 0, 0); } while (0)
#define PG8_LDA(dst, b, h) do { _Pragma("unroll") for (int m = 0; m < 4; ++m) _Pragma("unroll") for (int k = 0; k < 2; ++k) dst[m][k] = *(const PG8_LAS bf16x8*)(lds + PG8_SA(b, h) + aoff + m * 2048 + k * 1024); } while (0)
#define PG8_LDB(dst, b, h) do { _Pragma("unroll") for (int n = 0; n < 2; ++n) _Pragma("unroll") for (int k = 0; k < 2; ++k) dst[n][k] = *(const PG8_LAS bf16x8*)(lds + PG8_SB(b, h) + boff + n * 2048 + k * 1024); } while (0)
#define PG8_CAT8(x) __builtin_shufflevector(__builtin_bit_cast(i32x4, (x)[0]), __builtin_bit_cast(i32x4, (x)[1]), 0, 1, 2, 3, 4, 5, 6, 7)
#define PG8_MMA(ai, bj, At, Bt) do { __builtin_amdgcn_s_setprio(1); \
        if constexpr (F8) { _Pragma("unroll") for (int m = 0; m < 4; ++m) _Pragma("unroll") for (int n = 0; n < 2; ++n) \
            asm volatile("v_mfma_f32_16x16x128_f8f6f4 %0, %1, %2, %0" : "+v"(acc[ai][bj][m][n]) : "v"(PG8_CAT8(Bt[n])), "v"(PG8_CAT8(At[m]))); } \
        else { _Pragma("unroll") for (int m = 0; m < 4; ++m) _Pragma("unroll") for (int n = 0; n < 2; ++n) _Pragma("unroll") for (int k = 0; k < 2; ++k) \
            acc[ai][bj][m][n] = __builtin_amdgcn_mfma_f32_16x16x32_bf16(Bt[n][k], At[m][k], acc[ai][bj][m][n], 0, 0, 0); } \
        __builtin_amdgcn_s_setprio(0); } while (0)
#define PG8_WAIT_V(n) asm volatile("s_waitcnt vmcnt(" #n ")" ::: "memory")
#define PG8_WAIT_L(n) asm volatile("s_waitcnt lgkmcnt(" #n ")" ::: "memory")
#define PG8_BAR __builtin_amdgcn_s_barrier()
#define PG8_SCHED __builtin_amdgcn_sched_barrier(0)
    Unit cur, nxt; int ui = 0;
    if (!S.next(0, cur)) return;
    f32x4 acc[2][2][4][2];
#pragma unroll
    for (int a = 0; a < 2; ++a)
#pragma unroll
        for (int b = 0; b < 2; ++b)
#pragma unroll
            for (int m = 0; m < 4; ++m)
#pragma unroll
                for (int n = 0; n < 2; ++n) acc[a][b][m][n] = (f32x4){0.f, 0.f, 0.f, 0.f};
    bf16x8 At[4][2], B0[2][2], B1[2][2];
    const char* cA = (const char*)g.A + (size_t)cur.pm * tstep; const char* cB = (const char*)g.Bt + b_tile_off(g, cur.pn, K);
    S.a_ready(cur);
    if constexpr (SP2) {
        PG8_STAGE(PG8_SB(0, 0), cB, voffB); PG8_STAGE(PG8_SB(0, 1), cB + hstepB, voffB); PG8_STAGE(PG8_SA(0, 0), cA, voffA); PG8_STAGE(PG8_SA(0, 1), cA + hstep, voffA);
        if (wr == 1) PG8_BAR;
        PG8_WAIT_V(2); PG8_BAR;
        PG8_STAGE(PG8_SB(1, 0), cB + kstep, voffB); PG8_STAGE(PG8_SA(1, 0), cA + kstep, voffA); PG8_STAGE(PG8_SB(1, 1), cB + hstepB + kstep, voffB);
        PG8_WAIT_V(6); PG8_BAR;
    } else {
        PG8_STAGE(PG8_SB(0, 0), cB, voffB); PG8_STAGE(PG8_SA(0, 0), cA, voffA); PG8_STAGE(PG8_SB(0, 1), cB + hstepB, voffB); PG8_STAGE(PG8_SA(0, 1), cA + hstep, voffA);
        if (wr == 1) PG8_BAR;
        PG8_WAIT_V(4); PG8_BAR;
        PG8_STAGE(PG8_SB(1, 0), cB + kstep, voffB); PG8_STAGE(PG8_SA(1, 0), cA + kstep, voffA); PG8_STAGE(PG8_SB(1, 1), cB + hstepB + kstep, voffB);
        PG8_WAIT_V(6); PG8_BAR;
    }
    for (;;) {
        const bool has_next = S.next(ui + 1, nxt);
        const char* nA = has_next ? (const char*)g.A + (size_t)nxt.pm * tstep : cA; const char* nB = has_next ? (const char*)g.Bt + b_tile_off(g, nxt.pn, K) : cB;
        for (int t = 0; t < nt; t += 2) {
            const bool last = (t == nt - 2);
            const char* a1 = cA + (size_t)(t + 1) * kstep;
            const char* a2 = last ? nA : cA + (size_t)(t + 2) * kstep; const char* b2 = last ? nB : cB + (size_t)(t + 2) * kstep;
            const char* a3 = a2 + kstep; const char* b3 = b2 + kstep;
            if (last && has_next) S.a_ready(nxt);
            if constexpr (SP2) {
            PG8_LDB(B0, 0, 0); PG8_LDB(B1, 0, 1); PG8_SCHED; PG8_LDA(At, 0, 0); PG8_STAGE(PG8_SA(1, 1), a1 + hstep, voffA);
            PG8_WAIT_V(8); PG8_WAIT_L(0); PG8_BAR; PG8_MMA(0, 0, At, B0); PG8_MMA(0, 1, At, B1); PG8_BAR; PG8_SCHED;
            PG8_LDA(At, 0, 1); PG8_STAGE(PG8_SB(0, 0), b2, voffB); PG8_STAGE(PG8_SB(0, 1), b2 + hstepB, voffB); PG8_STAGE(PG8_SA(0, 0), a2, voffA);
            PG8_WAIT_V(8); PG8_WAIT_L(0); PG8_BAR; PG8_MMA(1, 0, At, B0); PG8_MMA(1, 1, At, B1); PG8_BAR; PG8_SCHED;
            PG8_LDB(B0, 1, 0); PG8_LDB(B1, 1, 1); PG8_SCHED; PG8_LDA(At, 1, 0); PG8_STAGE(PG8_SA(0, 1), a2 + hstep, voffA);
            PG8_WAIT_V(8); PG8_WAIT_L(0); PG8_BAR; PG8_MMA(0, 0, At, B0); PG8_MMA(0, 1, At, B1); PG8_BAR; PG8_SCHED;
            PG8_LDA(At, 1, 1); PG8_STAGE(PG8_SB(1, 0), b3, voffB); PG8_STAGE(PG8_SB(1, 1), b3 + hstepB, voffB); PG8_STAGE(PG8_SA(1, 0), a3, voffA);
            PG8_WAIT_V(8); PG8_WAIT_L(0); PG8_BAR; PG8_MMA(1, 0, At, B0); PG8_MMA(1, 1, At, B1); PG8_BAR; PG8_SCHED;
            } else {
            PG8_LDB(B0, 0, 0); PG8_SCHED; PG8_LDA(At, 0, 0); PG8_STAGE(PG8_SA(1, 1), a1 + hstep, voffA);
            PG8_WAIT_L(8); PG8_BAR; PG8_WAIT_L(0); PG8_MMA(0, 0, At, B0); PG8_BAR; PG8_SCHED;
            PG8_LDB(B1, 0, 1); PG8_STAGE(PG8_SB(0, 0), b2, voffB);
            PG8_BAR; PG8_WAIT_L(0); PG8_MMA(0, 1, At, B1); PG8_BAR;
            PG8_LDA(At, 0, 1); PG8_STAGE(PG8_SA(0, 0), a2, voffA);
            PG8_BAR; PG8_WAIT_L(0); PG8_MMA(1, 0, At, B0); PG8_BAR; PG8_SCHED;
            PG8_STAGE(PG8_SB(0, 1), b2 + hstepB, voffB);
            PG8_WAIT_V(6); PG8_BAR; PG8_MMA(1, 1, At, B1); PG8_BAR;
            PG8_LDB(B0, 1, 0); PG8_SCHED; PG8_LDA(At, 1, 0); PG8_STAGE(PG8_SA(0, 1), a2 + hstep, voffA);
            PG8_WAIT_L(8); PG8_BAR; PG8_WAIT_L(0); PG8_MMA(0, 0, At, B0); PG8_BAR; PG8_SCHED;
            PG8_LDB(B1, 1, 1); PG8_STAGE(PG8_SB(1, 0), b3, voffB);
            PG8_BAR; PG8_WAIT_L(0); PG8_MMA(0, 1, At, B1); PG8_BAR;
            PG8_LDA(At, 1, 1); PG8_STAGE(PG8_SA(1, 0), a3, voffA);
            PG8_BAR; PG8_WAIT_L(0); PG8_MMA(1, 0, At, B0); PG8_BAR; PG8_SCHED;
            PG8_STAGE(PG8_SB(1, 1), b3 + hstepB, voffB);
            PG8_WAIT_V(6); PG8_BAR; PG8_MMA(1, 1, At, B1); PG8_BAR;
            }
        }
        if constexpr (F8) asm volatile("s_nop 15\n\ts_nop 15" ::: "memory");
        if constexpr (ALIGN_EPI) { if (wr == 0) PG8_BAR; }
        if constexpr (!Epi::AFTER_DRAIN) { E(acc, cur, wr, wc, fr, fq); S.done(cur); }
        if (!has_next) break;
#pragma unroll
        for (int a = 0; a < 2; ++a)
#pragma unroll
            for (int b = 0; b < 2; ++b)
#pragma unroll
                for (int m = 0; m < 4; ++m)
#pragma unroll
                    for (int n = 0; n < 2; ++n) acc[a][b][m][n] = (f32x4){0.f, 0.f, 0.f, 0.f};
        cur = nxt; cA = nA; cB = nB; ++ui;
        if constexpr (ALIGN_EPI) { if (wr == 1) PG8_BAR; }
    }
    PG8_WAIT_V(0);
    if constexpr (!ALIGN_EPI) { if (wr == 0) PG8_BAR; }
    PG8_BAR;
    if constexpr (Epi::AFTER_DRAIN) { E.fused(acc, cur, wr, wc, fr, fq, lds, wid, lane); S.done(cur); }
#undef PG8_SA
#undef PG8_SB
#undef PG8_STAGE
#undef PG8_LDA
#undef PG8_LDB
#undef PG8_MMA
#undef PG8_CAT8
#undef PG8_WAIT_V
#undef PG8_WAIT_L
#undef PG8_BAR
#undef PG8_SCHED
}
}

constexpr int NWAVES = 8, NTHR = NWAVES * 64;
constexpr int BATCH = 4, SEQ = 2048, DM = 2048, MTOK = BATCH * SEQ;
constexpr int A_IN = 20480, B_IN = 6144, NA1 = 14336;
constexpr float RMS_EPS = 1e-6f, LN_EPS = 1e-5f;
constexpr size_t MiB = 1u << 20;
constexpr size_t SZ_ACT = (size_t)MTOK * DM * 2;
constexpr size_t WS_WAIN = 2 * MiB;
constexpr size_t WS_WAOUT = WS_WAIN + 2 * (size_t)A_IN * DM * 2;
constexpr size_t WS_WBIN = WS_WAOUT + 2 * (size_t)DM * DM * 2;
constexpr size_t WS_WBOUT = WS_WBIN + 2 * (size_t)B_IN * DM * 2;
constexpr size_t WS_WM = WS_WBOUT + 2 * (size_t)DM * DM * 2;
constexpr size_t WS_COS = WS_WM + 2 * 16 * 128 * 128 * 2;
constexpr size_t WS_SIN = WS_COS + (size_t)MTOK * 16 * 4;
constexpr size_t WS_STATS = WS_SIN + (size_t)MTOK * 16 * 4;
constexpr size_t WS_LSE = WS_STATS + 2 * (size_t)MTOK * 2 * 4;
constexpr size_t WS_X = WS_LSE + 3 * (size_t)MTOK * 16 * 4;
constexpr size_t WS_XN = WS_X + 2 * SZ_ACT;
constexpr size_t WS_QK = WS_XN + SZ_ACT;
constexpr size_t WS_VT = WS_QK + 6 * SZ_ACT;
constexpr size_t WS_GATE = WS_VT + 3 * SZ_ACT;
constexpr size_t WS_OG = WS_GATE + SZ_ACT;
constexpr size_t WS_Y = WS_OG + 3 * SZ_ACT;
constexpr size_t WS_END = WS_Y + SZ_ACT;
constexpr size_t WS_BAR = 65536;
constexpr int LDS_BYTES = 147456;

typedef unsigned short bf16;
typedef unsigned v4u __attribute__((ext_vector_type(4)));
typedef unsigned v2u __attribute__((ext_vector_type(2)));
typedef float f32x4 __attribute__((ext_vector_type(4)));
typedef float f32x2v __attribute__((ext_vector_type(2)));
typedef float f32x16 __attribute__((ext_vector_type(16)));
typedef short bf16x8 __attribute__((ext_vector_type(8)));
typedef __bf16 bf16x2_t __attribute__((ext_vector_type(2)));
#define LAS __attribute__((address_space(3)))
#define MFMA32(a, b, c) __builtin_amdgcn_mfma_f32_32x32x16_bf16((a), (b), (c), 0, 0, 0)
__device__ __forceinline__ unsigned pk2(float lo, float hi) { f32x2v v = {lo, hi}; bf16x2_t b = __builtin_convertvector(v, bf16x2_t); return __builtin_bit_cast(unsigned, b); }
__device__ __forceinline__ float bflo(unsigned w) { return __builtin_bit_cast(float, w << 16); }
__device__ __forceinline__ float bfhi(unsigned w) { return __builtin_bit_cast(float, w & 0xffff0000u); }
__device__ __forceinline__ float wave_sum(float v) {
#pragma unroll
    for (int o = 1; o < 64; o <<= 1) v += __shfl_xor(v, o);
    return v;
}

#define XB_TMO      128
#define XB_XCNT(j)  (256  + 64 * (j))
#define XB_XSUB(j)  (1280 + 64 * (j))
#define XB_XGEN(j)  (2304 + 64 * (j))
#define XB_TOP      3328
#define XB_TOPGEN   3392
#define XCD_BAR_WORDS 3456
#define XB_SPIN_CAP (1u << 18)

__device__ __forceinline__ unsigned xb_ld(unsigned* p)              { return __hip_atomic_load(p, __ATOMIC_RELAXED, __HIP_MEMORY_SCOPE_AGENT); }
__device__ __forceinline__ unsigned xb_add(unsigned* p, unsigned v) { return __hip_atomic_fetch_add(p, v, __ATOMIC_RELAXED, __HIP_MEMORY_SCOPE_AGENT); }
__device__ __forceinline__ unsigned xb_xcc_id() { return (unsigned)__builtin_amdgcn_s_getreg((3 << 11) | 20) & 0xFu; }
#define XB_SPIN(cond, bar) do { unsigned _sp = 0; while (cond) { __builtin_amdgcn_s_sleep(1); \
    if ((++_sp & 255u) == 0u) { if (xb_ld(&(bar)[XB_TMO])) break; if (_sp > XB_SPIN_CAP) { atomicAdd(&(bar)[XB_TMO], 1u); break; } } } } while (0)

struct XcdBarrier {
    unsigned* bar; unsigned x;
    volatile LAS unsigned* st;
};

__device__ __forceinline__ XcdBarrier xcd_barrier_post(unsigned* bar, volatile LAS unsigned* st) {
    XcdBarrier b; b.bar = bar; b.x = xb_xcc_id(); b.st = st;
    if (threadIdx.x == 0) (void)xb_add(&bar[XB_XCNT(b.x)], 1u);
    return b;
}
__device__ __forceinline__ void xcd_barrier_complete(unsigned* bar, unsigned x, unsigned& nloc, unsigned& nx) {
    const unsigned G = gridDim.x * gridDim.y * gridDim.z;
    unsigned sum, cnt, mine, sp = 0u;
    for (;;) {
        sum = 0u; cnt = 0u; mine = 0u;
#pragma unroll
        for (unsigned j = 0; j < 16; ++j) { const unsigned c = xb_ld(&bar[XB_XCNT(j)]); sum += c; cnt += (c > 0u) ? 1u : 0u; mine = (j == x) ? c : mine; }
        if (sum == G) break;
        __builtin_amdgcn_s_sleep(1);
        if ((++sp & 255u) == 0u) { if (xb_ld(&bar[XB_TMO])) break; if (sp > XB_SPIN_CAP) { atomicAdd(&bar[XB_TMO], 1u); break; } }
    }
    nloc = mine > 0u ? mine : 1u; nx = cnt > 0u ? cnt : 1u;
}

__device__ __forceinline__ void xcd_barrier(const XcdBarrier& b) {
    asm volatile("s_waitcnt vmcnt(0)" ::: "memory");
    __syncthreads();
    if (threadIdx.x == 0) {
        unsigned* bar = b.bar;
        __builtin_amdgcn_s_waitcnt(0);
        unsigned nloc = b.st[0], nx = b.st[1];
        if (nloc == 0u) { xcd_barrier_complete(bar, b.x, nloc, nx); b.st[0] = nloc; b.st[1] = nx; }
        const unsigned old = xb_add(&bar[XB_XSUB(b.x)], 1u);
        const unsigned gen = old / nloc;
        if (old + 1u == (gen + 1u) * nloc) {
            __builtin_amdgcn_fence(__ATOMIC_RELEASE, "agent");
            asm volatile("s_waitcnt vmcnt(0)" ::: "memory");
            const unsigned og = xb_add(&bar[XB_TOP], 1u);
            const unsigned tg = og / nx;
            if (og + 1u == (tg + 1u) * nx) xb_add(&bar[XB_TOPGEN], 1u);
            else XB_SPIN(xb_ld(&bar[XB_TOPGEN]) == tg, bar);
            __builtin_amdgcn_fence(__ATOMIC_ACQUIRE, "agent");
            xb_add(&bar[XB_XGEN(b.x)], 1u);
            asm volatile("s_waitcnt vmcnt(0)" ::: "memory");
        } else {
            XB_SPIN(xb_ld(&bar[XB_XGEN(b.x)]) == gen, bar);
            __builtin_amdgcn_fence(__ATOMIC_ACQUIRE, "agent");
            asm volatile("s_waitcnt vmcnt(0)" ::: "memory");
        }
    }
    __syncthreads();
}

__device__ __forceinline__ int launder(int v) { asm volatile("" : "+v"(v)); return v; }
struct Args {
    const float* x; const int* pos; const float* a_norm_g; const float* a_w_in; const float* a_w_out; const float* b_norm_g; const float* b_w_in;
    const float* b_ln_g; const float* b_ln_b; const float* b_w_s; const float* b_b_s; const float* b_w_out; const float* final_g;
    float* out; unsigned char* ws; double invf[16];
    int ph_lo, ph_hi;
};

__device__ __forceinline__ void p0_transpose_item(const float* W, int K, int N, bf16* WT, int row_off, LAS float* scr, int kb, int nb, int lane) {
    const int k0 = 64 * kb, n0 = 32 * nb;
#pragma unroll 8
    for (int i = 0; i < 32; ++i) { const int kk = 2 * i + (lane >> 5); scr[kk * 33 + (lane & 31)] = W[(size_t)(k0 + kk) * N + n0 + (lane & 31)]; }
    asm volatile("s_waitcnt lgkmcnt(0)" ::: "memory");
    const int c = lane & 7;
#pragma unroll
    for (int j = 0; j < 4; ++j) { const int n = (lane >> 3) + 8 * j; const LAS float* s = scr + (8 * c) * 33 + n;
        v4u o; o.x = pk2(s[0 * 33], s[1 * 33]); o.y = pk2(s[2 * 33], s[3 * 33]); o.z = pk2(s[4 * 33], s[5 * 33]); o.w = pk2(s[6 * 33], s[7 * 33]);
        *(v4u*)(WT + (size_t)(row_off + n0 + n) * K + k0 + 8 * c) = o; }
    asm volatile("s_waitcnt lgkmcnt(0)" ::: "memory");
}
constexpr float W8_SCALE = 32.0f;
__device__ __forceinline__ unsigned pk4_fp8(float a, float b, float c, float d) {
    a = fminf(fmaxf(a, -448.f), 448.f); b = fminf(fmaxf(b, -448.f), 448.f); c = fminf(fmaxf(c, -448.f), 448.f); d = fminf(fmaxf(d, -448.f), 448.f);
    int w = 0; w = __builtin_amdgcn_cvt_pk_fp8_f32(a, b, w, false); w = __builtin_amdgcn_cvt_pk_fp8_f32(c, d, w, true); return (unsigned)w; }
__device__ __forceinline__ void p0_transpose_item_f8(const float* W, int K, int N, unsigned char* WT, int row_off, LAS float* scr, int kb, int nb, int lane) {
    const int k0 = 64 * kb, n0 = 32 * nb;
#pragma unroll 8
    for (int i = 0; i < 32; ++i) { const int kk = 2 * i + (lane >> 5); scr[kk * 33 + (lane & 31)] = W[(size_t)(k0 + kk) * N + n0 + (lane & 31)] * W8_SCALE; }
    asm volatile("s_waitcnt lgkmcnt(0)" ::: "memory");
    const int c = lane & 7;
#pragma unroll
    for (int j = 0; j < 4; ++j) { const int n = (lane >> 3) + 8 * j; const LAS float* s = scr + (8 * c) * 33 + n;
        v2u o; o.x = pk4_fp8(s[0 * 33], s[1 * 33], s[2 * 33], s[3 * 33]); o.y = pk4_fp8(s[4 * 33], s[5 * 33], s[6 * 33], s[7 * 33]);
        *(v2u*)(WT + (size_t)(row_off + n0 + n) * K + k0 + 8 * c) = o; }
    asm volatile("s_waitcnt lgkmcnt(0)" ::: "memory");
}
template <int MODE  > __device__ __forceinline__ void rms_row(const float* xrow, const float* g, void* orow, int lane) {
    const f32x4* xr = (const f32x4*)xrow + lane; const f32x4* gr = (const f32x4*)g + lane;
    f32x4 v[8]; float s = 0.f;
#pragma unroll
    for (int j = 0; j < 8; ++j) { v[j] = xr[64 * j]; s += (v[j].x * v[j].x + v[j].y * v[j].y) + (v[j].z * v[j].z + v[j].w * v[j].w); }
    const float rstd = 1.0f / sqrtf(wave_sum(s) * (1.0f / DM) + RMS_EPS);
#pragma unroll
    for (int j = 0; j < 8; ++j) { const f32x4 gg = gr[64 * j]; const f32x4 y = v[j] * rstd * gg;
        if (MODE == 1) ((f32x4*)orow + lane)[64 * j] = y;
        else if (MODE == 2) ((unsigned*)orow + lane)[64 * j] = pk4_fp8(y.x, y.y, y.z, y.w);
        else { v2u w; w.x = pk2(y.x, y.y); w.y = pk2(y.z, y.w); ((v2u*)orow + lane)[64 * j] = w; } }
}

struct AttnUnit { unsigned uq, uk, uv; int p0, t0; unsigned orow; };
__device__ __forceinline__ AttnUnit attn_decode(int wu) {
    AttnUnit u; const int g = wu >> 12, rest = wu & 4095, qw = rest & 3, blk = (rest >> 2) & 15, h = (rest >> 6) & 15, b = rest >> 10;
    const int dsh = 2 * g; const bool has_prev = (blk & ((16 >> dsh) - 1)) != 0;
    u.uq = __builtin_amdgcn_readfirstlane((unsigned)((((g * 2 + 0) * 4 + b) * 16 + h) * 2048 + blk * 128 + qw * 32) * 256u);
    u.uk = __builtin_amdgcn_readfirstlane((unsigned)((((g * 2 + 1) * 4 + b) * 16 + h) * 2048) * 256u);
    u.uv = __builtin_amdgcn_readfirstlane((unsigned)(g * 2048 * 8192 + b * 64 * 65536 + h * 128 * 32) * 2u);
    u.p0 = __builtin_amdgcn_readfirstlane(blk * 128 - 128 + qw * 32); u.t0 = __builtin_amdgcn_readfirstlane(has_prev ? 0 : 4 - qw);
    u.orow = __builtin_amdgcn_readfirstlane((unsigned)(((g * 4 + b) * 16 + h) * 2048 + blk * 128 + qw * 32));
    return u;
}
__device__ __forceinline__ void attn_phase(const bf16* QK, const bf16* VT, bf16* OG, float* LSE, int gw, int NGW, int lane, LAS unsigned char* wl) {
    const int q = lane & 31, hh = lane >> 5;
    const int kperm = (q & 0x13) | ((q & 4) << 1) | ((q & 8) >> 1);
    const unsigned lq = (unsigned)(q * 128 + 8 * hh) * 2u, lk = (unsigned)(kperm * 128 + 8 * hh) * 2u, lv = (unsigned)(q * 32 + 8 * hh) * 2u;
    const char* QKc = (const char*)QK; const char* VTc = (const char*)VT;
    LAS bf16x8* qs = (LAS bf16x8*)(wl + lane * 16);
    bf16x8 kf[8], vf[4][2], vn[4][2];
#define ATT_LDKV(U, P, VD) do { const char* kp_ = QKc + ((U).uk + (unsigned)(P) * 256u + lk); const char* vp_ = VTc + ((U).uv + (unsigned)((P) >> 5) * 131072u + lv); \
        _Pragma("unroll") for (int c = 0; c < 8; ++c) kf[c] = *(const bf16x8*)(kp_ + 32 * c); \
        _Pragma("unroll") for (int db = 0; db < 4; ++db) { VD[db][0] = *(const bf16x8*)(vp_ + db * 2048); VD[db][1] = *(const bf16x8*)(vp_ + db * 2048 + 32); } } while (0)
    for (int wu = gw; wu < 3 * 4096; wu += NGW) {
        const AttnUnit u = attn_decode(wu);
        { const char* qp_ = QKc + (u.uq + lq);
#pragma unroll
          for (int c = 0; c < 8; ++c) qs[c * 64] = *(const bf16x8*)(qp_ + 32 * c); }
        ATT_LDKV(u, u.p0 + 32 * u.t0, vf);
        f32x16 O[4];
#pragma unroll
        for (int db = 0; db < 4; ++db)
#pragma unroll
            for (int i = 0; i < 16; ++i) O[db][i] = 0.f;
        float m = -INFINITY, l = 0.f;
        for (int t = u.t0; t < 5; ++t) {
            const int p0 = u.p0 + 32 * t;
            f32x16 S;
#pragma unroll
            for (int i = 0; i < 16; ++i) S[i] = 0.f;
#pragma unroll
            for (int c = 0; c < 8; ++c) { const bf16x8 qv = qs[c * 64]; S = MFMA32(kf[c], qv, S); }
            __builtin_amdgcn_sched_barrier(0);
            if (t < 4) { ATT_LDKV(u, p0 + 32, vn); }
            __builtin_amdgcn_sched_barrier(0);
            if (t == 0) {
#pragma unroll
                for (int i = 0; i < 16; ++i) { const int kt = 16 * (i >> 3) + 8 * hh + (i & 7); if (kt < q) S[i] = -INFINITY; }
            }
            if (t == 4) {
#pragma unroll
                for (int i = 0; i < 16; ++i) { const int kt = 16 * (i >> 3) + 8 * hh + (i & 7); if (kt > q) S[i] = -INFINITY; }
            }
            float mx = S[0];
#pragma unroll
            for (int i = 1; i < 16; ++i) mx = fmaxf(mx, S[i]);
            mx = fmaxf(mx, __shfl_xor(mx, 32));
            const float mn = fmaxf(m, mx), alpha = __builtin_amdgcn_exp2f(m - mn);
            float rs = 0.f;
#pragma unroll
            for (int i = 0; i < 16; ++i) { S[i] = __builtin_amdgcn_exp2f(S[i] - mn); rs += S[i]; }
            l = l * alpha + rs; m = mn;
#pragma unroll
            for (int db = 0; db < 4; ++db)
#pragma unroll
                for (int i = 0; i < 16; ++i) O[db][i] *= alpha;
            v4u w0, w1;
            w0.x = pk2(S[0], S[1]); w0.y = pk2(S[2], S[3]); w0.z = pk2(S[4], S[5]); w0.w = pk2(S[6], S[7]);
            w1.x = pk2(S[8], S[9]); w1.y = pk2(S[10], S[11]); w1.z = pk2(S[12], S[13]); w1.w = pk2(S[14], S[15]);
            const bf16x8 ps0 = __builtin_bit_cast(bf16x8, w0), ps1 = __builtin_bit_cast(bf16x8, w1);
#pragma unroll
            for (int db = 0; db < 4; ++db) { O[db] = MFMA32(vf[db][0], ps0, O[db]); O[db] = MFMA32(vf[db][1], ps1, O[db]); }
            __builtin_amdgcn_sched_barrier(0);
            if (t < 4) {
#pragma unroll
                for (int db = 0; db < 4; ++db) { vf[db][0] = vn[db][0]; vf[db][1] = vn[db][1]; } }
        }
        l += __shfl_xor(l, 32);
        const float inv = 1.0f / l, lse2 = m + __builtin_amdgcn_logf(l);
        bf16* op = OG + (size_t)(u.orow + q) * 128 + 4 * hh;
#pragma unroll
        for (int db = 0; db < 4; ++db)
#pragma unroll
            for (int i4 = 0; i4 < 4; ++i4) { v2u w; w.x = pk2(O[db][4 * i4] * inv, O[db][4 * i4 + 1] * inv); w.y = pk2(O[db][4 * i4 + 2] * inv, O[db][4 * i4 + 3] * inv);
                *(v2u*)(op + db * 32 + 8 * i4) = w; }
        if (hh == 0) LSE[u.orow + q] = lse2;
    }
#undef ATT_LDKV
}
__device__ __forceinline__ void merge_phase(const bf16* OG, const float* LSE, const bf16* GATE, bf16* Y, int gw, int NGW, int lane) {
    for (int row = gw; row < MTOK; row += NGW) { const int b = row >> 11, s = row & 2047;
#pragma unroll
        for (int j = 0; j < 4; ++j) { const int col = lane * 8 + 512 * j, h = col >> 7, e = col & 127;
            size_t r[3]; float lg[3];
#pragma unroll
            for (int g = 0; g < 3; ++g) { const int dsh = 2 * g, p = ((s & ((1 << dsh) - 1)) << (11 - dsh)) | (s >> dsh); r[g] = ((size_t)(g * 4 + b) * 16 + h) * 2048 + p; lg[g] = LSE[r[g]]; }
            const float mx = fmaxf(lg[0], fmaxf(lg[1], lg[2]));
            float w0 = __builtin_amdgcn_exp2f(lg[0] - mx), w1 = __builtin_amdgcn_exp2f(lg[1] - mx), w2 = __builtin_amdgcn_exp2f(lg[2] - mx);
            const float inv = 1.0f / (w0 + w1 + w2); w0 *= inv; w1 *= inv; w2 *= inv;
            const v4u a = *(const v4u*)(OG + r[0] * 128 + e), bb = *(const v4u*)(OG + r[1] * 128 + e), c = *(const v4u*)(OG + r[2] * 128 + e), gt = *(const v4u*)(GATE + (size_t)row * 2048 + col);
            v4u o;
#pragma unroll
            for (int k = 0; k < 4; ++k) {
                const float ylo = (w0 * bflo(a[k]) + w1 * bflo(bb[k]) + w2 * bflo(c[k])) * bflo(gt[k]);
                const float yhi = (w0 * bfhi(a[k]) + w1 * bfhi(bb[k]) + w2 * bfhi(c[k])) * bfhi(gt[k]);
                o[k] = pk2(ylo, yhi); }
            *(v4u*)(Y + (size_t)row * 2048 + col) = o; }
    }
}
__device__ __forceinline__ void sgu_phase(const bf16* VTB, const float* STATS, const float* LNG, const float* LNB, const bf16* WM, const float* BS, const bf16* U, const bf16* ZS, bf16* Y,
                                          int gw, int NGW, int lane) {
    const int r = lane & 31, hh = lane >> 5;
    for (int wu = gw; wu < 4096; wu += NGW) {
        const int cblk = wu & 3, g = (wu >> 2) & 15, chunk = (wu >> 6) & 15, b = wu >> 10;
        const int ch = g * 128 + cblk * 32 + r, tok0 = b * 2048 + chunk * 128;
        const float lng = LNG[ch], lnb = LNB[ch];
        bf16x8 af[8];
#pragma unroll
        for (int ks = 0; ks < 8; ++ks) { const int s0 = 16 * ks + 8 * hh;
            const v4u raw = *(const v4u*)(VTB + (size_t)((tok0 + 16 * ks) >> 5) * 65536 + (size_t)ch * 32 + ((16 * ks) & 31) + 8 * hh);
            const f32x4* st = (const f32x4*)(STATS + 2 * (size_t)(tok0 + s0));
            v4u o;
#pragma unroll
            for (int k = 0; k < 4; ++k) { const f32x4 sv = st[k];
                const float mu0 = sv.x * (1.0f / 2048), mu1 = sv.z * (1.0f / 2048);
                const float a0 = lng / sqrtf(fmaxf(sv.y * (1.0f / 2048) - mu0 * mu0, 0.f) + LN_EPS), a1 = lng / sqrtf(fmaxf(sv.w * (1.0f / 2048) - mu1 * mu1, 0.f) + LN_EPS);
                o[k] = pk2(bflo(raw[k]) * a0 + (lnb - mu0 * a0), bfhi(raw[k]) * a1 + (lnb - mu1 * a1)); }
            af[ks] = __builtin_bit_cast(bf16x8, o); }
#pragma unroll
        for (int tb = 0; tb < 4; ++tb) {
            f32x16 D;
#pragma unroll
            for (int i = 0; i < 16; ++i) D[i] = 0.f;
            const bf16* wp = WM + (size_t)(g * 128 + tb * 32 + r) * 128 + 8 * hh;
#pragma unroll
            for (int ks = 0; ks < 2 * tb + 2; ++ks) { const bf16x8 bfr = *(const bf16x8*)(wp + 16 * ks); D = MFMA32(af[ks], bfr, D); }
            const int t = tb * 32 + r; const float bs = BS[g * 128 + t];
            const size_t rowoff = (size_t)(tok0 + t) * 2048 + g * 128 + cblk * 32 + 4 * hh;
#pragma unroll
            for (int i4 = 0; i4 < 4; ++i4) { const v2u uu = *(const v2u*)(U + rowoff + 8 * i4), zz = *(const v2u*)(ZS + rowoff + 8 * i4);
                v2u w; w.x = pk2(bflo(uu.x) * (D[4 * i4] + bs) * bflo(zz.x), bfhi(uu.x) * (D[4 * i4 + 1] + bs) * bfhi(zz.x));
                w.y = pk2(bflo(uu.y) * (D[4 * i4 + 2] + bs) * bflo(zz.y), bfhi(uu.y) * (D[4 * i4 + 3] + bs) * bfhi(zz.y));
                *(v2u*)(Y + rowoff + 8 * i4) = w; }
        }
    }
}

constexpr int N_PHASES = 19;
__global__ void __launch_bounds__(NTHR) trunk_fwd(Args args) {
    extern __shared__ __attribute__((aligned(16))) unsigned char lds[];
    const int tid = threadIdx.x, lane = tid & 63, wave = __builtin_amdgcn_readfirstlane(tid >> 6);
    const int G = gridDim.x, bx = blockIdx.x;
    const int gw = bx * NWAVES + wave, NGW = G * NWAVES;
    unsigned char* ws = args.ws;
    bf16* WAin = (bf16*)(ws + WS_WAIN); bf16* WAout = (bf16*)(ws + WS_WAOUT); bf16* WBin = (bf16*)(ws + WS_WBIN); bf16* WBout = (bf16*)(ws + WS_WBOUT); bf16* WM = (bf16*)(ws + WS_WM);
    float* COS = (float*)(ws + WS_COS); float* SIN = (float*)(ws + WS_SIN); float* STATS = (float*)(ws + WS_STATS); float* LSE = (float*)(ws + WS_LSE);
    float* X = (float*)(ws + WS_X); bf16* XN = (bf16*)(ws + WS_XN); bf16* QK = (bf16*)(ws + WS_QK); bf16* VT = (bf16*)(ws + WS_VT); bf16* GATE = (bf16*)(ws + WS_GATE);
    bf16* OG = (bf16*)(ws + WS_OG); bf16* Y = (bf16*)(ws + WS_Y);
    bf16* U = OG; bf16* ZS = OG + (size_t)MTOK * 2048;
    const int lo = args.ph_lo, hi = args.ph_hi;
#define IN(k) (lo <= (k) && (k) < hi)
    volatile LAS unsigned* MISC = (volatile LAS unsigned*)((LAS unsigned char*)lds + 131072 + 320);
    if (tid < 32) MISC[tid] = 0u;
    unsigned* barw = (unsigned*)(ws + WS_BAR);
#if !MK_PER_PHASE
    if (bx == 0) for (int i = tid; i < XCD_BAR_WORDS; i += NTHR) __hip_atomic_store(barw + i, 0u, __ATOMIC_RELAXED, __HIP_MEMORY_SCOPE_AGENT);
#endif
    __syncthreads();
    XcdBarrier xbar; xbar.bar = barw; xbar.x = 0; xbar.st = MISC + 8;
#if MK_PER_PHASE
#define SEAM(k) do { } while (0)
#else
#define SEAM(k) do { if (IN(k) && IN((k) + 1)) xcd_barrier(xbar); } while (0)
#endif
    if (IN(0)) {
        LAS float* scr = (LAS float*)((LAS unsigned char*)lds + wave * 16384);
        constexpr int I_AIN = 32 * (A_IN / 32), I_SQ = 32 * (DM / 32), I_BIN = 32 * (B_IN / 32);
        constexpr int NITEMS = 2 * (I_AIN + I_SQ + I_BIN + I_SQ);
        for (int it = gw; it < NITEMS; it += NGW) {
            int r = it; const int j = r / (NITEMS / 2); r -= j * (NITEMS / 2);
            if (r < I_AIN) { const int nblk = A_IN / 32, kb = r / nblk, nb = r % nblk, sb = (nb * 32) / 2048;
                const int db = sb == 9 ? 6 : ((sb % 3) == 2 ? 7 + sb / 3 : 2 * (sb / 3) + (sb % 3));
                p0_transpose_item_f8(args.a_w_in + (size_t)j * DM * A_IN, DM, A_IN, (unsigned char*)WAin + (size_t)j * A_IN * DM, (db - sb) * 2048, scr, kb, nb, lane); continue; } r -= I_AIN;
            if (r < I_SQ) { p0_transpose_item(args.a_w_out + (size_t)j * DM * DM, DM, DM, WAout + (size_t)j * DM * DM, 0, scr, r / (DM / 32), r % (DM / 32), lane); continue; } r -= I_SQ;
            if (r < I_BIN) { const int nblk = B_IN / 32, kb = r / nblk, nb = r % nblk, sb = (nb * 32) / 2048;
                const int db = sb == 0 ? 0 : (sb == 1 ? 2 : 1);
                p0_transpose_item(args.b_w_in + (size_t)j * DM * B_IN, DM, B_IN, WBin + (size_t)j * B_IN * DM, (db - sb) * 2048, scr, kb, nb, lane); continue; } r -= I_BIN;
            p0_transpose_item(args.b_w_out + (size_t)j * DM * DM, DM, DM, WBout + (size_t)j * DM * DM, 0, scr, r / (DM / 32), r % (DM / 32), lane);
        }
        const int gt = bx * NTHR + tid, NGT = G * NTHR;
        for (int i = gt; i < 2 * 16 * 128 * 128 / 2; i += NGT) { const int e = 2 * i, s = e & 127, t = (e >> 7) & 127;
            const f32x2v w = *(const f32x2v*)(args.b_w_s + e); ((unsigned*)WM)[i] = pk2(s <= t ? w.x : 0.f, s + 1 <= t ? w.y : 0.f); }
        for (int i = gt; i < MTOK * 16; i += NGT) { const int tok = i >> 4, f = i & 15; const double rev = (double)args.pos[tok] * args.invf[f]; const float fr = (float)(rev - floor(rev));
            COS[i] = __builtin_amdgcn_cosf(fr); SIN[i] = __builtin_amdgcn_sinf(fr); }
        for (int i = gt; i < 2 * MTOK * 2; i += NGT) STATS[i] = 0.f;
        for (int m = gw; m < MTOK; m += NGW) rms_row<2>(args.x + (size_t)m * DM, args.a_norm_g, (unsigned char*)XN + (size_t)m * DM, lane);
    }
#if !MK_PER_PHASE
    cg::this_grid().sync();
    xbar = xcd_barrier_post(barw, MISC + 8);
#endif
    for (int rep = 0; rep < 2; ++rep) {
        const int P = 1 + 9 * rep;
        if (IN(P)) {
            const unsigned char* W = (const unsigned char*)WAin + (size_t)rep * A_IN * DM;
            { pg8::Gemm g{XN, (const bf16*)W, MTOK, NA1, DM, 1}; pg8::StaticOrder S; S.init(MTOK, NA1, G, bx); pg8::EpiA1 E{QK, GATE, COS, SIN, 1.0f / W8_SCALE};
              pg8::gemm_phase<pg8::EpiA1, pg8::StaticOrder, true, true, true>((LAS unsigned char*)lds, g, S, E); }
            for (int grp = 0; grp < 3; ++grp) {
                pg8::Gemm g{(const bf16*)(W + (size_t)(NA1 + grp * 2048) * DM), XN, 2048, MTOK, DM, 1 << (2 * grp)}; pg8::StaticOrder S; S.init(2048, MTOK, G, bx);
                pg8::EpiPlain E{VT + (size_t)grp * 2048 * 8192, 1.0f / W8_SCALE};
                pg8::gemm_phase<pg8::EpiPlain, pg8::StaticOrder, true, true, true>((LAS unsigned char*)lds, g, S, E); }
        }
        SEAM(P);
        if (IN(P + 1)) attn_phase(QK, VT, OG, LSE, gw, NGW, launder(lane), (LAS unsigned char*)lds + wave * 16384);
        SEAM(P + 1);
        if (IN(P + 2)) merge_phase(OG, LSE, GATE, Y, gw, NGW, launder(lane));
        SEAM(P + 2);
        if (IN(P + 3)) { pg8::Gemm g{Y, WAout + (size_t)rep * DM * DM, MTOK, DM, DM, 1}; pg8::StaticOrder S; S.init(MTOK, DM, G, bx); pg8::EpiOut E{rep == 0 ? args.x : X, X};
            pg8::gemm_phase<pg8::EpiOut, pg8::StaticOrder, true, true>((LAS unsigned char*)lds, g, S, E); }
        SEAM(P + 3);
        if (IN(P + 4)) { const int ln = launder(lane); const float* gn = args.b_norm_g + (size_t)rep * DM; for (int m = gw; m < MTOK; m += NGW) rms_row<0>(X + (size_t)m * DM, gn, XN + (size_t)m * DM, ln); }
        SEAM(P + 4);
        if (IN(P + 5)) {
            const bf16* W = WBin + (size_t)rep * B_IN * DM;
            { pg8::Gemm g{XN, W, MTOK, 4096, DM, 1}; pg8::StaticOrder S; S.init(MTOK, 4096, G, bx); pg8::EpiB1 E{U, ZS};
              pg8::gemm_phase<pg8::EpiB1, pg8::StaticOrder, true, true>((LAS unsigned char*)lds, g, S, E); }
            { pg8::Gemm g{W + (size_t)4096 * DM, XN, 2048, MTOK, DM, 1}; pg8::StaticOrder S; S.init(2048, MTOK, G, bx); pg8::EpiB2 E{VT, STATS + (size_t)rep * MTOK * 2};
              pg8::gemm_phase<pg8::EpiB2, pg8::StaticOrder, true, true>((LAS unsigned char*)lds, g, S, E); }
        }
        SEAM(P + 5);
        if (IN(P + 6)) sgu_phase(VT, STATS + (size_t)rep * MTOK * 2, args.b_ln_g + (size_t)rep * DM, args.b_ln_b + (size_t)rep * DM, WM + (size_t)rep * 16 * 128 * 128, args.b_b_s + (size_t)rep * 16 * 128, U, ZS, Y, gw, NGW, launder(lane));
        SEAM(P + 6);
        if (IN(P + 7)) { pg8::Gemm g{Y, WBout + (size_t)rep * DM * DM, MTOK, DM, DM, 1}; pg8::StaticOrder S; S.init(MTOK, DM, G, bx); pg8::EpiOut E{X, X};
            pg8::gemm_phase<pg8::EpiOut, pg8::StaticOrder, true, true>((LAS unsigned char*)lds, g, S, E); }
        SEAM(P + 7);
        if (IN(P + 8)) { const int ln = launder(lane);
            if (rep == 0) { const float* gn = args.a_norm_g + DM; for (int m = gw; m < MTOK; m += NGW) rms_row<2>(X + (size_t)m * DM, gn, (unsigned char*)XN + (size_t)m * DM, ln); }
            else { for (int m = gw; m < MTOK; m += NGW) rms_row<1>(X + (size_t)m * DM, args.final_g, args.out + (size_t)m * DM, ln); }
        }
        if (rep == 0) SEAM(P + 8);
    }
#undef IN
#undef SEAM
}

extern "C" void kernel_launch(void* const* d_in, const int* in_sizes, int n_in, void* d_out, int out_size, void* d_ws, size_t ws_size, hipStream_t stream) {
    static int grid = 0;
    if (grid == 0) {
        if (n_in != 13 || in_sizes[0] != MTOK * DM || out_size != MTOK * DM || ws_size < WS_END) { fprintf(stderr, "kernel_launch: unexpected shapes / workspace (n_in %d, in0 %d, out %d, ws %zu, need %zu)\n", n_in, n_in > 0 ? in_sizes[0] : -1, out_size, ws_size, (size_t)WS_END); grid = -1; return; }
        int dev = 0, cus = 0, per_cu = 0;
        if (hipGetDevice(&dev) != hipSuccess || hipDeviceGetAttribute(&cus, hipDeviceAttributeMultiprocessorCount, dev) != hipSuccess) { grid = -1; return; }
        if (hipFuncSetAttribute((const void*)trunk_fwd, hipFuncAttributeMaxDynamicSharedMemorySize, LDS_BYTES) != hipSuccess) { fprintf(stderr, "kernel_launch: hipFuncSetAttribute failed\n"); grid = -1; return; }
        if (hipOccupancyMaxActiveBlocksPerMultiprocessor(&per_cu, (const void*)trunk_fwd, NTHR, LDS_BYTES) != hipSuccess || per_cu < 1) { fprintf(stderr, "kernel_launch: occupancy query failed (%d)\n", per_cu); (void)hipGetLastError(); grid = -1; return; }
        grid = cus * per_cu;
    }
    if (grid < 0) return;
    Args a{};
    a.x = (const float*)d_in[0]; a.pos = (const int*)d_in[1]; a.a_norm_g = (const float*)d_in[2]; a.a_w_in = (const float*)d_in[3]; a.a_w_out = (const float*)d_in[4];
    a.b_norm_g = (const float*)d_in[5]; a.b_w_in = (const float*)d_in[6]; a.b_ln_g = (const float*)d_in[7]; a.b_ln_b = (const float*)d_in[8]; a.b_w_s = (const float*)d_in[9];
    a.b_b_s = (const float*)d_in[10]; a.b_w_out = (const float*)d_in[11]; a.final_g = (const float*)d_in[12];
    a.out = (float*)d_out; a.ws = (unsigned char*)d_ws;
    for (int i = 0; i < 16; ++i) a.invf[i] = pow(500000.0, -(double)i / 16.0) / 6.283185307179586476925;
#if MK_PER_PHASE
    for (int p = 0; p < N_PHASES; ++p) { a.ph_lo = p; a.ph_hi = p + 1; hipLaunchKernelGGL(trunk_fwd, dim3(grid), dim3(NTHR), LDS_BYTES, stream, a); }
#else
    a.ph_lo = 0; a.ph_hi = N_PHASES;
    void* kargs[] = {&a};
    const hipError_t e = hipLaunchCooperativeKernel((const void*)trunk_fwd, dim3(grid), dim3(NTHR), kargs, LDS_BYTES, stream);
    if (e != hipSuccess) fprintf(stderr, "kernel_launch: cooperative launch failed: %s (grid %d)\n", hipGetErrorString(e), grid);
#endif
}
```

```cpp
#include <hip/hip_runtime.h>
#include <hip/hip_cooperative_groups.h>
#include <cstdio>
#include <cstdint>
#include <cmath>
namespace cg = cooperative_groups;
#ifndef A_VG_FP8
#define A_VG_FP8 1
#endif
#ifndef A_GATE_BF16
#define A_GATE_BF16 1
#endif
#ifndef MK_PER_PHASE
#define MK_PER_PHASE 0
#endif
__device__ __forceinline__ int lane_id() { int l; asm volatile("v_mbcnt_lo_u32_b32 %0, -1, 0\n\tv_mbcnt_hi_u32_b32 %0, -1, %0" : "=v"(l)); return l; }
namespace pg8 {
#define PG8_LAS __attribute__((address_space(3)))
typedef unsigned short bf16_t;
typedef short bf16x8 __attribute__((ext_vector_type(8)));
typedef float f32x4 __attribute__((ext_vector_type(4)));
typedef unsigned u32x4 __attribute__((ext_vector_type(4)));
typedef int i32x4 __attribute__((ext_vector_type(4)));
constexpr int BM = 256, BK = 64, HALF = 128, HTB = HALF * BK * 2  , STAGE_BYTES = 8 * HTB, NXCD = 8, WGM = 8;

__host__ __device__ __forceinline__ int lds_byte(int r, int c) { const int st = (r >> 4) * 2 + (c >> 5), rr = r & 15, cc = c & 31, ob = rr * 64 + cc * 2; return st * 1024 + (ob ^ (((ob >> 9) & 1) << 5)); }
__host__ __device__ __forceinline__ void stage_rc(int b, int& R, int& C) { const int st = b / 1024, sb = b % 1024, swz = sb ^ (((sb >> 9) & 1) << 5); R = (st >> 1) * 16 + swz / 64; C = (st & 1) * 32 + (swz % 64) / 2; }
__host__ __device__ __forceinline__ int perm32(int rho) { const int n = rho >> 4, i = rho & 15; return 8 * (i >> 2) + 4 * n + (i & 3); }

struct Unit { int pm, pn, k; };
struct Prob { const char* A; const char* B; int nM, nN, bdil; };
struct StaticOrder {
    int nM, nN, nwg, G, c;
    __host__ __device__ void init(int M, int N, int G_, int c_) { nM = M / BM; nN = N / BM; nwg = nM * nN; G = G_; c = c_; }
    __host__ __device__ bool next(int i, Unit& u) const {
        const long L = (long)i * G + c; if (L >= nwg) return false;
        int wgid = (int)L; { const int q = nwg / NXCD, r = nwg % NXCD, xcd = wgid % NXCD, off = wgid / NXCD; wgid = (xcd < r ? xcd * (q + 1) : r * (q + 1) + (xcd - r) * q) + off; }
        const int nig = WGM * nN, gid = wgid / nig, fm = gid * WGM, gsz = (nM - fm) < WGM ? (nM - fm) : WGM;
        u.pm = fm + ((wgid % nig) % gsz); u.pn = (wgid % nig) / gsz; return true;
    }
    __device__ __forceinline__ void a_ready(const Unit&) const {}
    __device__ __forceinline__ void done(const Unit&) const {}
};
struct MultiOrder {
    Prob p0, p1, p2, p3; int np, G, c, rowbytes;
    __device__ __forceinline__ static void map(const Prob& P, int wgid, Unit& u) {
        const int nM = P.nM, nN = P.nN, nwg = nM * nN;
        { const int q = nwg / NXCD, r = nwg % NXCD, xcd = wgid % NXCD, off = wgid / NXCD; wgid = (xcd < r ? xcd * (q + 1) : r * (q + 1) + (xcd - r) * q) + off; }
        const int nig = WGM * nN, gid = wgid / nig, fm = gid * WGM, gsz = (nM - fm) < WGM ? (nM - fm) : WGM;
        u.pm = fm + ((wgid % nig) % gsz); u.pn = (wgid % nig) / gsz;
    }
    __device__ __forceinline__ bool next(int i, Unit& u) const {
        long L = (long)i * G + c;
        { const int n = p0.nM * p0.nN; if (L < n) { map(p0, (int)L, u); u.k = 0; return true; } L -= n; }
        if (np > 1) { const int n = p1.nM * p1.nN; if (L < n) { map(p1, (int)L, u); u.k = 1; return true; } L -= n; }
        if (np > 2) { const int n = p2.nM * p2.nN; if (L < n) { map(p2, (int)L, u); u.k = 2; return true; } L -= n; }
        if (np > 3) { const int n = p3.nM * p3.nN; if (L < n) { map(p3, (int)L, u); u.k = 3; return true; } L -= n; }
        return false;
    }
    __device__ __forceinline__ const char* selA(int k) const { return k == 0 ? p0.A : (k == 1 ? p1.A : (k == 2 ? p2.A : p3.A)); }
    __device__ __forceinline__ const char* selB(int k) const { return k == 0 ? p0.B : (k == 1 ? p1.B : (k == 2 ? p2.B : p3.B)); }
    __device__ __forceinline__ int bdil(const Unit& u) const { return u.k == 0 ? p0.bdil : (u.k == 1 ? p1.bdil : (u.k == 2 ? p2.bdil : p3.bdil)); }
    __device__ __forceinline__ const char* a_base(const Unit& u) const { return selA(u.k) + (size_t)u.pm * 256 * rowbytes; }
    __device__ __forceinline__ const char* b_base(const Unit& u) const { const int d = bdil(u), t8 = u.pn & 7; const int r = (u.pn >> 3) * 2048 + (d == 1 ? 256 * t8 : (d == 4 ? 1024 * (t8 & 1) + (t8 >> 1) : 2 * t8)); return selB(u.k) + (size_t)r * rowbytes; }
    __device__ __forceinline__ void a_ready(const Unit&) const {}
    __device__ __forceinline__ void done(const Unit&) const {}
};


__device__ __forceinline__ unsigned cvt_pk_bf16(float lo, float hi) { unsigned r; asm volatile("v_cvt_pk_bf16_f32 %0, %1, %2" : "=v"(r) : "v"(lo), "v"(hi)); return r; }
typedef float f32x2 __attribute__((ext_vector_type(2)));
__device__ __forceinline__ f32x2 gelu_pk(f32x2 v) {
    const f32x2 av = __builtin_elementwise_abs(v), d = av * 0.2316418882f + 1.0f;
    f32x2 t; t.x = __builtin_amdgcn_rcpf(d.x); t.y = __builtin_amdgcn_rcpf(d.y);
    f32x2 q = t * 0.5307027145f + (-0.7265760135f); q = q * t + 0.7107068705f; q = q * t + (-0.142248368f); q = q * t + 0.127414796f; q = q * t;
    const f32x2 s = (v * v) * (-0.72134752044f);
    f32x2 e; e.x = __builtin_amdgcn_exp2f(s.x); e.y = __builtin_amdgcn_exp2f(s.y);
    const f32x2 m = v * (q * e), r = v - m;
    f32x2 o; o.x = v.x < 0.f ? m.x : r.x; o.y = v.y < 0.f ? m.y : r.y; return o;
}

constexpr float C2 = 0.08838834764831845f * 1.4426950408889634f;
__device__ __forceinline__ float silu_f(float x) { return x * __builtin_amdgcn_rcpf(1.0f + __builtin_amdgcn_exp2f(-1.4426950408889634f * x)); }
__device__ __forceinline__ u32x4 pack8(const f32x4& v0, const f32x4& v1) { u32x4 w; w.x = cvt_pk_bf16(v0[0], v0[1]); w.y = cvt_pk_bf16(v0[2], v0[3]); w.z = cvt_pk_bf16(v1[0], v1[1]); w.w = cvt_pk_bf16(v1[2], v1[3]); return w; }
__device__ __forceinline__ void gelu8(f32x4& v0, f32x4& v1) { f32x2 a = gelu_pk((f32x2){v0[0], v0[1]}), b = gelu_pk((f32x2){v0[2], v0[3]}), c = gelu_pk((f32x2){v1[0], v1[1]}), d = gelu_pk((f32x2){v1[2], v1[3]});
    v0 = (f32x4){a.x, a.y, b.x, b.y}; v1 = (f32x4){c.x, c.y, d.x, d.y}; }

struct EpiA1 {
    static constexpr bool PERM = true, AFTER_DRAIN = false;
    bf16_t* QK; bf16_t* GATE; const float* COS; const float* SIN; float osc; int pn0; const float* rss;
    __device__ __forceinline__ void operator()(const f32x4 (&acc)[2][2][4][2], const Unit& u, int wr, int wc, int fr, int fq) const {
        const int pn = u.pn + pn0; const int rowb = u.pm * BM + wr * 64 + fr;
        if (pn >= 48) {
            const int col0 = (pn - 48) * 256 + wc * 32 + 8 * fq;
#pragma unroll
            for (int ai = 0; ai < 2; ++ai)
#pragma unroll
                for (int m = 0; m < 4; ++m) { bf16_t* rowp = GATE + (size_t)(rowb + ai * HALF + m * 16) * 2048 + col0; const float rs = osc * __builtin_amdgcn_rsqf(rss[rowb + ai * HALF + m * 16] * (1.0f / 2048) + 1e-6f);
#pragma unroll
                    for (int bj = 0; bj < 2; ++bj) { f32x4 v0 = acc[ai][bj][m][0] * rs, v1 = acc[ai][bj][m][1] * rs;
#pragma unroll
                        for (int i = 0; i < 4; ++i) { v0[i] = silu_f(v0[i]); v1[i] = silu_f(v1[i]); }
                        *(u32x4*)(rowp + bj * HALF) = pack8(v0, v1); } }
        } else {
            const int g = pn >> 4, qk = (pn >> 3) & 1, hp = pn & 7, dsh = 2 * g, dm1 = (1 << dsh) - 1;
            const float sc = osc; const float sgn = fq < 2 ? -1.0f : 1.0f; const int e0 = wc * 32 + 8 * fq;
#pragma unroll
            for (int ai = 0; ai < 2; ++ai)
#pragma unroll
                for (int m = 0; m < 4; ++m) { const int row = rowb + ai * HALF + m * 16, b = row >> 11, s = row & 2047, p = ((s & dm1) << (11 - dsh)) | (s >> dsh);
                    f32x4 c0, c1, s0, s1; const float scr = sc * __builtin_amdgcn_rsqf(rss[row] * (1.0f / 2048) + 1e-6f);
                    if (wc == 0) { const float* cp = COS + (size_t)row * 16 + 8 * (fq & 1); const float* sp = SIN + (size_t)row * 16 + 8 * (fq & 1);
                        c0 = *(const f32x4*)cp; c1 = *(const f32x4*)(cp + 4); s0 = *(const f32x4*)sp; s1 = *(const f32x4*)(sp + 4);
                        }
#pragma unroll
                    for (int bj = 0; bj < 2; ++bj) { f32x4 v0 = acc[ai][bj][m][0], v1 = acc[ai][bj][m][1];
                        if (wc == 0) {
#pragma unroll
                            for (int i = 0; i < 4; ++i) { const float p0 = __shfl_xor(v0[i], 32), p1 = __shfl_xor(v1[i], 32);
                                v0[i] = v0[i] * c0[i] + sgn * p0 * s0[i]; v1[i] = v1[i] * c1[i] + sgn * p1 * s1[i]; } }
                        v0 = v0 * scr; v1 = v1 * scr;
                        unsigned char* dst = (unsigned char*)QK + ((((size_t)((g * 2 + qk) * 4 + b) * 16 + (2 * hp + bj)) * 2048 + p) * 128 + e0);
                        int w0 = 0, w1 = 0; w0 = __builtin_amdgcn_cvt_pk_fp8_f32(v0[0], v0[1], w0, false); w0 = __builtin_amdgcn_cvt_pk_fp8_f32(v0[2], v0[3], w0, true);
                        w1 = __builtin_amdgcn_cvt_pk_fp8_f32(v1[0], v1[1], w1, false); w1 = __builtin_amdgcn_cvt_pk_fp8_f32(v1[2], v1[3], w1, true);
                        *(unsigned long long*)dst = ((unsigned long long)(unsigned)w1 << 32) | (unsigned)w0; } }
        }
    }
};
struct EpiB1 {
    static constexpr bool PERM = true, AFTER_DRAIN = false;
    bf16_t* U; bf16_t* ZS; const float* rss;
    __device__ __forceinline__ void operator()(const f32x4 (&acc)[2][2][4][2], const Unit& u, int wr, int wc, int fr, int fq) const {
        const int pn = u.pn; const int rowb = u.pm * BM + wr * 64 + fr; const bool isz = pn >= 8;
        bf16_t* base = isz ? ZS : U; const int col0 = (pn & 7) * 256 + wc * 32 + 8 * fq;
#pragma unroll
        for (int ai = 0; ai < 2; ++ai)
#pragma unroll
            for (int m = 0; m < 4; ++m) { bf16_t* rowp = base + (size_t)(rowb + ai * HALF + m * 16) * 2048 + col0; const float rs = __builtin_amdgcn_rsqf(rss[rowb + ai * HALF + m * 16] * (1.0f / 2048) + 1e-6f);
#pragma unroll
                for (int bj = 0; bj < 2; ++bj) { f32x4 v0 = acc[ai][bj][m][0] * rs, v1 = acc[ai][bj][m][1] * rs;
                    if (isz) {
#pragma unroll
                        for (int i = 0; i < 4; ++i) { v0[i] = silu_f(v0[i]); v1[i] = silu_f(v1[i]); }
                    } else gelu8(v0, v1);
                    *(u32x4*)(rowp + bj * HALF) = pack8(v0, v1); } }
    }
};
struct EpiPlain {
    static constexpr bool PERM = true, AFTER_DRAIN = false;
    bf16_t* O; float osc; const float* rss; int dsh;
    __device__ __forceinline__ void operator()(const f32x4 (&acc)[2][2][4][2], const Unit& u, int wr, int wc, int fr, int fq) const {
        const int rowb = u.pm * BM + wr * 64 + fr; const int col0 = u.pn * BM + wc * 32 + 8 * fq;
#pragma unroll
        for (int bj = 0; bj < 2; ++bj) { const int c = col0 + bj * HALF, p = c & 2047, Lm1 = (2048 >> dsh) - 1; const float* rp = rss + (c & ~2047) + ((p & Lm1) << dsh) + (p >> (11 - dsh));
            f32x4 r0, r1;
#pragma unroll
            for (int k = 0; k < 4; ++k) { r0[k] = osc * __builtin_amdgcn_rsqf(rp[k << dsh] * (1.0f / 2048) + 1e-6f); r1[k] = osc * __builtin_amdgcn_rsqf(rp[(k + 4) << dsh] * (1.0f / 2048) + 1e-6f); }
#pragma unroll
            for (int ai = 0; ai < 2; ++ai)
#pragma unroll
                for (int m = 0; m < 4; ++m) { bf16_t* rowp = O + (size_t)((c >> 5)) * 65536 + (size_t)(rowb + ai * HALF + m * 16) * 32 + (c & 31);
                    *(u32x4*)rowp = pack8(acc[ai][bj][m][0] * r0, acc[ai][bj][m][1] * r1); } }
    }
};
struct EpiB2 {
    static constexpr bool PERM = true, AFTER_DRAIN = false;
    bf16_t* VT; float* STATS; const float* rss;
    __device__ __forceinline__ static float row16_sum(float v) {
        v += __builtin_bit_cast(float, __builtin_amdgcn_update_dpp(0, __builtin_bit_cast(int, v), 0xB1, 0xf, 0xf, true));
        v += __builtin_bit_cast(float, __builtin_amdgcn_update_dpp(0, __builtin_bit_cast(int, v), 0x4E, 0xf, 0xf, true));
        v += __builtin_bit_cast(float, __builtin_amdgcn_update_dpp(0, __builtin_bit_cast(int, v), 0x141, 0xf, 0xf, true));
        v += __builtin_bit_cast(float, __builtin_amdgcn_update_dpp(0, __builtin_bit_cast(int, v), 0x140, 0xf, 0xf, true));
        return v; }
    __device__ __forceinline__ void operator()(const f32x4 (&acc)[2][2][4][2], const Unit& u, int wr, int wc, int fr, int fq) const {
        const int rowb = u.pm * BM + wr * 64 + fr; const int col0 = u.pn * BM + wc * 32 + 8 * fq;
#pragma unroll
        for (int bj = 0; bj < 2; ++bj) {
            float s1[8], s2[8]; f32x4 r0 = *(const f32x4*)(rss + col0 + bj * HALF), r1 = *(const f32x4*)(rss + col0 + bj * HALF + 4);
#pragma unroll
            for (int k = 0; k < 4; ++k) { r0[k] = __builtin_amdgcn_rsqf(r0[k] * (1.0f / 2048) + 1e-6f); r1[k] = __builtin_amdgcn_rsqf(r1[k] * (1.0f / 2048) + 1e-6f); }
#pragma unroll
            for (int k = 0; k < 8; ++k) { s1[k] = 0.f; s2[k] = 0.f; }
#pragma unroll
            for (int ai = 0; ai < 2; ++ai)
#pragma unroll
                for (int m = 0; m < 4; ++m) { bf16_t* rowp = VT + (size_t)((col0 >> 5) + 4 * bj) * 65536 + (size_t)(rowb + ai * HALF + m * 16) * 32 + (col0 & 31);
                    f32x4 v0 = acc[ai][bj][m][0] * r0, v1 = acc[ai][bj][m][1] * r1; gelu8(v0, v1);
#pragma unroll
                    for (int i = 0; i < 4; ++i) { s1[i] += v0[i]; s2[i] += v0[i] * v0[i]; s1[4 + i] += v1[i]; s2[4 + i] += v1[i] * v1[i]; }
                    *(u32x4*)rowp = pack8(v0, v1); }
#pragma unroll
            for (int k = 0; k < 8; ++k) { const float a = row16_sum(s1[k]), b = row16_sum(s2[k]);
                if (fr == 0) { float* sp = STATS + 2 * (size_t)(col0 + bj * HALF + k); atomicAdd(sp, a); atomicAdd(sp + 1, b); } }
            asm volatile("" ::: "memory");
        }
    }
};
struct EpiAllA {
    static constexpr bool PERM = true, AFTER_DRAIN = false;
    EpiA1 e1; EpiPlain ev; int kv0;
    __device__ __forceinline__ void operator()(const f32x4 (&acc)[2][2][4][2], const Unit& u, int wr, int wc, int fr, int fq) const {
        if (u.k < kv0) e1(acc, u, wr, wc, fr, fq);
        else { EpiPlain e = ev; e.O += (size_t)(u.k - kv0) * 2048 * 8192; e.dsh = 2 * (u.k - kv0); e(acc, u, wr, wc, fr, fq); }
    }
};
struct EpiAllB {
    static constexpr bool PERM = true, AFTER_DRAIN = false;
    EpiB1 e1; EpiB2 e2;
    __device__ __forceinline__ void operator()(const f32x4 (&acc)[2][2][4][2], const Unit& u, int wr, int wc, int fr, int fq) const {
        if (u.k == 0) e1(acc, u, wr, wc, fr, fq); else e2(acc, u, wr, wc, fr, fq);
    }
};
struct EpiOut {
    static constexpr bool PERM = false, AFTER_DRAIN = false;
    const float* base; float* out; const float* gn; bf16_t* xb; unsigned char* x8; float* rss;
    __device__ __forceinline__ void operator()(const f32x4 (&acc)[2][2][4][2], const Unit& u, int wr, int wc, int fr, int fq) const {
        const int rowb = u.pm * BM + wr * 64 + fr; const int col0 = u.pn * BM + wc * 32 + 4 * fq;
        f32x4 gv[2][2];
        if (gn) {
#pragma unroll
            for (int bj = 0; bj < 2; ++bj)
#pragma unroll
                for (int n = 0; n < 2; ++n) gv[bj][n] = *(const f32x4*)(gn + col0 + bj * HALF + n * 16); }
#pragma unroll
        for (int ai = 0; ai < 2; ++ai)
#pragma unroll
            for (int m = 0; m < 4; ++m) { const int row = rowb + ai * HALF + m * 16; const size_t off = (size_t)row * 2048 + col0; float ss = 0.f;
#pragma unroll
                for (int bj = 0; bj < 2; ++bj)
#pragma unroll
                    for (int n = 0; n < 2; ++n) { const f32x4 bs = *(const f32x4*)(base + off + bj * HALF + n * 16); const f32x4 x = bs + acc[ai][bj][m][n]; *(f32x4*)(out + off + bj * HALF + n * 16) = x;
                        if (gn) { ss += (x[0] * x[0] + x[1] * x[1]) + (x[2] * x[2] + x[3] * x[3]); const f32x4 y = x * gv[bj][n];
                            unsigned lo = cvt_pk_bf16(y[0], y[1]), hi = cvt_pk_bf16(y[2], y[3]); *(unsigned long long*)(xb + off + bj * HALF + n * 16) = ((unsigned long long)hi << 32) | lo;
                            if (x8) { int w = 0; w = __builtin_amdgcn_cvt_pk_fp8_f32(y[0], y[1], w, false); w = __builtin_amdgcn_cvt_pk_fp8_f32(y[2], y[3], w, true); *(int*)(x8 + off + bj * HALF + n * 16) = w; } } }
                if (gn) { ss += __shfl_xor(ss, 16); ss += __shfl_xor(ss, 32); if (fq == 0) atomicAdd(rss + row, ss); } }
    }
};
template <class Epi, class Sched, bool ALIGN_EPI = false, bool SP2 = false, bool F8 = false>
__device__ __forceinline__ void gemm_phase(PG8_LAS unsigned char* lds, const int Kel, const Sched& S, const Epi& E, const int wave_) {
    const int tid = wave_ * 64 + ::lane_id(); const int wid = __builtin_amdgcn_readfirstlane(tid >> 6), lane = tid & 63, wr = wid >> 2, wc = wid & 3, fr = lane & 15, fq = lane >> 4;
    const int K = F8 ? Kel / 2 : Kel, nt = K / BK;
    unsigned voffA[2], voffB[2]; size_t hstepB;
#pragma unroll
    for (int i = 0; i < 2; ++i) { int R, C; stage_rc(tid * 16 + i * 8192, R, C); voffA[i] = (unsigned)(R * K + C) * 2u; }
#define PG8_SETB(dil) do { const int d_ = (dil); _Pragma("unroll") for (int i = 0; i < 2; ++i) { int R, C; stage_rc(tid * 16 + i * 8192, R, C); const int Rb = Epi::PERM ? ((R & ~31) + perm32(R & 31)) : R; \
        voffB[i] = (unsigned)(Rb * d_ * K + C) * 2u; } hstepB = (d_ == 16) ? (size_t)K * 2 : (size_t)HALF * d_ * K * 2; } while (0)
    const size_t kstep = (size_t)(BK * 2);
    const size_t hstep = (size_t)HALF * K * 2;
    const size_t tstep = 2 * hstep;
    const unsigned ldsw = (unsigned)wid * 1024u;
    const int aoff = lds_byte(wr * 64 + fr, fq * 8), boff = lds_byte(wc * 32 + fr, fq * 8);
#define PG8_SA(b, h) (((b) * 2 + (h)) * HTB)
#define PG8_SB(b, h) ((4 + (b) * 2 + (h)) * HTB)
#define PG8_STAGE(bufoff, gbase, voff) do { _Pragma("unroll") for (int _i = 0; _i < 2; ++_i) \
        __builtin_amdgcn_global_load_lds((const unsigned*)((const char*)(gbase) + (voff)[_i]), (PG8_LAS unsigned*)(lds + (bufoff) + ldsw + _i * 8192), 16, 0, 0); } while (0)
#define PG8_LDA(dst, b, h) do { _Pragma("unroll") for (int m = 0; m < 4; ++m) _Pragma("unroll") for (int k = 0; k < 2; ++k) dst[m][k] = *(const PG8_LAS bf16x8*)(lds + PG8_SA(b, h) + aoff + m * 2048 + k * 1024); } while (0)
#define PG8_LDB(dst, b, h) do { _Pragma("unroll") for (int n = 0; n < 2; ++n) _Pragma("unroll") for (int k = 0; k < 2; ++k) dst[n][k] = *(const PG8_LAS bf16x8*)(lds + PG8_SB(b, h) + boff + n * 2048 + k * 1024); } while (0)
#define PG8_CAT8(x) __builtin_shufflevector(__builtin_bit_cast(i32x4, (x)[0]), __builtin_bit_cast(i32x4, (x)[1]), 0, 1, 2, 3, 4, 5, 6, 7)
#define PG8_MMA(ai, bj, At, Bt) do { __builtin_amdgcn_s_setprio(1); \
        if constexpr (F8) { _Pragma("unroll") for (int m = 0; m < 4; ++m) _Pragma("unroll") for (int n = 0; n < 2; ++n) \
            asm volatile("v_mfma_f32_16x16x128_f8f6f4 %0, %1, %2, %0" : "+v"(acc[ai][bj][m][n]) : "v"(PG8_CAT8(Bt[n])), "v"(PG8_CAT8(At[m]))); } \
        else { _Pragma("unroll") for (int m = 0; m < 4; ++m) _Pragma("unroll") for (int n = 0; n < 2; ++n) _Pragma("unroll") for (int k = 0; k < 2; ++k) \
            acc[ai][bj][m][n] = __builtin_amdgcn_mfma_f32_16x16x32_bf16(Bt[n][k], At[m][k], acc[ai][bj][m][n], 0, 0, 0); } \
        __builtin_amdgcn_s_setprio(0); } while (0)
#define PG8_WAIT_V(n) asm volatile("s_waitcnt vmcnt(" #n ")" ::: "memory")
#define PG8_WAIT_L(n) asm volatile("s_waitcnt lgkmcnt(" #n ")" ::: "memory")
#define PG8_BAR __builtin_amdgcn_s_barrier()
#define PG8_SCHED __builtin_amdgcn_sched_barrier(0)
    Unit cur, nxt; int ui = 0;
    if (!S.next(0, cur)) return;
    f32x4 acc[2][2][4][2];
#pragma unroll
    for (int a = 0; a < 2; ++a)
#pragma unroll
        for (int b = 0; b < 2; ++b)
#pragma unroll
            for (int m = 0; m < 4; ++m)
#pragma unroll
                for (int n = 0; n < 2; ++n) acc[a][b][m][n] = (f32x4){0.f, 0.f, 0.f, 0.f};
    bf16x8 At[4][2], B0[2][2], B1[2][2];
    const char* cA = S.a_base(cur); const char* cB = S.b_base(cur); PG8_SETB(S.bdil(cur));
    S.a_ready(cur);
    if constexpr (SP2) {
        PG8_STAGE(PG8_SB(0, 0), cB, voffB); PG8_STAGE(PG8_SB(0, 1), cB + hstepB, voffB); PG8_STAGE(PG8_SA(0, 0), cA, voffA); PG8_STAGE(PG8_SA(0, 1), cA + hstep, voffA);
        if (wr == 1) PG8_BAR;
        PG8_WAIT_V(2); PG8_BAR;
        PG8_STAGE(PG8_SB(1, 0), cB + kstep, voffB); PG8_STAGE(PG8_SA(1, 0), cA + kstep, voffA); PG8_STAGE(PG8_SB(1, 1), cB + hstepB + kstep, voffB);
        PG8_WAIT_V(6); PG8_BAR;
    } else {
        PG8_STAGE(PG8_SB(0, 0), cB, voffB); PG8_STAGE(PG8_SA(0, 0), cA, voffA); PG8_STAGE(PG8_SB(0, 1), cB + hstepB, voffB); PG8_STAGE(PG8_SA(0, 1), cA + hstep, voffA);
        if (wr == 1) PG8_BAR;
        PG8_WAIT_V(4); PG8_BAR;
        PG8_STAGE(PG8_SB(1, 0), cB + kstep, voffB); PG8_STAGE(PG8_SA(1, 0), cA + kstep, voffA); PG8_STAGE(PG8_SB(1, 1), cB + hstepB + kstep, voffB);
        PG8_WAIT_V(6); PG8_BAR;
    }
    for (;;) {
        const bool has_next = S.next(ui + 1, nxt);
        const char* nA = has_next ? S.a_base(nxt) : cA; const char* nB = has_next ? S.b_base(nxt) : cB;
        for (int t = 0; t < nt; t += 2) {
            const bool last = (t == nt - 2);
            const char* a1 = cA + (size_t)(t + 1) * kstep;
            const char* a2 = last ? nA : cA + (size_t)(t + 2) * kstep; const char* b2 = last ? nB : cB + (size_t)(t + 2) * kstep;
            const char* a3 = a2 + kstep; const char* b3 = b2 + kstep;
            if (last && has_next) { S.a_ready(nxt); PG8_SETB(S.bdil(nxt)); }
            if constexpr (SP2) {
            PG8_LDB(B0, 0, 0); PG8_LDB(B1, 0, 1); PG8_SCHED; PG8_LDA(At, 0, 0); PG8_STAGE(PG8_SA(1, 1), a1 + hstep, voffA);
            PG8_WAIT_V(8); PG8_WAIT_L(0); PG8_BAR; PG8_MMA(0, 0, At, B0); PG8_MMA(0, 1, At, B1); PG8_BAR; PG8_SCHED;
            PG8_LDA(At, 0, 1); PG8_STAGE(PG8_SB(0, 0), b2, voffB); PG8_STAGE(PG8_SB(0, 1), b2 + hstepB, voffB); PG8_STAGE(PG8_SA(0, 0), a2, voffA);
            PG8_WAIT_V(8); PG8_WAIT_L(0); PG8_BAR; PG8_MMA(1, 0, At, B0); PG8_MMA(1, 1, At, B1); PG8_BAR; PG8_SCHED;
            PG8_LDB(B0, 1, 0); PG8_LDB(B1, 1, 1); PG8_SCHED; PG8_LDA(At, 1, 0); PG8_STAGE(PG8_SA(0, 1), a2 + hstep, voffA);
            PG8_WAIT_V(8); PG8_WAIT_L(0); PG8_BAR; PG8_MMA(0, 0, At, B0); PG8_MMA(0, 1, At, B1); PG8_BAR; PG8_SCHED;
            PG8_LDA(At, 1, 1); PG8_STAGE(PG8_SB(1, 0), b3, voffB); PG8_STAGE(PG8_SB(1, 1), b3 + hstepB, voffB); PG8_STAGE(PG8_SA(1, 0), a3, voffA);
            PG8_WAIT_V(8); PG8_WAIT_L(0); PG8_BAR; PG8_MMA(1, 0, At, B0); PG8_MMA(1, 1, At, B1); PG8_BAR; PG8_SCHED;
            } else {
            PG8_LDB(B0, 0, 0); PG8_SCHED; PG8_LDA(At, 0, 0); PG8_STAGE(PG8_SA(1, 1), a1 + hstep, voffA);
            PG8_WAIT_L(8); PG8_BAR; PG8_WAIT_L(0); PG8_MMA(0, 0, At, B0); PG8_BAR; PG8_SCHED;
            PG8_LDB(B1, 0, 1); PG8_STAGE(PG8_SB(0, 0), b2, voffB);
            PG8_BAR; PG8_WAIT_L(0); PG8_MMA(0, 1, At, B1); PG8_BAR;
            PG8_LDA(At, 0, 1); PG8_STAGE(PG8_SA(0, 0), a2, voffA);
            PG8_BAR; PG8_WAIT_L(0); PG8_MMA(1, 0, At, B0); PG8_BAR; PG8_SCHED;
            PG8_STAGE(PG8_SB(0, 1), b2 + hstepB, voffB);
            PG8_WAIT_V(6); PG8_BAR; PG8_MMA(1, 1, At, B1); PG8_BAR;
            PG8_LDB(B0, 1, 0); PG8_SCHED; PG8_LDA(At, 1, 0); PG8_STAGE(PG8_SA(0, 1), a2 + hstep, voffA);
            PG8_WAIT_L(8); PG8_BAR; PG8_WAIT_L(0); PG8_MMA(0, 0, At, B0); PG8_BAR; PG8_SCHED;
            PG8_LDB(B1, 1, 1); PG8_STAGE(PG8_SB(1, 0), b3, voffB);
            PG8_BAR; PG8_WAIT_L(0); PG8_MMA(0, 1, At, B1); PG8_BAR;
            PG8_LDA(At, 1, 1); PG8_STAGE(PG8_SA(1, 0), a3, voffA);
            PG8_BAR; PG8_WAIT_L(0); PG8_MMA(1, 0, At, B0); PG8_BAR; PG8_SCHED;
            PG8_STAGE(PG8_SB(1, 1), b3 + hstepB, voffB);
            PG8_WAIT_V(6); PG8_BAR; PG8_MMA(1, 1, At, B1); PG8_BAR;
            }
        }
        if constexpr (F8) asm volatile("s_nop 15\n\ts_nop 15" ::: "memory");
        if constexpr (ALIGN_EPI) { if (wr == 0) PG8_BAR; }
        if constexpr (!Epi::AFTER_DRAIN) { E(acc, cur, wr, wc, fr, fq); S.done(cur); }
        if (!has_next) break;
#pragma unroll
        for (int a = 0; a < 2; ++a)
#pragma unroll
            for (int b = 0; b < 2; ++b)
#pragma unroll
                for (int m = 0; m < 4; ++m)
#pragma unroll
                    for (int n = 0; n < 2; ++n) acc[a][b][m][n] = (f32x4){0.f, 0.f, 0.f, 0.f};
        cur = nxt; cA = nA; cB = nB; ++ui;
        if constexpr (ALIGN_EPI) { if (wr == 1) PG8_BAR; }
    }
    PG8_WAIT_V(0);
    if constexpr (!ALIGN_EPI) { if (wr == 0) PG8_BAR; }
    PG8_BAR;
    if constexpr (Epi::AFTER_DRAIN) { E.fused(acc, cur, wr, wc, fr, fq, lds, wid, lane); S.done(cur); }
#undef PG8_SA
#undef PG8_SB
#undef PG8_STAGE
#undef PG8_LDA
#undef PG8_LDB
#undef PG8_MMA
#undef PG8_SETB
#undef PG8_CAT8
#undef PG8_WAIT_V
#undef PG8_WAIT_L
#undef PG8_BAR
#undef PG8_SCHED
}
}

constexpr int NWAVES = 8, NTHR = NWAVES * 64;
constexpr int BATCH = 4, SEQ = 2048, DM = 2048, MTOK = BATCH * SEQ;
constexpr int A_IN = 20480, B_IN = 6144, NA1 = 14336;
constexpr float RMS_EPS = 1e-6f, LN_EPS = 1e-5f;
constexpr size_t MiB = 1u << 20;
constexpr size_t SZ_ACT = (size_t)MTOK * DM * 2;
constexpr size_t WS_WAIN = 2 * MiB;
constexpr size_t WS_WAOUT = WS_WAIN + 2 * (size_t)A_IN * DM * 2;
constexpr size_t WS_WBIN = WS_WAOUT + 2 * (size_t)DM * DM * 2;
constexpr size_t WS_WBOUT = WS_WBIN + 2 * (size_t)B_IN * DM * 2;
constexpr size_t WS_WM = WS_WBOUT + 2 * (size_t)DM * DM * 2;
constexpr size_t WS_COS = WS_WM + 2 * 16 * 128 * 128 * 2;
constexpr size_t WS_SIN = WS_COS + (size_t)MTOK * 16 * 4;
constexpr size_t WS_STATS = WS_SIN + (size_t)MTOK * 16 * 4;
constexpr size_t WS_LSE = WS_STATS + 2 * (size_t)MTOK * 2 * 4;
constexpr size_t WS_X = WS_LSE + 3 * (size_t)MTOK * 16 * 4;
constexpr size_t WS_XN = WS_X + 2 * SZ_ACT;
constexpr size_t WS_QK = WS_XN + SZ_ACT;
constexpr size_t WS_VT = WS_QK + 6 * SZ_ACT;
constexpr size_t WS_GATE = WS_VT + 3 * SZ_ACT;
constexpr size_t WS_OG = WS_GATE + SZ_ACT;
constexpr size_t WS_Y = WS_OG + 3 * SZ_ACT;
constexpr size_t WS_XN8 = WS_Y + SZ_ACT;
constexpr size_t WS_RSS = WS_XN8 + SZ_ACT / 2;
constexpr size_t WS_END = WS_RSS + 4 * (size_t)MTOK * 4;
constexpr size_t WS_BAR = 65536;
constexpr int LDS_BYTES = 147456;

typedef unsigned short bf16;
typedef unsigned v4u __attribute__((ext_vector_type(4)));
typedef unsigned v2u __attribute__((ext_vector_type(2)));
typedef float f32x4 __attribute__((ext_vector_type(4)));
typedef float f32x2v __attribute__((ext_vector_type(2)));
typedef float f32x16 __attribute__((ext_vector_type(16)));
typedef short bf16x8 __attribute__((ext_vector_type(8)));
typedef __bf16 bf16x2_t __attribute__((ext_vector_type(2)));
#define LAS __attribute__((address_space(3)))
#define MFMA32(a, b, c) __builtin_amdgcn_mfma_f32_32x32x16_bf16((a), (b), (c), 0, 0, 0)
__device__ __forceinline__ unsigned pk2(float lo, float hi) { f32x2v v = {lo, hi}; bf16x2_t b = __builtin_convertvector(v, bf16x2_t); return __builtin_bit_cast(unsigned, b); }
__device__ __forceinline__ float bflo(unsigned w) { return __builtin_bit_cast(float, w << 16); }
__device__ __forceinline__ float bfhi(unsigned w) { return __builtin_bit_cast(float, w & 0xffff0000u); }
__device__ __forceinline__ float wave_sum(float v) {
#pragma unroll
    for (int o = 1; o < 64; o <<= 1) v += __shfl_xor(v, o);
    return v;
}

#define XB_TMO      128
#define XB_XCNT(j)  (256  + 64 * (j))
#define XB_XSUB(j)  (1280 + 64 * (j))
#define XB_XGEN(j)  (2304 + 64 * (j))
#define XB_TOP      3328
#define XB_TOPGEN   3392
#define XCD_BAR_WORDS 3456
#define XB_SPIN_CAP (1u << 18)

__device__ __forceinline__ unsigned xb_ld(unsigned* p)              { return __hip_atomic_load(p, __ATOMIC_RELAXED, __HIP_MEMORY_SCOPE_AGENT); }
__device__ __forceinline__ unsigned xb_add(unsigned* p, unsigned v) { return __hip_atomic_fetch_add(p, v, __ATOMIC_RELAXED, __HIP_MEMORY_SCOPE_AGENT); }
__device__ __forceinline__ unsigned xb_xcc_id() { return (unsigned)__builtin_amdgcn_s_getreg((3 << 11) | 20) & 0xFu; }
#define XB_SPIN(cond, bar) do { unsigned _sp = 0; while (cond) { __builtin_amdgcn_s_sleep(1); \
    if ((++_sp & 255u) == 0u) { if (xb_ld(&(bar)[XB_TMO])) break; if (_sp > XB_SPIN_CAP) { atomicAdd(&(bar)[XB_TMO], 1u); break; } } } } while (0)

struct XcdBarrier {
    int w;
    unsigned* bar; unsigned x;
    volatile LAS unsigned* st;
};

__device__ __forceinline__ XcdBarrier xcd_barrier_post(unsigned* bar, volatile LAS unsigned* st, int w) {
    XcdBarrier b; b.w = w; b.bar = bar; b.x = xb_xcc_id(); b.st = st;
    if (w == 0 && lane_id() == 0) (void)xb_add(&bar[XB_XCNT(b.x)], 1u);
    return b;
}
__device__ __forceinline__ void xcd_barrier_complete(unsigned* bar, unsigned x, unsigned& nloc, unsigned& nx) {
    const unsigned G = gridDim.x * gridDim.y * gridDim.z;
    unsigned sum, cnt, mine, sp = 0u;
    for (;;) {
        sum = 0u; cnt = 0u; mine = 0u;
#pragma unroll
        for (unsigned j = 0; j < 16; ++j) { const unsigned c = xb_ld(&bar[XB_XCNT(j)]); sum += c; cnt += (c > 0u) ? 1u : 0u; mine = (j == x) ? c : mine; }
        if (sum == G) break;
        __builtin_amdgcn_s_sleep(1);
        if ((++sp & 255u) == 0u) { if (xb_ld(&bar[XB_TMO])) break; if (sp > XB_SPIN_CAP) { atomicAdd(&bar[XB_TMO], 1u); break; } }
    }
    nloc = mine > 0u ? mine : 1u; nx = cnt > 0u ? cnt : 1u;
}

__device__ __forceinline__ void xcd_barrier(const XcdBarrier& b) {
    asm volatile("s_waitcnt vmcnt(0)" ::: "memory");
    __syncthreads();
    if (b.w == 0 && lane_id() == 0) {
        unsigned* bar = b.bar;
        __builtin_amdgcn_s_waitcnt(0);
        unsigned nloc = b.st[0], nx = b.st[1];
        if (nloc == 0u) { xcd_barrier_complete(bar, b.x, nloc, nx); b.st[0] = nloc; b.st[1] = nx; }
        const unsigned old = xb_add(&bar[XB_XSUB(b.x)], 1u);
        const unsigned gen = old / nloc;
        if (old + 1u == (gen + 1u) * nloc) {
            __builtin_amdgcn_fence(__ATOMIC_RELEASE, "agent");
            asm volatile("s_waitcnt vmcnt(0)" ::: "memory");
            const unsigned og = xb_add(&bar[XB_TOP], 1u);
            const unsigned tg = og / nx;
            if (og + 1u == (tg + 1u) * nx) xb_add(&bar[XB_TOPGEN], 1u);
            else XB_SPIN(xb_ld(&bar[XB_TOPGEN]) == tg, bar);
            __builtin_amdgcn_fence(__ATOMIC_ACQUIRE, "agent");
            xb_add(&bar[XB_XGEN(b.x)], 1u);
            asm volatile("s_waitcnt vmcnt(0)" ::: "memory");
        } else {
            XB_SPIN(xb_ld(&bar[XB_XGEN(b.x)]) == gen, bar);
            __builtin_amdgcn_fence(__ATOMIC_ACQUIRE, "agent");
            asm volatile("s_waitcnt vmcnt(0)" ::: "memory");
        }
    }
    __syncthreads();
}

__device__ __forceinline__ int launder_s(int v) { asm volatile("" : "+s"(v)); return v; }
__device__ __forceinline__ int launder(int v) { asm volatile("" : "+v"(v)); return v; }
struct Args {
    const float* x; const int* pos; const float* a_norm_g; const float* a_w_in; const float* a_w_out; const float* b_norm_g; const float* b_w_in;
    const float* b_ln_g; const float* b_ln_b; const float* b_w_s; const float* b_b_s; const float* b_w_out; const float* final_g;
    float* out; unsigned char* ws; double invf[16];
    int ph_lo, ph_hi;
};

__device__ __forceinline__ void p0_transpose_item(const float* W, int K, int N, bf16* WT, int row_off, LAS float* scr, int kb, int nb, int lane) {
    const int k0 = 64 * kb, n0 = 32 * nb;
    float wv[32];
#pragma unroll
    for (int i = 0; i < 32; ++i) wv[i] = W[(size_t)(k0 + 2 * i + (lane >> 5)) * N + n0 + (lane & 31)];
#pragma unroll
    for (int i = 0; i < 32; ++i) scr[(2 * i + (lane >> 5)) * 33 + (lane & 31)] = wv[i];
    asm volatile("s_waitcnt lgkmcnt(0)" ::: "memory");
    const int c = lane & 7;
#pragma unroll
    for (int j = 0; j < 4; ++j) { const int n = (lane >> 3) + 8 * j; const LAS float* s = scr + (8 * c) * 33 + n;
        v4u o; o.x = pk2(s[0 * 33], s[1 * 33]); o.y = pk2(s[2 * 33], s[3 * 33]); o.z = pk2(s[4 * 33], s[5 * 33]); o.w = pk2(s[6 * 33], s[7 * 33]);
        *(v4u*)(WT + (size_t)(row_off + n0 + n) * K + k0 + 8 * c) = o; }
    asm volatile("s_waitcnt lgkmcnt(0)" ::: "memory");
}
constexpr float W8_SCALE = 32.0f;
__device__ __forceinline__ unsigned pk4_fp8(float a, float b, float c, float d) {
    a = fminf(fmaxf(a, -448.f), 448.f); b = fminf(fmaxf(b, -448.f), 448.f); c = fminf(fmaxf(c, -448.f), 448.f); d = fminf(fmaxf(d, -448.f), 448.f);
    int w = 0; w = __builtin_amdgcn_cvt_pk_fp8_f32(a, b, w, false); w = __builtin_amdgcn_cvt_pk_fp8_f32(c, d, w, true); return (unsigned)w; }
__device__ __forceinline__ void p0_transpose_item_f8(const float* W, int K, int N, unsigned char* WT, int row_off, LAS float* scr, int kb, int nb, int lane) {
    const int k0 = 64 * kb, n0 = 32 * nb;
    float wv[32];
#pragma unroll
    for (int i = 0; i < 32; ++i) wv[i] = W[(size_t)(k0 + 2 * i + (lane >> 5)) * N + n0 + (lane & 31)];
#pragma unroll
    for (int i = 0; i < 32; ++i) scr[(2 * i + (lane >> 5)) * 33 + (lane & 31)] = wv[i] * W8_SCALE;
    asm volatile("s_waitcnt lgkmcnt(0)" ::: "memory");
    const int c = lane & 7;
#pragma unroll
    for (int j = 0; j < 4; ++j) { const int n = (lane >> 3) + 8 * j; const LAS float* s = scr + (8 * c) * 33 + n;
        v2u o; o.x = pk4_fp8(s[0 * 33], s[1 * 33], s[2 * 33], s[3 * 33]); o.y = pk4_fp8(s[4 * 33], s[5 * 33], s[6 * 33], s[7 * 33]);
        *(v2u*)(WT + (size_t)(row_off + n0 + n) * K + k0 + 8 * c) = o; }
    asm volatile("s_waitcnt lgkmcnt(0)" ::: "memory");
}
template <bool OB16, bool OF32, bool OF8> __device__ __forceinline__ void rms_row(const float* xrow, const float* g, bf16* o16, float* o32, unsigned char* o8, int lane) {
    const f32x4* xr = (const f32x4*)xrow + lane; const f32x4* gr = (const f32x4*)g + lane;
    f32x4 v[8]; float s = 0.f;
#pragma unroll
    for (int j = 0; j < 8; ++j) { v[j] = xr[64 * j]; s += (v[j].x * v[j].x + v[j].y * v[j].y) + (v[j].z * v[j].z + v[j].w * v[j].w); }
    const float rstd = 1.0f / sqrtf(wave_sum(s) * (1.0f / DM) + RMS_EPS);
#pragma unroll
    for (int j = 0; j < 8; ++j) { const f32x4 gg = gr[64 * j]; const f32x4 y = v[j] * rstd * gg;
        if (OF32) ((f32x4*)o32 + lane)[64 * j] = y;
        if (OF8) ((unsigned*)o8 + lane)[64 * j] = pk4_fp8(y.x, y.y, y.z, y.w);
        if (OB16) { v2u w; w.x = pk2(y.x, y.y); w.y = pk2(y.z, y.w); ((v2u*)o16 + lane)[64 * j] = w; } }
}

constexpr float C2S = 0.08838834764831845f * 1.4426950408889634f;
constexpr int ATT_KP = 144, ATT_VP = 80;
constexpr int ATT_KB = 32 * ATT_KP, ATT_VB = 128 * ATT_VP, ATT_BUF = ATT_KB + ATT_VB;
__device__ __forceinline__ bf16x8 f8x8_to_bf16x8(v2u w) {
    const f32x2v a = __builtin_amdgcn_cvt_pk_f32_fp8((int)w.x, false), b = __builtin_amdgcn_cvt_pk_f32_fp8((int)w.x, true), c = __builtin_amdgcn_cvt_pk_f32_fp8((int)w.y, false), d = __builtin_amdgcn_cvt_pk_f32_fp8((int)w.y, true);
    v4u o; o.x = pk2(a.x, a.y); o.y = pk2(b.x, b.y); o.z = pk2(c.x, c.y); o.w = pk2(d.x, d.y); return __builtin_bit_cast(bf16x8, o); }
struct AttPair { unsigned uq, uk, uv, orow; int j0, g; };
__device__ __forceinline__ AttPair att_decode(int pi, int grp, int qw) {
    AttPair d; const int uid = 2 * pi + grp, g = 2 - (uid >> 10), rest = uid & 1023, blk = rest & 15, h = (rest >> 4) & 15, b = rest >> 8;
    const int dsh = 2 * g; const bool has_prev = (blk & ((16 >> dsh) - 1)) != 0;
    d.j0 = __builtin_amdgcn_readfirstlane(has_prev ? 0 : 4); d.g = __builtin_amdgcn_readfirstlane(g);
    d.uq = __builtin_amdgcn_readfirstlane((unsigned)((((g * 2 + 0) * 4 + b) * 16 + h) * 2048 + blk * 128 + qw * 32) * 128u);
    d.uk = __builtin_amdgcn_readfirstlane((unsigned)((((g * 2 + 1) * 4 + b) * 16 + h) * 2048 + blk * 128 - 128) * 128u);
    d.uv = __builtin_amdgcn_readfirstlane((unsigned)(g * 2048 * 8192 + (b * 64 + blk * 4 - 4) * 65536 + h * 128 * 32) * 2u);
    d.orow = __builtin_amdgcn_readfirstlane((unsigned)(((g * 4 + b) * 16 + h) * 2048 + blk * 128 + qw * 32));
    return d;
}
__device__ __forceinline__ void attn_phase(const bf16* QK, const bf16* VT, bf16* OG, float* LSE, int bx, int G, int wave, int lane, LAS unsigned char* lds) {
    const int q = lane & 31, hh = lane >> 5, grp = wave >> 2, qw = wave & 3;
    const int kperm = (q & 0x13) | ((q & 4) << 1) | ((q & 8) >> 1);
    const char* QKc = (const char*)QK; const char* VTc = (const char*)VT;
    LAS unsigned char* gl = lds + grp * (2 * ATT_BUF);
    const int L2 = (qw * 64 + lane) * 2, L1 = qw * 64 + lane;
    const unsigned kw0 = (unsigned)((L1 >> 3) * ATT_KP + (L1 & 7) * 16);
    const unsigned vw0 = (unsigned)(ATT_KB + (L2 >> 2) * ATT_VP + (L2 & 3) * 16), vw1 = (unsigned)(ATT_KB + ((L2 + 1) >> 2) * ATT_VP + ((L2 + 1) & 3) * 16);
    const unsigned kr = (unsigned)(kperm * ATT_KP + 8 * hh), vr = (unsigned)(ATT_KB + q * ATT_VP + 16 * hh);
    const unsigned lqo = (unsigned)(q * 128 + 8 * hh);
    int pi = bx; if (pi >= 1536) return;
    v4u st[4][3]; long qf[8], qn[8];
#define ATT_FETCH(P, J, D) do { const char* kp_ = QKc + ((P).uk + (unsigned)(J) * 4096u + (unsigned)L1 * 16u); const char* vp_ = VTc + ((P).uv + (unsigned)(J) * 131072u + (unsigned)L2 * 16u); \
            D[0] = *(const v4u*)kp_; D[1] = *(const v4u*)vp_; D[2] = *(const v4u*)(vp_ + 16); } while (0)
#define ATT_PARK(J, D) do { LAS unsigned char* wb_ = gl + ((J) & 1) * ATT_BUF; *(LAS v4u*)(wb_ + kw0) = D[0]; *(LAS v4u*)(wb_ + vw0) = D[1]; *(LAS v4u*)(wb_ + vw1) = D[2]; } while (0)
#define ATT_LDQ(P, D) do { const char* qp_ = QKc + ((P).uq + lqo); _Pragma("unroll") for (int c = 0; c < 8; ++c) D[c] = *(const long*)(qp_ + 16 * c); } while (0)
    AttPair cur = att_decode(pi, grp, qw);
    ATT_LDQ(cur, qf);
    ATT_FETCH(cur, cur.j0, st[0]); ATT_FETCH(cur, cur.j0 + 1, st[1]); ATT_FETCH(cur, cur.j0 + 2, st[2]); ATT_FETCH(cur, cur.j0 + 3, st[3]);
    ATT_PARK(0, st[0]);
    asm volatile("s_waitcnt lgkmcnt(0)\n\ts_barrier" ::: "memory");
    for (;;) {
        const bool has_next = pi + G < 1536;
        AttPair nxt = cur; if (has_next) nxt = att_decode(pi + G, grp, qw);
        const int j0 = cur.j0;
        f32x16 O[4];
#pragma unroll
        for (int db = 0; db < 4; ++db)
#pragma unroll
            for (int i = 0; i < 16; ++i) O[db][i] = 0.f;
        float m = -INFINITY, l = 0.f;
#pragma unroll
        for (int j = 0; j < 8; ++j) {
            if (j < 4 && cur.g == 2) continue;
            if (j < 4) { if (j0 == 0) ATT_FETCH(cur, j + 4, st[j & 3]); }
            else if (has_next) { ATT_FETCH(nxt, nxt.j0 + (j - 4), st[j & 3]); if (j == 4) ATT_LDQ(nxt, qn); }
            const int t = j - qw;
            if (j >= j0 && t >= 0 && t <= 4) {
                const LAS unsigned char* rb = gl + (j & 1) * ATT_BUF;
                f32x16 S;
#pragma unroll
                for (int i = 0; i < 16; ++i) S[i] = 0.f;
                long kf[8]; bf16x8 vf[4][2];
#pragma unroll
                for (int c = 0; c < 8; ++c) kf[c] = *(const LAS long*)(rb + kr + 16 * c);
#pragma unroll
                for (int db = 0; db < 4; ++db) { vf[db][0] = *(const LAS bf16x8*)(rb + vr + db * 32 * ATT_VP); vf[db][1] = *(const LAS bf16x8*)(rb + vr + db * 32 * ATT_VP + 32); }
                __builtin_amdgcn_sched_barrier(0);
#pragma unroll
                for (int c = 0; c < 8; ++c) S = __builtin_amdgcn_mfma_f32_32x32x16_fp8_fp8(kf[c], qf[c], S, 0, 0, 0);
                if (t == 0) {
#pragma unroll
                    for (int i = 0; i < 16; ++i) { const int kt = 16 * (i >> 3) + 8 * hh + (i & 7); if (kt < q) S[i] = -INFINITY; }
                }
                if (t == 4) {
#pragma unroll
                    for (int i = 0; i < 16; ++i) { const int kt = 16 * (i >> 3) + 8 * hh + (i & 7); if (kt > q) S[i] = -INFINITY; }
                }
                float mx = S[0];
#pragma unroll
                for (int i = 1; i < 16; ++i) mx = fmaxf(mx, S[i]);
                mx = fmaxf(mx, __shfl_xor(mx, 32)) * C2S;
                if (__builtin_amdgcn_ballot_w64(mx > m + 8.0f) != 0ull) { const float mn = fmaxf(m, mx), alpha = __builtin_amdgcn_exp2f(m - mn); l *= alpha; m = mn;
#pragma unroll
                    for (int db = 0; db < 4; ++db)
#pragma unroll
                        for (int i = 0; i < 16; ++i) O[db][i] *= alpha; }
                float rs = 0.f;
#pragma unroll
                for (int i = 0; i < 16; ++i) { S[i] = __builtin_amdgcn_exp2f(__builtin_fmaf(S[i], C2S, -m)); rs += S[i]; }
                l += rs;
                v4u w0, w1;
                w0.x = pk2(S[0], S[1]); w0.y = pk2(S[2], S[3]); w0.z = pk2(S[4], S[5]); w0.w = pk2(S[6], S[7]);
                w1.x = pk2(S[8], S[9]); w1.y = pk2(S[10], S[11]); w1.z = pk2(S[12], S[13]); w1.w = pk2(S[14], S[15]);
                const bf16x8 ps0 = __builtin_bit_cast(bf16x8, w0), ps1 = __builtin_bit_cast(bf16x8, w1);
#pragma unroll
                for (int db = 0; db < 4; ++db) { O[db] = MFMA32(vf[db][0], ps0, O[db]); O[db] = MFMA32(vf[db][1], ps1, O[db]); }
            }
            if (j < 7) { if (j + 1 >= j0 + 1) ATT_PARK(j + 1, st[(j + 1) & 3]); }
            else if (has_next) ATT_PARK(0, st[0]);
            asm volatile("s_waitcnt lgkmcnt(0)\n\ts_barrier" ::: "memory");
        }
        l += __shfl_xor(l, 32);
        const float inv = 1.0f / l, lse2 = m + __builtin_amdgcn_logf(l);
        bf16* op = OG + (size_t)(cur.orow + q) * 128 + 4 * hh;
#pragma unroll
        for (int db = 0; db < 4; ++db)
#pragma unroll
            for (int i4 = 0; i4 < 4; ++i4) { v2u w; w.x = pk2(O[db][4 * i4] * inv, O[db][4 * i4 + 1] * inv); w.y = pk2(O[db][4 * i4 + 2] * inv, O[db][4 * i4 + 3] * inv);
                *(v2u*)(op + db * 32 + 8 * i4) = w; }
        if (hh == 0) LSE[cur.orow + q] = lse2;
        if (!has_next) break;
        cur = nxt; pi += G;
#pragma unroll
        for (int c = 0; c < 8; ++c) qf[c] = qn[c];
    }
#undef ATT_FETCH
#undef ATT_PARK
#undef ATT_LDQ
}
__device__ __forceinline__ void merge_phase(const bf16* OG, const float* LSE, const bf16* GATE, bf16* Y, int gw, int NGW, int lane) {
    for (int row = gw; row < MTOK; row += NGW) { const int b = row >> 11, s = row & 2047;
#pragma unroll
        for (int j = 0; j < 4; ++j) { const int col = lane * 8 + 512 * j, h = col >> 7, e = col & 127;
            size_t r[3]; float lg[3];
#pragma unroll
            for (int g = 0; g < 3; ++g) { const int dsh = 2 * g, p = ((s & ((1 << dsh) - 1)) << (11 - dsh)) | (s >> dsh); r[g] = ((size_t)(g * 4 + b) * 16 + h) * 2048 + p; lg[g] = LSE[r[g]]; }
            const float mx = fmaxf(lg[0], fmaxf(lg[1], lg[2]));
            float w0 = __builtin_amdgcn_exp2f(lg[0] - mx), w1 = __builtin_amdgcn_exp2f(lg[1] - mx), w2 = __builtin_amdgcn_exp2f(lg[2] - mx);
            const float inv = 1.0f / (w0 + w1 + w2); w0 *= inv; w1 *= inv; w2 *= inv;
            const v4u a = *(const v4u*)(OG + r[0] * 128 + e), bb = *(const v4u*)(OG + r[1] * 128 + e), c = *(const v4u*)(OG + r[2] * 128 + e), gt = *(const v4u*)(GATE + (size_t)row * 2048 + col);
            v4u o;
#pragma unroll
            for (int k = 0; k < 4; ++k) {
                const float ylo = (w0 * bflo(a[k]) + w1 * bflo(bb[k]) + w2 * bflo(c[k])) * bflo(gt[k]);
                const float yhi = (w0 * bfhi(a[k]) + w1 * bfhi(bb[k]) + w2 * bfhi(c[k])) * bfhi(gt[k]);
                o[k] = pk2(ylo, yhi); }
            *(v4u*)(Y + (size_t)row * 2048 + col) = o; }
    }
}
__device__ __forceinline__ void sgu_phase(const bf16* VTB, const float* STATS, const float* LNG, const float* LNB, const bf16* WM, const float* BS, const bf16* U, const bf16* ZS, bf16* Y,
                                          int gw, int NGW, int lane) {
    const int r = lane & 31, hh = lane >> 5;
    for (int wu = gw; wu < 4096; wu += NGW) {
        const int cblk = wu & 3, g = (wu >> 2) & 15, chunk = (wu >> 6) & 15, b = wu >> 10;
        const int ch = g * 128 + cblk * 32 + r, tok0 = b * 2048 + chunk * 128;
        v4u raw[8];
#pragma unroll
        for (int ks = 0; ks < 8; ++ks) raw[ks] = *(const v4u*)(VTB + (size_t)((tok0 + 16 * ks) >> 5) * 65536 + (size_t)ch * 32 + ((16 * ks) & 31) + 8 * hh);
        v2u uu[4][4], zz[4][4]; float bs[4];
        const size_t rowoff0 = (size_t)(tok0 + r) * 2048 + g * 128 + cblk * 32 + 4 * hh;
#pragma unroll
        for (int tb = 0; tb < 4; ++tb) { bs[tb] = BS[g * 128 + tb * 32 + r];
#pragma unroll
            for (int i4 = 0; i4 < 4; ++i4) { uu[tb][i4] = *(const v2u*)(U + rowoff0 + (size_t)tb * 32 * 2048 + 8 * i4); zz[tb][i4] = *(const v2u*)(ZS + rowoff0 + (size_t)tb * 32 * 2048 + 8 * i4); } }
        const float lng = LNG[ch], lnb = LNB[ch];
        bf16x8 af[8];
#pragma unroll
        for (int ks = 0; ks < 8; ++ks) { v4u o; const f32x4* sp = (const f32x4*)(STATS + 2 * (size_t)(tok0 + 16 * ks + 8 * hh));
#pragma unroll
            for (int k = 0; k < 4; ++k) { const f32x4 sv = sp[k];
                const float mu0 = sv.x * (1.0f / 2048), mu1 = sv.z * (1.0f / 2048);
                const float a0 = lng * __builtin_amdgcn_rsqf(fmaxf(sv.y * (1.0f / 2048) - mu0 * mu0, 0.f) + LN_EPS), a1 = lng * __builtin_amdgcn_rsqf(fmaxf(sv.w * (1.0f / 2048) - mu1 * mu1, 0.f) + LN_EPS);
                o[k] = pk2(bflo(raw[ks][k]) * a0 + (lnb - mu0 * a0), bfhi(raw[ks][k]) * a1 + (lnb - mu1 * a1)); }
            af[ks] = __builtin_bit_cast(bf16x8, o); }
        bf16x8 wf[2][8];
        { const bf16* wp = WM + (size_t)(g * 128 + r) * 128 + 8 * hh; wf[0][0] = *(const bf16x8*)wp; wf[0][1] = *(const bf16x8*)(wp + 16); }
#pragma unroll
        for (int tb = 0; tb < 4; ++tb) {
            f32x16 D;
#pragma unroll
            for (int i = 0; i < 16; ++i) D[i] = 0.f;
#pragma unroll
            for (int ks = 0; ks < 2 * tb + 2; ++ks) D = MFMA32(af[ks], wf[tb & 1][ks], D);
            __builtin_amdgcn_sched_barrier(0);
            if (tb < 3) { const bf16* wp = WM + (size_t)(g * 128 + (tb + 1) * 32 + r) * 128 + 8 * hh;
#pragma unroll
                for (int ks = 0; ks < 2 * tb + 4; ++ks) wf[(tb + 1) & 1][ks] = *(const bf16x8*)(wp + 16 * ks); }
            __builtin_amdgcn_sched_barrier(0);
#pragma unroll
            for (int i4 = 0; i4 < 4; ++i4) { const v2u u4 = uu[tb][i4], z4 = zz[tb][i4];
                v2u w; w.x = pk2(bflo(u4.x) * (D[4 * i4] + bs[tb]) * bflo(z4.x), bfhi(u4.x) * (D[4 * i4 + 1] + bs[tb]) * bfhi(z4.x));
                w.y = pk2(bflo(u4.y) * (D[4 * i4 + 2] + bs[tb]) * bflo(z4.y), bfhi(u4.y) * (D[4 * i4 + 3] + bs[tb]) * bfhi(z4.y));
                *(v2u*)(Y + rowoff0 + (size_t)tb * 32 * 2048 + 8 * i4) = w; }
        }
    }
}

constexpr int N_PHASES = 19;
__global__ void __launch_bounds__(NTHR) trunk_fwd(Args args) {
    extern __shared__ __attribute__((aligned(16))) unsigned char lds[];
    const int wave = __builtin_amdgcn_readfirstlane(threadIdx.x >> 6);
#define tid (wave * 64 + lane_id())
#define lane lane_id()
    const int G = gridDim.x, bx = blockIdx.x;
    const int gw = bx * NWAVES + wave, NGW = G * NWAVES;
    unsigned char* ws = args.ws;
#define WS_PTRS __attribute__((address_space(1))) unsigned char* wg_ = (__attribute__((address_space(1))) unsigned char*)ws; asm volatile("" : "+s"(wg_)); unsigned char* wl_ = (unsigned char*)wg_;     \
    bf16* WAin = (bf16*)(wl_ + WS_WAIN); bf16* WAout = (bf16*)(wl_ + WS_WAOUT); bf16* WBin = (bf16*)(wl_ + WS_WBIN); bf16* WBout = (bf16*)(wl_ + WS_WBOUT); bf16* WM = (bf16*)(wl_ + WS_WM); float* COS = (float*)(wl_ + WS_COS); float* SIN = (float*)(wl_ + WS_SIN); float* STATS = (float*)(wl_ + WS_STATS); float* LSE = (float*)(wl_ + WS_LSE); float* X = (float*)(wl_ + WS_X); bf16* XN = (bf16*)(wl_ + WS_XN); bf16* QK = (bf16*)(wl_ + WS_QK); bf16* VT = (bf16*)(wl_ + WS_VT); bf16* GATE = (bf16*)(wl_ + WS_GATE); bf16* OG = (bf16*)(wl_ + WS_OG); bf16* Y = (bf16*)(wl_ + WS_Y); bf16* U = OG; bf16* ZS = OG + (size_t)MTOK * 2048; unsigned char* XN8 = wl_ + WS_XN8; float* RSS = (float*)(wl_ + WS_RSS); (void)RSS; (void)WAin; (void)WAout; (void)WBin; (void)WBout; (void)WM; (void)COS; (void)SIN; (void)STATS; (void)LSE; (void)X; (void)XN; (void)QK; (void)VT; (void)GATE; (void)OG; (void)Y; (void)U; (void)ZS; (void)XN8;
    const int lo = args.ph_lo, hi = args.ph_hi; (void)lo; (void)hi;
#if MK_PER_PHASE
#define IN(k) (lo <= (k) && (k) < hi)
#else
#define IN(k) true
#endif
    volatile LAS unsigned* MISC = (volatile LAS unsigned*)((LAS unsigned char*)lds + 131072 + 320);
    if (tid < 32) MISC[tid] = 0u;
    unsigned* barw = (unsigned*)(ws + WS_BAR);
#if !MK_PER_PHASE
    if (bx == 0) for (int i = tid; i < XCD_BAR_WORDS; i += NTHR) __hip_atomic_store(barw + i, 0u, __ATOMIC_RELAXED, __HIP_MEMORY_SCOPE_AGENT);
#endif
    __syncthreads();
    XcdBarrier xbar; xbar.w = wave; xbar.bar = barw; xbar.x = 0; xbar.st = MISC + 8;
#if MK_PER_PHASE
#define SEAM(k) do { } while (0)
#else
#define SEAM(k) do { if (IN(k) && IN((k) + 1)) xcd_barrier(xbar); } while (0)
#endif
    if (IN(0)) { WS_PTRS
        LAS float* scr = (LAS float*)((LAS unsigned char*)lds + wave * 16384);
        constexpr int I_AIN = 32 * (A_IN / 32), I_SQ = 32 * (DM / 32), I_BIN = 32 * (B_IN / 32);
        constexpr int NITEMS = 2 * (I_AIN + I_SQ + I_BIN + I_SQ);
        for (int it = gw; it < NITEMS; it += NGW) {
            int r = it; const int j = r / (NITEMS / 2); r -= j * (NITEMS / 2);
            if (r < I_AIN) { const int nblk = A_IN / 32, kb = r / nblk, nb = r % nblk, sb = (nb * 32) / 2048;
                unsigned char* W8 = (unsigned char*)WAin + (size_t)j * A_IN * DM * 2; bf16* W16 = (bf16*)(W8 + 48 * MiB);
                const float* src = args.a_w_in + (size_t)j * DM * A_IN;
                if (sb < 9 && (sb % 3) < 2) p0_transpose_item_f8(src, DM, A_IN, W8, (2 * (sb / 3) + (sb % 3) - sb) * 2048, scr, kb, nb, lane);
                else if (A_VG_FP8 && !(A_GATE_BF16 && sb == 9)) p0_transpose_item_f8(src, DM, A_IN, W8, ((sb == 9 ? 6 : 7 + sb / 3) - sb) * 2048, scr, kb, nb, lane);
                else p0_transpose_item(src, DM, A_IN, W16, ((sb == 9 ? 0 : 1 + sb / 3) - sb) * 2048, scr, kb, nb, lane);
                continue; } r -= I_AIN;
            if (r < I_SQ) { p0_transpose_item(args.a_w_out + (size_t)j * DM * DM, DM, DM, WAout + (size_t)j * DM * DM, 0, scr, r / (DM / 32), r % (DM / 32), lane); continue; } r -= I_SQ;
            if (r < I_BIN) { const int nblk = B_IN / 32, kb = r / nblk, nb = r % nblk, sb = (nb * 32) / 2048;
                const int db = sb == 0 ? 0 : (sb == 1 ? 2 : 1);
                p0_transpose_item(args.b_w_in + (size_t)j * DM * B_IN, DM, B_IN, WBin + (size_t)j * B_IN * DM, (db - sb) * 2048, scr, kb, nb, lane); continue; } r -= I_BIN;
            p0_transpose_item(args.b_w_out + (size_t)j * DM * DM, DM, DM, WBout + (size_t)j * DM * DM, 0, scr, r / (DM / 32), r % (DM / 32), lane);
        }
        const int gt = bx * NTHR + tid, NGT = G * NTHR;
        for (int i = gt; i < 2 * 16 * 128 * 128 / 2; i += NGT) { const int e = 2 * i, s = e & 127, t = (e >> 7) & 127;
            const f32x2v w = *(const f32x2v*)(args.b_w_s + e); ((unsigned*)WM)[i] = pk2(s <= t ? w.x : 0.f, s + 1 <= t ? w.y : 0.f); }
        for (int i = gt; i < MTOK * 16; i += NGT) { const int tok = i >> 4, f = i & 15; const double rev = (double)args.pos[tok] * args.invf[f]; const float fr = (float)(rev - floor(rev));
            COS[i] = __builtin_amdgcn_cosf(fr); SIN[i] = __builtin_amdgcn_sinf(fr); }
        for (int i = gt; i < 2 * MTOK * 2; i += NGT) STATS[i] = 0.f;
        for (int i = gt; i < 4 * MTOK; i += NGT) RSS[i] = i < MTOK ? 2048.0f * (1.0f - 1e-6f) : 0.f;
        for (int m = gw; m < MTOK; m += NGW) rms_row<(!A_VG_FP8 || A_GATE_BF16), false, true>(args.x + (size_t)m * DM, args.a_norm_g, XN + (size_t)m * DM, nullptr, XN8 + (size_t)m * DM, lane);
    }
#if !MK_PER_PHASE
    cg::this_grid().sync();
    xbar = xcd_barrier_post(barw, MISC + 8, wave);
#endif
    for (int rep = 0; rep < 2; ++rep) {
        const int P = 1 + 9 * rep;
        if (IN(P)) { WS_PTRS
            const char* W8 = (const char*)WAin + (size_t)rep * A_IN * DM * 2;
            const float* rssA = RSS + (size_t)(2 * rep) * MTOK;
            const pg8::EpiA1 e1{QK, GATE, COS, SIN, 1.0f / W8_SCALE, 0, rssA};
#if A_VG_FP8 && A_GATE_BF16
            { pg8::MultiOrder S{{(const char*)XN8, W8, 32, 48, 1}, {W8 + (size_t)14336 * DM, (const char*)XN8, 8, 32, 1}, {W8 + (size_t)16384 * DM, (const char*)XN8, 8, 32, 4},
                                {W8 + (size_t)18432 * DM, (const char*)XN8, 8, 32, 16}, 4, launder_s(G), launder_s(bx), DM};
              pg8::EpiAllA E{e1, pg8::EpiPlain{VT, 1.0f / W8_SCALE, rssA, 0}, 1};
              pg8::gemm_phase<pg8::EpiAllA, pg8::MultiOrder, true, true, true>((LAS unsigned char*)lds, DM, S, E, wave); }
            { const char* W16 = W8 + 48 * MiB;
              pg8::MultiOrder S{{(const char*)XN, W16, 32, 8, 1}, {nullptr, nullptr, 0, 0, 1}, {nullptr, nullptr, 0, 0, 1}, {nullptr, nullptr, 0, 0, 1}, 1, launder_s(G), launder_s(bx), DM * 2};
              const pg8::EpiA1 eg{QK, GATE, COS, SIN, 1.0f, 48, rssA};
              pg8::gemm_phase<pg8::EpiA1, pg8::MultiOrder, true, true, false>((LAS unsigned char*)lds, DM, S, eg, wave); }
#elif A_VG_FP8
            pg8::MultiOrder S{{(const char*)XN8, W8, 32, 56, 1}, {W8 + (size_t)14336 * DM, (const char*)XN8, 8, 32, 1}, {W8 + (size_t)16384 * DM, (const char*)XN8, 8, 32, 4},
                              {W8 + (size_t)18432 * DM, (const char*)XN8, 8, 32, 16}, 4, launder_s(G), launder_s(bx), DM};
            pg8::EpiAllA E{e1, pg8::EpiPlain{VT, 1.0f / W8_SCALE, rssA, 0}, 1};
            pg8::gemm_phase<pg8::EpiAllA, pg8::MultiOrder, true, true, true>((LAS unsigned char*)lds, DM, S, E, wave);
#else
            { pg8::MultiOrder S{{(const char*)XN8, W8, 32, 48, 1}, {nullptr, nullptr, 0, 0, 1}, {nullptr, nullptr, 0, 0, 1}, {nullptr, nullptr, 0, 0, 1}, 1, launder_s(G), launder_s(bx), DM};
              pg8::gemm_phase<pg8::EpiA1, pg8::MultiOrder, true, true, true>((LAS unsigned char*)lds, DM, S, e1, wave); }
            { const char* W16 = W8 + 48 * MiB;
              pg8::MultiOrder S{{(const char*)XN, W16, 32, 8, 1}, {W16 + (size_t)2048 * DM * 2, (const char*)XN, 8, 32, 1}, {W16 + (size_t)4096 * DM * 2, (const char*)XN, 8, 32, 4},
                                {W16 + (size_t)6144 * DM * 2, (const char*)XN, 8, 32, 16}, 4, launder_s(G), launder_s(bx), DM * 2};
              pg8::EpiAllA E{pg8::EpiA1{QK, GATE, COS, SIN, 1.0f, 48, rssA}, pg8::EpiPlain{VT, 1.0f, rssA, 0}, 1};
              pg8::gemm_phase<pg8::EpiAllA, pg8::MultiOrder, true, true, false>((LAS unsigned char*)lds, DM, S, E, wave); }
#endif
        }
        SEAM(P);
        if (IN(P + 1)) { WS_PTRS attn_phase(QK, VT, OG, LSE, bx, G, wave, launder(lane), (LAS unsigned char*)lds); }
        SEAM(P + 1);
        if (IN(P + 2)) { WS_PTRS merge_phase(OG, LSE, GATE, Y, gw, NGW, launder(lane)); }
        SEAM(P + 2);
        if (IN(P + 3)) { WS_PTRS pg8::MultiOrder S{{(const char*)Y, (const char*)(WAout + (size_t)rep * DM * DM), 32, 8, 1}, {nullptr, nullptr, 0, 0, 1}, {nullptr, nullptr, 0, 0, 1}, {nullptr, nullptr, 0, 0, 1}, 1, launder_s(G), launder_s(bx), DM * 2};
            pg8::EpiOut E{rep == 0 ? args.x : X, X, args.b_norm_g + (size_t)rep * DM, XN, nullptr, RSS + (size_t)(2 * rep + 1) * MTOK};
            pg8::gemm_phase<pg8::EpiOut, pg8::MultiOrder, true, true>((LAS unsigned char*)lds, DM, S, E, wave); }
        SEAM(P + 3);
        if (IN(P + 5)) { WS_PTRS
            const char* W = (const char*)(WBin + (size_t)rep * B_IN * DM);
            pg8::MultiOrder S{{(const char*)XN, W, 32, 16, 1}, {W + (size_t)4096 * DM * 2, (const char*)XN, 8, 32, 1}, {nullptr, nullptr, 0, 0, 1}, {nullptr, nullptr, 0, 0, 1}, 2, launder_s(G), launder_s(bx), DM * 2};
            const float* rssB = RSS + (size_t)(2 * rep + 1) * MTOK;
            pg8::EpiAllB E{pg8::EpiB1{U, ZS, rssB}, pg8::EpiB2{VT, STATS + (size_t)rep * MTOK * 2, rssB}};
            pg8::gemm_phase<pg8::EpiAllB, pg8::MultiOrder, true, true>((LAS unsigned char*)lds, DM, S, E, wave);
        }
        SEAM(P + 5);
        if (IN(P + 6)) { WS_PTRS sgu_phase(VT, STATS + (size_t)rep * MTOK * 2, args.b_ln_g + (size_t)rep * DM, args.b_ln_b + (size_t)rep * DM, WM + (size_t)rep * 16 * 128 * 128, args.b_b_s + (size_t)rep * 16 * 128, U, ZS, Y, gw, NGW, launder(lane)); }
        SEAM(P + 6);
        if (IN(P + 7)) { WS_PTRS pg8::MultiOrder S{{(const char*)Y, (const char*)(WBout + (size_t)rep * DM * DM), 32, 8, 1}, {nullptr, nullptr, 0, 0, 1}, {nullptr, nullptr, 0, 0, 1}, {nullptr, nullptr, 0, 0, 1}, 1, launder_s(G), launder_s(bx), DM * 2};
            pg8::EpiOut E{X, X, rep == 0 ? args.a_norm_g + DM : nullptr, XN, XN8, RSS + (size_t)2 * MTOK};
            pg8::gemm_phase<pg8::EpiOut, pg8::MultiOrder, true, true>((LAS unsigned char*)lds, DM, S, E, wave); }
        if (rep == 1) SEAM(P + 7);
        if (IN(P + 8)) { WS_PTRS const int ln = launder(lane);
            if (rep == 1) { for (int m = gw; m < MTOK; m += NGW) rms_row<false, true, false>(X + (size_t)m * DM, args.final_g, nullptr, args.out + (size_t)m * DM, nullptr, ln); }
        }
        if (rep == 0) SEAM(P + 8);
    }
#undef IN
#undef SEAM
#undef tid
#undef lane
}

extern "C" void kernel_launch(void* const* d_in, const int* in_sizes, int n_in, void* d_out, int out_size, void* d_ws, size_t ws_size, hipStream_t stream) {
    static int grid = 0;
    if (grid == 0) {
        if (n_in != 13 || in_sizes[0] != MTOK * DM || out_size != MTOK * DM || ws_size < WS_END) { fprintf(stderr, "kernel_launch: unexpected shapes / workspace (n_in %d, in0 %d, out %d, ws %zu, need %zu)\n", n_in, n_in > 0 ? in_sizes[0] : -1, out_size, ws_size, (size_t)WS_END); grid = -1; return; }
        int dev = 0, cus = 0, per_cu = 0;
        if (hipGetDevice(&dev) != hipSuccess || hipDeviceGetAttribute(&cus, hipDeviceAttributeMultiprocessorCount, dev) != hipSuccess) { grid = -1; return; }
        if (hipFuncSetAttribute((const void*)trunk_fwd, hipFuncAttributeMaxDynamicSharedMemorySize, LDS_BYTES) != hipSuccess) { fprintf(stderr, "kernel_launch: hipFuncSetAttribute failed\n"); grid = -1; return; }
        if (hipOccupancyMaxActiveBlocksPerMultiprocessor(&per_cu, (const void*)trunk_fwd, NTHR, LDS_BYTES) != hipSuccess || per_cu < 1) { fprintf(stderr, "kernel_launch: occupancy query failed (%d)\n", per_cu); (void)hipGetLastError(); grid = -1; return; }
        grid = cus * per_cu;
    }
    if (grid < 0) return;
    Args a{};
    a.x = (const float*)d_in[0]; a.pos = (const int*)d_in[1]; a.a_norm_g = (const float*)d_in[2]; a.a_w_in = (const float*)d_in[3]; a.a_w_out = (const float*)d_in[4];
    a.b_norm_g = (const float*)d_in[5]; a.b_w_in = (const float*)d_in[6]; a.b_ln_g = (const float*)d_in[7]; a.b_ln_b = (const float*)d_in[8]; a.b_w_s = (const float*)d_in[9];
    a.b_b_s = (const float*)d_in[10]; a.b_w_out = (const float*)d_in[11]; a.final_g = (const float*)d_in[12];
    a.out = (float*)d_out; a.ws = (unsigned char*)d_ws;
    for (int i = 0; i < 16; ++i) a.invf[i] = pow(500000.0, -(double)i / 16.0) / 6.283185307179586476925;
#if MK_PER_PHASE
    for (int p = 0; p < N_PHASES; ++p) { a.ph_lo = p; a.ph_hi = p + 1; hipLaunchKernelGGL(trunk_fwd, dim3(grid), dim3(NTHR), LDS_BYTES, stream, a); }
#else
    a.ph_lo = 0; a.ph_hi = N_PHASES;
    void* kargs[] = {&a};
    const hipError_t e = hipLaunchCooperativeKernel((const void*)trunk_fwd, dim3(grid), dim3(NTHR), kargs, LDS_BYTES, stream);
    if (e != hipSuccess) fprintf(stderr, "kernel_launch: cooperative launch failed: %s (grid %d)\n", hipGetErrorString(e), grid);
#endif
}
```

```cpp
#include <hip/hip_runtime.h>
#include <hip/hip_cooperative_groups.h>
#include <cstdio>
#include <cstdint>
#include <cmath>
namespace cg = cooperative_groups;
#ifndef A_VG_FP8
#define A_VG_FP8 1
#endif
#ifndef A_GATE_BF16
#define A_GATE_BF16 1
#endif
#ifndef MK_PER_PHASE
#define MK_PER_PHASE 0
#endif
__device__ __forceinline__ int lane_id() { int l; asm volatile("v_mbcnt_lo_u32_b32 %0, -1, 0\n\tv_mbcnt_hi_u32_b32 %0, -1, %0" : "=v"(l)); return l; }
namespace pg8 {
#define PG8_LAS __attribute__((address_space(3)))
typedef unsigned short bf16_t;
typedef short bf16x8 __attribute__((ext_vector_type(8)));
typedef float f32x4 __attribute__((ext_vector_type(4)));
typedef unsigned u32x4 __attribute__((ext_vector_type(4)));
typedef int i32x4 __attribute__((ext_vector_type(4)));
constexpr int BM = 256, BK = 64, HALF = 128, HTB = HALF * BK * 2  , STAGE_BYTES = 8 * HTB, NXCD = 8, WGM = 8;

__host__ __device__ __forceinline__ int lds_byte(int r, int c) { const int st = (r >> 4) * 2 + (c >> 5), rr = r & 15, cc = c & 31, ob = rr * 64 + cc * 2; return st * 1024 + (ob ^ (((ob >> 9) & 1) << 5)); }
__host__ __device__ __forceinline__ void stage_rc(int b, int& R, int& C) { const int st = b / 1024, sb = b % 1024, swz = sb ^ (((sb >> 9) & 1) << 5); R = (st >> 1) * 16 + swz / 64; C = (st & 1) * 32 + (swz % 64) / 2; }
__host__ __device__ __forceinline__ int perm32(int rho) { const int n = rho >> 4, i = rho & 15; return 8 * (i >> 2) + 4 * n + (i & 3); }

struct Unit { int pm, pn, k; };
struct Prob { const char* A; const char* B; int nM, nN, bdil; };
struct StaticOrder {
    int nM, nN, nwg, G, c;
    __host__ __device__ void init(int M, int N, int G_, int c_) { nM = M / BM; nN = N / BM; nwg = nM * nN; G = G_; c = c_; }
    __host__ __device__ bool next(int i, Unit& u) const {
        const long L = (long)i * G + c; if (L >= nwg) return false;
        int wgid = (int)L; { const int q = nwg / NXCD, r = nwg % NXCD, xcd = wgid % NXCD, off = wgid / NXCD; wgid = (xcd < r ? xcd * (q + 1) : r * (q + 1) + (xcd - r) * q) + off; }
        const int nig = WGM * nN, gid = wgid / nig, fm = gid * WGM, gsz = (nM - fm) < WGM ? (nM - fm) : WGM;
        u.pm = fm + ((wgid % nig) % gsz); u.pn = (wgid % nig) / gsz; return true;
    }
    __device__ __forceinline__ void a_ready(const Unit&) const {}
    __device__ __forceinline__ void done(const Unit&) const {}
};
struct MultiOrder {
    Prob p0, p1, p2, p3; int np, G, c, rowbytes;
    __device__ __forceinline__ static void map(const Prob& P, int wgid, Unit& u) {
        const int nM = P.nM, nN = P.nN, nwg = nM * nN;
        { const int q = nwg / NXCD, r = nwg % NXCD, xcd = wgid % NXCD, off = wgid / NXCD; wgid = (xcd < r ? xcd * (q + 1) : r * (q + 1) + (xcd - r) * q) + off; }
        const int nig = WGM * nN, gid = wgid / nig, fm = gid * WGM, gsz = (nM - fm) < WGM ? (nM - fm) : WGM;
        u.pm = fm + ((wgid % nig) % gsz); u.pn = (wgid % nig) / gsz;
    }
    __device__ __forceinline__ bool next(int i, Unit& u) const {
        long L = (long)i * G + c;
        { const int n = p0.nM * p0.nN; if (L < n) { map(p0, (int)L, u); u.k = 0; return true; } L -= n; }
        if (np > 1) { const int n = p1.nM * p1.nN; if (L < n) { map(p1, (int)L, u); u.k = 1; return true; } L -= n; }
        if (np > 2) { const int n = p2.nM * p2.nN; if (L < n) { map(p2, (int)L, u); u.k = 2; return true; } L -= n; }
        if (np > 3) { const int n = p3.nM * p3.nN; if (L < n) { map(p3, (int)L, u); u.k = 3; return true; } L -= n; }
        return false;
    }
    __device__ __forceinline__ const char* selA(int k) const { return k == 0 ? p0.A : (k == 1 ? p1.A : (k == 2 ? p2.A : p3.A)); }
    __device__ __forceinline__ const char* selB(int k) const { return k == 0 ? p0.B : (k == 1 ? p1.B : (k == 2 ? p2.B : p3.B)); }
    __device__ __forceinline__ int bdil(const Unit& u) const { return u.k == 0 ? p0.bdil : (u.k == 1 ? p1.bdil : (u.k == 2 ? p2.bdil : p3.bdil)); }
    __device__ __forceinline__ const char* a_base(const Unit& u) const { return selA(u.k) + (size_t)u.pm * 256 * rowbytes; }
    __device__ __forceinline__ const char* b_base(const Unit& u) const { const int d = bdil(u), t8 = u.pn & 7; const int r = (u.pn >> 3) * 2048 + (d == 1 ? 256 * t8 : (d == 4 ? 1024 * (t8 & 1) + (t8 >> 1) : 2 * t8)); return selB(u.k) + (size_t)r * rowbytes; }
    __device__ __forceinline__ void a_ready(const Unit&) const {}
    __device__ __forceinline__ void done(const Unit&) const {}
};


__device__ __forceinline__ unsigned cvt_pk_bf16(float lo, float hi) { unsigned r; asm volatile("v_cvt_pk_bf16_f32 %0, %1, %2" : "=v"(r) : "v"(lo), "v"(hi)); return r; }
typedef float f32x2 __attribute__((ext_vector_type(2)));
__device__ __forceinline__ f32x2 gelu_pk(f32x2 v) {
    const f32x2 av = __builtin_elementwise_abs(v), d = av * 0.2316418882f + 1.0f;
    f32x2 t; t.x = __builtin_amdgcn_rcpf(d.x); t.y = __builtin_amdgcn_rcpf(d.y);
    f32x2 q = t * 0.5307027145f + (-0.7265760135f); q = q * t + 0.7107068705f; q = q * t + (-0.142248368f); q = q * t + 0.127414796f; q = q * t;
    const f32x2 s = (v * v) * (-0.72134752044f);
    f32x2 e; e.x = __builtin_amdgcn_exp2f(s.x); e.y = __builtin_amdgcn_exp2f(s.y);
    const f32x2 m = v * (q * e), r = v - m;
    f32x2 o; o.x = v.x < 0.f ? m.x : r.x; o.y = v.y < 0.f ? m.y : r.y; return o;
}

constexpr float C2 = 0.08838834764831845f * 1.4426950408889634f;
__device__ __forceinline__ float silu_f(float x) { return x * __builtin_amdgcn_rcpf(1.0f + __builtin_amdgcn_exp2f(-1.4426950408889634f * x)); }
__device__ __forceinline__ u32x4 pack8(const f32x4& v0, const f32x4& v1) { u32x4 w; w.x = cvt_pk_bf16(v0[0], v0[1]); w.y = cvt_pk_bf16(v0[2], v0[3]); w.z = cvt_pk_bf16(v1[0], v1[1]); w.w = cvt_pk_bf16(v1[2], v1[3]); return w; }
__device__ __forceinline__ void gelu8(f32x4& v0, f32x4& v1) { f32x2 a = gelu_pk((f32x2){v0[0], v0[1]}), b = gelu_pk((f32x2){v0[2], v0[3]}), c = gelu_pk((f32x2){v1[0], v1[1]}), d = gelu_pk((f32x2){v1[2], v1[3]});
    v0 = (f32x4){a.x, a.y, b.x, b.y}; v1 = (f32x4){c.x, c.y, d.x, d.y}; }

struct EpiA1 {
    static constexpr bool PERM = true, AFTER_DRAIN = false;
    bf16_t* QK; bf16_t* GATE; const float* COS; const float* SIN; float osc; int pn0; const float* rss;
    __device__ __forceinline__ void operator()(const f32x4 (&acc)[2][2][4][2], const Unit& u, int wr, int wc, int fr, int fq) const {
        const int pn = u.pn + pn0; const int rowb = u.pm * BM + wr * 64 + fr;
        if (pn >= 48) {
            const int col0 = (pn - 48) * 256 + wc * 32 + 8 * fq;
#pragma unroll
            for (int ai = 0; ai < 2; ++ai)
#pragma unroll
                for (int m = 0; m < 4; ++m) { bf16_t* rowp = GATE + (size_t)(rowb + ai * HALF + m * 16) * 2048 + col0; const float rs = osc * __builtin_amdgcn_rsqf(rss[rowb + ai * HALF + m * 16] * (1.0f / 2048) + 1e-6f);
#pragma unroll
                    for (int bj = 0; bj < 2; ++bj) { f32x4 v0 = acc[ai][bj][m][0] * rs, v1 = acc[ai][bj][m][1] * rs;
#pragma unroll
                        for (int i = 0; i < 4; ++i) { v0[i] = silu_f(v0[i]); v1[i] = silu_f(v1[i]); }
                        *(u32x4*)(rowp + bj * HALF) = pack8(v0, v1); } }
        } else {
            const int g = pn >> 4, qk = (pn >> 3) & 1, hp = pn & 7, dsh = 2 * g, dm1 = (1 << dsh) - 1;
            const float sc = osc; const float sgn = fq < 2 ? -1.0f : 1.0f; const int e0 = wc * 32 + 8 * fq;
#pragma unroll
            for (int ai = 0; ai < 2; ++ai)
#pragma unroll
                for (int m = 0; m < 4; ++m) { const int row = rowb + ai * HALF + m * 16, b = row >> 11, s = row & 2047, p = ((s & dm1) << (11 - dsh)) | (s >> dsh);
                    f32x4 c0, c1, s0, s1; const float scr = sc * __builtin_amdgcn_rsqf(rss[row] * (1.0f / 2048) + 1e-6f);
                    if (wc == 0) { const float* cp = COS + (size_t)row * 16 + 8 * (fq & 1); const float* sp = SIN + (size_t)row * 16 + 8 * (fq & 1);
                        c0 = *(const f32x4*)cp; c1 = *(const f32x4*)(cp + 4); s0 = *(const f32x4*)sp; s1 = *(const f32x4*)(sp + 4);
                        }
#pragma unroll
                    for (int bj = 0; bj < 2; ++bj) { f32x4 v0 = acc[ai][bj][m][0], v1 = acc[ai][bj][m][1];
                        if (wc == 0) {
#pragma unroll
                            for (int i = 0; i < 4; ++i) { const float p0 = __shfl_xor(v0[i], 32), p1 = __shfl_xor(v1[i], 32);
                                v0[i] = v0[i] * c0[i] + sgn * p0 * s0[i]; v1[i] = v1[i] * c1[i] + sgn * p1 * s1[i]; } }
                        v0 = v0 * scr; v1 = v1 * scr;
                        unsigned char* dst = (unsigned char*)QK + ((((size_t)((g * 2 + qk) * 4 + b) * 16 + (2 * hp + bj)) * 2048 + p) * 128 + e0);
                        int w0 = 0, w1 = 0; w0 = __builtin_amdgcn_cvt_pk_fp8_f32(v0[0], v0[1], w0, false); w0 = __builtin_amdgcn_cvt_pk_fp8_f32(v0[2], v0[3], w0, true);
                        w1 = __builtin_amdgcn_cvt_pk_fp8_f32(v1[0], v1[1], w1, false); w1 = __builtin_amdgcn_cvt_pk_fp8_f32(v1[2], v1[3], w1, true);
                        *(unsigned long long*)dst = ((unsigned long long)(unsigned)w1 << 32) | (unsigned)w0; } }
        }
    }
};
struct EpiB1 {
    static constexpr bool PERM = true, AFTER_DRAIN = false;
    bf16_t* U; bf16_t* ZS; const float* rss;
    __device__ __forceinline__ void operator()(const f32x4 (&acc)[2][2][4][2], const Unit& u, int wr, int wc, int fr, int fq) const {
        const int pn = u.pn; const int rowb = u.pm * BM + wr * 64 + fr; const bool isz = pn >= 8;
        bf16_t* base = isz ? ZS : U; const int col0 = (pn & 7) * 256 + wc * 32 + 8 * fq;
#pragma unroll
        for (int ai = 0; ai < 2; ++ai)
#pragma unroll
            for (int m = 0; m < 4; ++m) { bf16_t* rowp = base + (size_t)(rowb + ai * HALF + m * 16) * 2048 + col0; const float rs = __builtin_amdgcn_rsqf(rss[rowb + ai * HALF + m * 16] * (1.0f / 2048) + 1e-6f);
#pragma unroll
                for (int bj = 0; bj < 2; ++bj) { f32x4 v0 = acc[ai][bj][m][0] * rs, v1 = acc[ai][bj][m][1] * rs;
                    if (isz) {
#pragma unroll
                        for (int i = 0; i < 4; ++i) { v0[i] = silu_f(v0[i]); v1[i] = silu_f(v1[i]); }
                    } else gelu8(v0, v1);
                    *(u32x4*)(rowp + bj * HALF) = pack8(v0, v1); } }
    }
};
struct EpiPlain {
    static constexpr bool PERM = true, AFTER_DRAIN = false;
    bf16_t* O; float osc; const float* rss; int dsh;
    __device__ __forceinline__ void operator()(const f32x4 (&acc)[2][2][4][2], const Unit& u, int wr, int wc, int fr, int fq) const {
        const int rowb = u.pm * BM + wr * 64 + fr; const int col0 = u.pn * BM + wc * 32 + 8 * fq;
#pragma unroll
        for (int bj = 0; bj < 2; ++bj) { const int c = col0 + bj * HALF, p = c & 2047, Lm1 = (2048 >> dsh) - 1; const float* rp = rss + (c & ~2047) + ((p & Lm1) << dsh) + (p >> (11 - dsh));
            f32x4 r0, r1;
#pragma unroll
            for (int k = 0; k < 4; ++k) { r0[k] = osc * __builtin_amdgcn_rsqf(rp[k << dsh] * (1.0f / 2048) + 1e-6f); r1[k] = osc * __builtin_amdgcn_rsqf(rp[(k + 4) << dsh] * (1.0f / 2048) + 1e-6f); }
#pragma unroll
            for (int ai = 0; ai < 2; ++ai)
#pragma unroll
                for (int m = 0; m < 4; ++m) { bf16_t* rowp = O + (size_t)((c >> 5)) * 65536 + (size_t)(rowb + ai * HALF + m * 16) * 32 + (c & 31);
                    *(u32x4*)rowp = pack8(acc[ai][bj][m][0] * r0, acc[ai][bj][m][1] * r1); } }
    }
};
struct EpiB2 {
    static constexpr bool PERM = true, AFTER_DRAIN = false;
    bf16_t* VT; float* STATS; const float* rss;
    __device__ __forceinline__ static float row16_sum(float v) {
        v += __builtin_bit_cast(float, __builtin_amdgcn_update_dpp(0, __builtin_bit_cast(int, v), 0xB1, 0xf, 0xf, true));
        v += __builtin_bit_cast(float, __builtin_amdgcn_update_dpp(0, __builtin_bit_cast(int, v), 0x4E, 0xf, 0xf, true));
        v += __builtin_bit_cast(float, __builtin_amdgcn_update_dpp(0, __builtin_bit_cast(int, v), 0x141, 0xf, 0xf, true));
        v += __builtin_bit_cast(float, __builtin_amdgcn_update_dpp(0, __builtin_bit_cast(int, v), 0x140, 0xf, 0xf, true));
        return v; }
    __device__ __forceinline__ void operator()(const f32x4 (&acc)[2][2][4][2], const Unit& u, int wr, int wc, int fr, int fq) const {
        const int rowb = u.pm * BM + wr * 64 + fr; const int col0 = u.pn * BM + wc * 32 + 8 * fq;
#pragma unroll
        for (int bj = 0; bj < 2; ++bj) {
            float s1[8], s2[8]; f32x4 r0 = *(const f32x4*)(rss + col0 + bj * HALF), r1 = *(const f32x4*)(rss + col0 + bj * HALF + 4);
#pragma unroll
            for (int k = 0; k < 4; ++k) { r0[k] = __builtin_amdgcn_rsqf(r0[k] * (1.0f / 2048) + 1e-6f); r1[k] = __builtin_amdgcn_rsqf(r1[k] * (1.0f / 2048) + 1e-6f); }
#pragma unroll
            for (int k = 0; k < 8; ++k) { s1[k] = 0.f; s2[k] = 0.f; }
#pragma unroll
            for (int ai = 0; ai < 2; ++ai)
#pragma unroll
                for (int m = 0; m < 4; ++m) { bf16_t* rowp = VT + (size_t)((col0 >> 5) + 4 * bj) * 65536 + (size_t)(rowb + ai * HALF + m * 16) * 32 + (col0 & 31);
                    f32x4 v0 = acc[ai][bj][m][0] * r0, v1 = acc[ai][bj][m][1] * r1; gelu8(v0, v1);
#pragma unroll
                    for (int i = 0; i < 4; ++i) { s1[i] += v0[i]; s2[i] += v0[i] * v0[i]; s1[4 + i] += v1[i]; s2[4 + i] += v1[i] * v1[i]; }
                    *(u32x4*)rowp = pack8(v0, v1); }
#pragma unroll
            for (int k = 0; k < 8; ++k) { const float a = row16_sum(s1[k]), b = row16_sum(s2[k]);
                if (fr == 0) { float* sp = STATS + 2 * (size_t)(col0 + bj * HALF + k); atomicAdd(sp, a); atomicAdd(sp + 1, b); } }
            asm volatile("" ::: "memory");
        }
    }
};
struct EpiAllA {
    static constexpr bool PERM = true, AFTER_DRAIN = false;
    EpiA1 e1; EpiPlain ev; int kv0;
    __device__ __forceinline__ void operator()(const f32x4 (&acc)[2][2][4][2], const Unit& u, int wr, int wc, int fr, int fq) const {
        if (u.k < kv0) e1(acc, u, wr, wc, fr, fq);
        else { EpiPlain e = ev; e.O += (size_t)(u.k - kv0) * 2048 * 8192; e.dsh = 2 * (u.k - kv0); e(acc, u, wr, wc, fr, fq); }
    }
};
struct EpiAllB {
    static constexpr bool PERM = true, AFTER_DRAIN = false;
    EpiB1 e1; EpiB2 e2;
    __device__ __forceinline__ void operator()(const f32x4 (&acc)[2][2][4][2], const Unit& u, int wr, int wc, int fr, int fq) const {
        if (u.k == 0) e1(acc, u, wr, wc, fr, fq); else e2(acc, u, wr, wc, fr, fq);
    }
};
struct EpiOut {
    static constexpr bool PERM = false, AFTER_DRAIN = false;
    const float* base; float* out; const float* gn; bf16_t* xb; unsigned char* x8; float* rss;
    __device__ __forceinline__ void operator()(const f32x4 (&acc)[2][2][4][2], const Unit& u, int wr, int wc, int fr, int fq) const {
        const int rowb = u.pm * BM + wr * 64 + fr; const int col0 = u.pn * BM + wc * 32 + 4 * fq;
        f32x4 gv[2][2];
        if (gn) {
#pragma unroll
            for (int bj = 0; bj < 2; ++bj)
#pragma unroll
                for (int n = 0; n < 2; ++n) gv[bj][n] = *(const f32x4*)(gn + col0 + bj * HALF + n * 16); }
#pragma unroll
        for (int ai = 0; ai < 2; ++ai)
#pragma unroll
            for (int m = 0; m < 4; ++m) { const int row = rowb + ai * HALF + m * 16; const size_t off = (size_t)row * 2048 + col0; float ss = 0.f;
#pragma unroll
                for (int bj = 0; bj < 2; ++bj)
#pragma unroll
                    for (int n = 0; n < 2; ++n) { const f32x4 bs = *(const f32x4*)(base + off + bj * HALF + n * 16); const f32x4 x = bs + acc[ai][bj][m][n]; *(f32x4*)(out + off + bj * HALF + n * 16) = x;
                        if (gn) { ss += (x[0] * x[0] + x[1] * x[1]) + (x[2] * x[2] + x[3] * x[3]); const f32x4 y = x * gv[bj][n];
                            unsigned lo = cvt_pk_bf16(y[0], y[1]), hi = cvt_pk_bf16(y[2], y[3]); *(unsigned long long*)(xb + off + bj * HALF + n * 16) = ((unsigned long long)hi << 32) | lo;
                            if (x8) { int w = 0; w = __builtin_amdgcn_cvt_pk_fp8_f32(y[0], y[1], w, false); w = __builtin_amdgcn_cvt_pk_fp8_f32(y[2], y[3], w, true); *(int*)(x8 + off + bj * HALF + n * 16) = w; } } }
                if (gn) { ss += __shfl_xor(ss, 16); ss += __shfl_xor(ss, 32); if (fq == 0) atomicAdd(rss + row, ss); } }
    }
};
template <class Epi, class Sched, bool ALIGN_EPI = false, bool SP2 = false, bool F8 = false>
__device__ __forceinline__ void gemm_phase(PG8_LAS unsigned char* lds, const int Kel, const Sched& S, const Epi& E, const int wave_) {
    const int tid = wave_ * 64 + ::lane_id(); const int wid = __builtin_amdgcn_readfirstlane(tid >> 6), lane = tid & 63, wr = wid >> 2, wc = wid & 3, fr = lane & 15, fq = lane >> 4;
    const int K = F8 ? Kel / 2 : Kel, nt = K / BK;
    unsigned voffA[2], voffB[2]; size_t hstepB;
#pragma unroll
    for (int i = 0; i < 2; ++i) { int R, C; stage_rc(tid * 16 + i * 8192, R, C); voffA[i] = (unsigned)(R * K + C) * 2u; }
#define PG8_SETB(dil) do { const int d_ = (dil); _Pragma("unroll") for (int i = 0; i < 2; ++i) { int R, C; stage_rc(tid * 16 + i * 8192, R, C); const int Rb = Epi::PERM ? ((R & ~31) + perm32(R & 31)) : R; \
        voffB[i] = (unsigned)(Rb * d_ * K + C) * 2u; } hstepB = (d_ == 16) ? (size_t)K * 2 : (size_t)HALF * d_ * K * 2; } while (0)
    const size_t kstep = (size_t)(BK * 2);
    const size_t hstep = (size_t)HALF * K * 2;
    const size_t tstep = 2 * hstep;
    const unsigned ldsw = (unsigned)wid * 1024u;
    const int aoff = lds_byte(wr * 64 + fr, fq * 8), boff = lds_byte(wc * 32 + fr, fq * 8);
#define PG8_SA(b, h) (((b) * 2 + (h)) * HTB)
#define PG8_SB(b, h) ((4 + (b) * 2 + (h)) * HTB)
#define PG8_STAGE(bufoff, gbase, voff) do { _Pragma("unroll") for (int _i = 0; _i < 2; ++_i) \
        __builtin_amdgcn_global_load_lds((const unsigned*)((const char*)(gbase) + (voff)[_i]), (PG8_LAS unsigned*)(lds + (bufoff) + ldsw + _i * 8192), 16, 0, 0); } while (0)
#define PG8_LDA(dst, b, h) do { _Pragma("unroll") for (int m = 0; m < 4; ++m) _Pragma("unroll") for (int k = 0; k < 2; ++k) dst[m][k] = *(const PG8_LAS bf16x8*)(lds + PG8_SA(b, h) + aoff + m * 2048 + k * 1024); } while (0)
#define PG8_LDB(dst, b, h) do { _Pragma("unroll") for (int n = 0; n < 2; ++n) _Pragma("unroll") for (int k = 0; k < 2; ++k) dst[n][k] = *(const PG8_LAS bf16x8*)(lds + PG8_SB(b, h) + boff + n * 2048 + k * 1024); } while (0)
#define PG8_CAT8(x) __builtin_shufflevector(__builtin_bit_cast(i32x4, (x)[0]), __builtin_bit_cast(i32x4, (x)[1]), 0, 1, 2, 3, 4, 5, 6, 7)
#define PG8_MMA(ai, bj, At, Bt) do { __builtin_amdgcn_s_setprio(1); \
        if constexpr (F8) { _Pragma("unroll") for (int m = 0; m < 4; ++m) _Pragma("unroll") for (int n = 0; n < 2; ++n) \
            asm volatile("v_mfma_f32_16x16x128_f8f6f4 %0, %1, %2, %0" : "+v"(acc[ai][bj][m][n]) : "v"(PG8_CAT8(Bt[n])), "v"(PG8_CAT8(At[m]))); } \
        else { _Pragma("unroll") for (int m = 0; m < 4; ++m) _Pragma("unroll") for (int n = 0; n < 2; ++n) _Pragma("unroll") for (int k = 0; k < 2; ++k) \
            acc[ai][bj][m][n] = __builtin_amdgcn_mfma_f32_16x16x32_bf16(Bt[n][k], At[m][k], acc[ai][bj][m][n], 0, 0, 0); } \
        __builtin_amdgcn_s_setprio(0); } while (0)
#define PG8_WAIT_V(n) asm volatile("s_waitcnt vmcnt(" #n ")" ::: "memory")
#define PG8_WAIT_L(n) asm volatile("s_waitcnt lgkmcnt(" #n ")" ::: "memory")
#define PG8_BAR __builtin_amdgcn_s_barrier()
#define PG8_SCHED __builtin_amdgcn_sched_barrier(0)
    Unit cur, nxt; int ui = 0;
    if (!S.next(0, cur)) return;
    f32x4 acc[2][2][4][2];
#pragma unroll
    for (int a = 0; a < 2; ++a)
#pragma unroll
        for (int b = 0; b < 2; ++b)
#pragma unroll
            for (int m = 0; m < 4; ++m)
#pragma unroll
                for (int n = 0; n < 2; ++n) acc[a][b][m][n] = (f32x4){0.f, 0.f, 0.f, 0.f};
    bf16x8 At[4][2], B0[2][2], B1[2][2];
    const char* cA = S.a_base(cur); const char* cB = S.b_base(cur); PG8_SETB(S.bdil(cur));
    S.a_ready(cur);
    if constexpr (SP2) {
        PG8_STAGE(PG8_SB(0, 0), cB, voffB); PG8_STAGE(PG8_SB(0, 1), cB + hstepB, voffB); PG8_STAGE(PG8_SA(0, 0), cA, voffA); PG8_STAGE(PG8_SA(0, 1), cA + hstep, voffA);
        if (wr == 1) PG8_BAR;
        PG8_WAIT_V(2); PG8_BAR;
        PG8_STAGE(PG8_SB(1, 0), cB + kstep, voffB); PG8_STAGE(PG8_SA(1, 0), cA + kstep, voffA); PG8_STAGE(PG8_SB(1, 1), cB + hstepB + kstep, voffB);
        PG8_WAIT_V(6); PG8_BAR;
    } else {
        PG8_STAGE(PG8_SB(0, 0), cB, voffB); PG8_STAGE(PG8_SA(0, 0), cA, voffA); PG8_STAGE(PG8_SB(0, 1), cB + hstepB, voffB); PG8_STAGE(PG8_SA(0, 1), cA + hstep, voffA);
        if (wr == 1) PG8_BAR;
        PG8_WAIT_V(4); PG8_BAR;
        PG8_STAGE(PG8_SB(1, 0), cB + kstep, voffB); PG8_STAGE(PG8_SA(1, 0), cA + kstep, voffA); PG8_STAGE(PG8_SB(1, 1), cB + hstepB + kstep, voffB);
        PG8_WAIT_V(6); PG8_BAR;
    }
    for (;;) {
        const bool has_next = S.next(ui + 1, nxt);
        const char* nA = has_next ? S.a_base(nxt) : cA; const char* nB = has_next ? S.b_base(nxt) : cB;
        for (int t = 0; t < nt; t += 2) {
            const bool last = (t == nt - 2);
            const char* a1 = cA + (size_t)(t + 1) * kstep;
            const char* a2 = last ? nA : cA + (size_t)(t + 2) * kstep; const char* b2 = last ? nB : cB + (size_t)(t + 2) * kstep;
            const char* a3 = a2 + kstep; const char* b3 = b2 + kstep;
            if (last && has_next) { S.a_ready(nxt); PG8_SETB(S.bdil(nxt)); }
            if constexpr (SP2) {
            PG8_LDB(B0, 0, 0); PG8_LDB(B1, 0, 1); PG8_SCHED; PG8_LDA(At, 0, 0); PG8_STAGE(PG8_SA(1, 1), a1 + hstep, voffA);
            PG8_WAIT_V(8); PG8_WAIT_L(0); PG8_BAR; PG8_MMA(0, 0, At, B0); PG8_MMA(0, 1, At, B1); PG8_BAR; PG8_SCHED;
            PG8_LDA(At, 0, 1); PG8_STAGE(PG8_SB(0, 0), b2, voffB); PG8_STAGE(PG8_SB(0, 1), b2 + hstepB, voffB); PG8_STAGE(PG8_SA(0, 0), a2, voffA);
            PG8_WAIT_V(8); PG8_WAIT_L(0); PG8_BAR; PG8_MMA(1, 0, At, B0); PG8_MMA(1, 1, At, B1); PG8_BAR; PG8_SCHED;
            PG8_LDB(B0, 1, 0); PG8_LDB(B1, 1, 1); PG8_SCHED; PG8_LDA(At, 1, 0); PG8_STAGE(PG8_SA(0, 1), a2 + hstep, voffA);
            PG8_WAIT_V(8); PG8_WAIT_L(0); PG8_BAR; PG8_MMA(0, 0, At, B0); PG8_MMA(0, 1, At, B1); PG8_BAR; PG8_SCHED;
            PG8_LDA(At, 1, 1); PG8_STAGE(PG8_SB(1, 0), b3, voffB); PG8_STAGE(PG8_SB(1, 1), b3 + hstepB, voffB); PG8_STAGE(PG8_SA(1, 0), a3, voffA);
            PG8_WAIT_V(8); PG8_WAIT_L(0); PG8_BAR; PG8_MMA(1, 0, At, B0); PG8_MMA(1, 1, At, B1); PG8_BAR; PG8_SCHED;
            } else {
            PG8_LDB(B0, 0, 0); PG8_SCHED; PG8_LDA(At, 0, 0); PG8_STAGE(PG8_SA(1, 1), a1 + hstep, voffA);
            PG8_WAIT_L(8); PG8_BAR; PG8_WAIT_L(0); PG8_MMA(0, 0, At, B0); PG8_BAR; PG8_SCHED;
            PG8_LDB(B1, 0, 1); PG8_STAGE(PG8_SB(0, 0), b2, voffB);
            PG8_BAR; PG8_WAIT_L(0); PG8_MMA(0, 1, At, B1); PG8_BAR;
            PG8_LDA(At, 0, 1); PG8_STAGE(PG8_SA(0, 0), a2, voffA);
            PG8_BAR; PG8_WAIT_L(0); PG8_MMA(1, 0, At, B0); PG8_BAR; PG8_SCHED;
            PG8_STAGE(PG8_SB(0, 1), b2 + hstepB, voffB);
            PG8_WAIT_V(6); PG8_BAR; PG8_MMA(1, 1, At, B1); PG8_BAR;
            PG8_LDB(B0, 1, 0); PG8_SCHED; PG8_LDA(At, 1, 0); PG8_STAGE(PG8_SA(0, 1), a2 + hstep, voffA);
            PG8_WAIT_L(8); PG8_BAR; PG8_WAIT_L(0); PG8_MMA(0, 0, At, B0); PG8_BAR; PG8_SCHED;
            PG8_LDB(B1, 1, 1); PG8_STAGE(PG8_SB(1, 0), b3, voffB);
            PG8_BAR; PG8_WAIT_L(0); PG8_MMA(0, 1, At, B1); PG8_BAR;
            PG8_LDA(At, 1, 1); PG8_STAGE(PG8_SA(1, 0), a3, voffA);
            PG8_BAR; PG8_WAIT_L(0); PG8_MMA(1, 0, At, B0); PG8_BAR; PG8_SCHED;
            PG8_STAGE(PG8_SB(1, 1), b3 + hstepB, voffB);
            PG8_WAIT_V(6); PG8_BAR; PG8_MMA(1, 1, At, B1); PG8_BAR;
            }
        }
        if constexpr (F8) asm volatile("s_nop 15\n\ts_nop 15" ::: "memory");
        if constexpr (ALIGN_EPI) { if (wr == 0) PG8_BAR; }
        if constexpr (!Epi::AFTER_DRAIN) { E(acc, cur, wr, wc, fr, fq); S.done(cur); }
        if (!has_next) break;
#pragma unroll
        for (int a = 0; a < 2; ++a)
#pragma unroll
            for (int b = 0; b < 2; ++b)
#pragma unroll
                for (int m = 0; m < 4; ++m)
#pragma unroll
                    for (int n = 0; n < 2; ++n) acc[a][b][m][n] = (f32x4){0.f, 0.f, 0.f, 0.f};
        cur = nxt; cA = nA; cB = nB; ++ui;
        if constexpr (ALIGN_EPI) { if (wr == 1) PG8_BAR; }
    }
    PG8_WAIT_V(0);
    if constexpr (!ALIGN_EPI) { if (wr == 0) PG8_BAR; }
    PG8_BAR;
    if constexpr (Epi::AFTER_DRAIN) { E.fused(acc, cur, wr, wc, fr, fq, lds, wid, lane); S.done(cur); }
#undef PG8_SA
#undef PG8_SB
#undef PG8_STAGE
#undef PG8_LDA
#undef PG8_LDB
#undef PG8_MMA
#undef PG8_SETB
#undef PG8_CAT8
#undef PG8_WAIT_V
#undef PG8_WAIT_L
#undef PG8_BAR
#undef PG8_SCHED
}
}

constexpr int NWAVES = 8, NTHR = NWAVES * 64;
constexpr int BATCH = 4, SEQ = 2048, DM = 2048, MTOK = BATCH * SEQ;
constexpr int A_IN = 20480, B_IN = 6144, NA1 = 14336;
constexpr float RMS_EPS = 1e-6f, LN_EPS = 1e-5f;
constexpr size_t MiB = 1u << 20;
constexpr size_t SZ_ACT = (size_t)MTOK * DM * 2;
constexpr size_t WS_WAIN = 2 * MiB;
constexpr size_t WS_WAOUT = WS_WAIN + 2 * (size_t)A_IN * DM * 2;
constexpr size_t WS_WBIN = WS_WAOUT + 2 * (size_t)DM * DM * 2;
constexpr size_t WS_WBOUT = WS_WBIN + 2 * (size_t)B_IN * DM * 2;
constexpr size_t WS_WM = WS_WBOUT + 2 * (size_t)DM * DM * 2;
constexpr size_t WS_COS = WS_WM + 2 * 16 * 128 * 128 * 2;
constexpr size_t WS_SIN = WS_COS + (size_t)MTOK * 16 * 4;
constexpr size_t WS_STATS = WS_SIN + (size_t)MTOK * 16 * 4;
constexpr size_t WS_LSE = WS_STATS + 2 * (size_t)MTOK * 2 * 4;
constexpr size_t WS_X = WS_LSE + 3 * (size_t)MTOK * 16 * 4;
constexpr size_t WS_XN = WS_X + 2 * SZ_ACT;
constexpr size_t WS_QK = WS_XN + SZ_ACT;
constexpr size_t WS_VT = WS_QK + 6 * SZ_ACT;
constexpr size_t WS_GATE = WS_VT + 3 * SZ_ACT;
constexpr size_t WS_OG = WS_GATE + SZ_ACT;
constexpr size_t WS_Y = WS_OG + 3 * SZ_ACT;
constexpr size_t WS_XN8 = WS_Y + SZ_ACT;
constexpr size_t WS_RSS = WS_XN8 + SZ_ACT / 2;
constexpr size_t WS_END = WS_RSS + 4 * (size_t)MTOK * 4;
constexpr size_t WS_BAR = 65536;
constexpr int LDS_BYTES = 147456;

typedef unsigned short bf16;
typedef unsigned v4u __attribute__((ext_vector_type(4)));
typedef unsigned v2u __attribute__((ext_vector_type(2)));
typedef float f32x4 __attribute__((ext_vector_type(4)));
typedef float f32x2v __attribute__((ext_vector_type(2)));
typedef float f32x16 __attribute__((ext_vector_type(16)));
typedef short bf16x8 __attribute__((ext_vector_type(8)));
typedef __bf16 bf16x2_t __attribute__((ext_vector_type(2)));
#define LAS __attribute__((address_space(3)))
#define MFMA32(a, b, c) __builtin_amdgcn_mfma_f32_32x32x16_bf16((a), (b), (c), 0, 0, 0)
__device__ __forceinline__ unsigned pk2(float lo, float hi) { f32x2v v = {lo, hi}; bf16x2_t b = __builtin_convertvector(v, bf16x2_t); return __builtin_bit_cast(unsigned, b); }
__device__ __forceinline__ float bflo(unsigned w) { return __builtin_bit_cast(float, w << 16); }
__device__ __forceinline__ float bfhi(unsigned w) { return __builtin_bit_cast(float, w & 0xffff0000u); }
__device__ __forceinline__ float wave_sum(float v) {
#pragma unroll
    for (int o = 1; o < 64; o <<= 1) v += __shfl_xor(v, o);
    return v;
}

#define XB_TMO      128
#define XB_XCNT(j)  (256  + 64 * (j))
#define XB_XSUB(j)  (1280 + 64 * (j))
#define XB_XGEN(j)  (2304 + 64 * (j))
#define XB_TOP      3328
#define XB_TOPGEN   3392
#define XCD_BAR_WORDS 3456
#define XB_SPIN_CAP (1u << 18)

__device__ __forceinline__ unsigned xb_ld(unsigned* p)              { return __hip_atomic_load(p, __ATOMIC_RELAXED, __HIP_MEMORY_SCOPE_AGENT); }
__device__ __forceinline__ unsigned xb_add(unsigned* p, unsigned v) { return __hip_atomic_fetch_add(p, v, __ATOMIC_RELAXED, __HIP_MEMORY_SCOPE_AGENT); }
__device__ __forceinline__ unsigned xb_xcc_id() { return (unsigned)__builtin_amdgcn_s_getreg((3 << 11) | 20) & 0xFu; }
#define XB_SPIN(cond, bar) do { unsigned _sp = 0; while (cond) { __builtin_amdgcn_s_sleep(1); \
    if ((++_sp & 255u) == 0u) { if (xb_ld(&(bar)[XB_TMO])) break; if (_sp > XB_SPIN_CAP) { atomicAdd(&(bar)[XB_TMO], 1u); break; } } } } while (0)

struct XcdBarrier {
    int w;
    unsigned* bar; unsigned x;
    volatile LAS unsigned* st;
};

__device__ __forceinline__ XcdBarrier xcd_barrier_post(unsigned* bar, volatile LAS unsigned* st, int w) {
    XcdBarrier b; b.w = w; b.bar = bar; b.x = xb_xcc_id(); b.st = st;
    if (w == 0 && lane_id() == 0) (void)xb_add(&bar[XB_XCNT(b.x)], 1u);
    return b;
}
__device__ __forceinline__ void xcd_barrier_complete(unsigned* bar, unsigned x, unsigned& nloc, unsigned& nx) {
    const unsigned G = gridDim.x * gridDim.y * gridDim.z;
    unsigned sum, cnt, mine, sp = 0u;
    for (;;) {
        sum = 0u; cnt = 0u; mine = 0u;
#pragma unroll
        for (unsigned j = 0; j < 16; ++j) { const unsigned c = xb_ld(&bar[XB_XCNT(j)]); sum += c; cnt += (c > 0u) ? 1u : 0u; mine = (j == x) ? c : mine; }
        if (sum == G) break;
        __builtin_amdgcn_s_sleep(1);
        if ((++sp & 255u) == 0u) { if (xb_ld(&bar[XB_TMO])) break; if (sp > XB_SPIN_CAP) { atomicAdd(&bar[XB_TMO], 1u); break; } }
    }
    nloc = mine > 0u ? mine : 1u; nx = cnt > 0u ? cnt : 1u;
}

__device__ __forceinline__ void xcd_barrier(const XcdBarrier& b) {
    asm volatile("s_waitcnt vmcnt(0)" ::: "memory");
    __syncthreads();
    if (b.w == 0 && lane_id() == 0) {
        unsigned* bar = b.bar;
        __builtin_amdgcn_s_waitcnt(0);
        unsigned nloc = b.st[0], nx = b.st[1];
        if (nloc == 0u) { xcd_barrier_complete(bar, b.x, nloc, nx); b.st[0] = nloc; b.st[1] = nx; }
        const unsigned old = xb_add(&bar[XB_XSUB(b.x)], 1u);
        const unsigned gen = old / nloc;
        if (old + 1u == (gen + 1u) * nloc) {
            __builtin_amdgcn_fence(__ATOMIC_RELEASE, "agent");
            asm volatile("s_waitcnt vmcnt(0)" ::: "memory");
            const unsigned og = xb_add(&bar[XB_TOP], 1u);
            const unsigned tg = og / nx;
            if (og + 1u == (tg + 1u) * nx) xb_add(&bar[XB_TOPGEN], 1u);
            else XB_SPIN(xb_ld(&bar[XB_TOPGEN]) == tg, bar);
            __builtin_amdgcn_fence(__ATOMIC_ACQUIRE, "agent");
            xb_add(&bar[XB_XGEN(b.x)], 1u);
            asm volatile("s_waitcnt vmcnt(0)" ::: "memory");
        } else {
            XB_SPIN(xb_ld(&bar[XB_XGEN(b.x)]) == gen, bar);
            __builtin_amdgcn_fence(__ATOMIC_ACQUIRE, "agent");
            asm volatile("s_waitcnt vmcnt(0)" ::: "memory");
        }
    }
    __syncthreads();
}

__device__ __forceinline__ int launder_s(int v) { asm volatile("" : "+s"(v)); return v; }
__device__ __forceinline__ int launder(int v) { asm volatile("" : "+v"(v)); return v; }
struct Args {
    const float* x; const int* pos; const float* a_norm_g; const float* a_w_in; const float* a_w_out; const float* b_norm_g; const float* b_w_in;
    const float* b_ln_g; const float* b_ln_b; const float* b_w_s; const float* b_b_s; const float* b_w_out; const float* final_g;
    float* out; unsigned char* ws; double invf[16];
    int ph_lo, ph_hi;
};

__device__ __forceinline__ void p0_transpose_item(const float* W, int K, int N, bf16* WT, int row_off, LAS float* scr, int kb, int nb, int lane) {
    const int k0 = 64 * kb, n0 = 32 * nb;
    float wv[32];
#pragma unroll
    for (int i = 0; i < 32; ++i) wv[i] = W[(size_t)(k0 + 2 * i + (lane >> 5)) * N + n0 + (lane & 31)];
#pragma unroll
    for (int i = 0; i < 32; ++i) scr[(2 * i + (lane >> 5)) * 33 + (lane & 31)] = wv[i];
    asm volatile("s_waitcnt lgkmcnt(0)" ::: "memory");
    const int c = lane & 7;
#pragma unroll
    for (int j = 0; j < 4; ++j) { const int n = (lane >> 3) + 8 * j; const LAS float* s = scr + (8 * c) * 33 + n;
        v4u o; o.x = pk2(s[0 * 33], s[1 * 33]); o.y = pk2(s[2 * 33], s[3 * 33]); o.z = pk2(s[4 * 33], s[5 * 33]); o.w = pk2(s[6 * 33], s[7 * 33]);
        *(v4u*)(WT + (size_t)(row_off + n0 + n) * K + k0 + 8 * c) = o; }
    asm volatile("s_waitcnt lgkmcnt(0)" ::: "memory");
}
constexpr float W8_SCALE = 32.0f;
__device__ __forceinline__ unsigned pk4_fp8(float a, float b, float c, float d) {
    a = fminf(fmaxf(a, -448.f), 448.f); b = fminf(fmaxf(b, -448.f), 448.f); c = fminf(fmaxf(c, -448.f), 448.f); d = fminf(fmaxf(d, -448.f), 448.f);
    int w = 0; w = __builtin_amdgcn_cvt_pk_fp8_f32(a, b, w, false); w = __builtin_amdgcn_cvt_pk_fp8_f32(c, d, w, true); return (unsigned)w; }
__device__ __forceinline__ void p0_transpose_item_f8(const float* W, int K, int N, unsigned char* WT, int row_off, LAS float* scr, int kb, int nb, int lane) {
    const int k0 = 64 * kb, n0 = 32 * nb;
    float wv[32];
#pragma unroll
    for (int i = 0; i < 32; ++i) wv[i] = W[(size_t)(k0 + 2 * i + (lane >> 5)) * N + n0 + (lane & 31)];
#pragma unroll
    for (int i = 0; i < 32; ++i) scr[(2 * i + (lane >> 5)) * 33 + (lane & 31)] = wv[i] * W8_SCALE;
    asm volatile("s_waitcnt lgkmcnt(0)" ::: "memory");
    const int c = lane & 7;
#pragma unroll
    for (int j = 0; j < 4; ++j) { const int n = (lane >> 3) + 8 * j; const LAS float* s = scr + (8 * c) * 33 + n;
        v2u o; o.x = pk4_fp8(s[0 * 33], s[1 * 33], s[2 * 33], s[3 * 33]); o.y = pk4_fp8(s[4 * 33], s[5 * 33], s[6 * 33], s[7 * 33]);
        *(v2u*)(WT + (size_t)(row_off + n0 + n) * K + k0 + 8 * c) = o; }
    asm volatile("s_waitcnt lgkmcnt(0)" ::: "memory");
}
template <bool OB16, bool OF32, bool OF8> __device__ __forceinline__ void rms_row(const float* xrow, const float* g, bf16* o16, float* o32, unsigned char* o8, int lane) {
    const f32x4* xr = (const f32x4*)xrow + lane; const f32x4* gr = (const f32x4*)g + lane;
    f32x4 v[8]; float s = 0.f;
#pragma unroll
    for (int j = 0; j < 8; ++j) { v[j] = xr[64 * j]; s += (v[j].x * v[j].x + v[j].y * v[j].y) + (v[j].z * v[j].z + v[j].w * v[j].w); }
    const float rstd = 1.0f / sqrtf(wave_sum(s) * (1.0f / DM) + RMS_EPS);
#pragma unroll
    for (int j = 0; j < 8; ++j) { const f32x4 gg = gr[64 * j]; const f32x4 y = v[j] * rstd * gg;
        if (OF32) ((f32x4*)o32 + lane)[64 * j] = y;
        if (OF8) ((unsigned*)o8 + lane)[64 * j] = pk4_fp8(y.x, y.y, y.z, y.w);
        if (OB16) { v2u w; w.x = pk2(y.x, y.y); w.y = pk2(y.z, y.w); ((v2u*)o16 + lane)[64 * j] = w; } }
}

constexpr float C2S = 0.08838834764831845f * 1.4426950408889634f;
constexpr int ATT_KP = 144, ATT_VP = 80;
constexpr int ATT_KB = 32 * ATT_KP, ATT_VB = 128 * ATT_VP, ATT_BUF = ATT_KB + ATT_VB;
__device__ __forceinline__ bf16x8 f8x8_to_bf16x8(v2u w) {
    const f32x2v a = __builtin_amdgcn_cvt_pk_f32_fp8((int)w.x, false), b = __builtin_amdgcn_cvt_pk_f32_fp8((int)w.x, true), c = __builtin_amdgcn_cvt_pk_f32_fp8((int)w.y, false), d = __builtin_amdgcn_cvt_pk_f32_fp8((int)w.y, true);
    v4u o; o.x = pk2(a.x, a.y); o.y = pk2(b.x, b.y); o.z = pk2(c.x, c.y); o.w = pk2(d.x, d.y); return __builtin_bit_cast(bf16x8, o); }
struct AttPair { unsigned uq, uk, uv, orow; int j0, g; };
__device__ __forceinline__ AttPair att_decode(int pi, int grp, int qw) {
    AttPair d; const int uid = 2 * pi + grp, g = 2 - (uid >> 10), rest = uid & 1023, blk = rest & 15, h = (rest >> 4) & 15, b = rest >> 8;
    const int dsh = 2 * g; const bool has_prev = (blk & ((16 >> dsh) - 1)) != 0;
    d.j0 = __builtin_amdgcn_readfirstlane(has_prev ? 0 : 4); d.g = __builtin_amdgcn_readfirstlane(g);
    d.uq = __builtin_amdgcn_readfirstlane((unsigned)((((g * 2 + 0) * 4 + b) * 16 + h) * 2048 + blk * 128 + qw * 32) * 128u);
    d.uk = __builtin_amdgcn_readfirstlane((unsigned)((((g * 2 + 1) * 4 + b) * 16 + h) * 2048 + blk * 128 - 128) * 128u);
    d.uv = __builtin_amdgcn_readfirstlane((unsigned)(g * 2048 * 8192 + (b * 64 + blk * 4 - 4) * 65536 + h * 128 * 32) * 2u);
    d.orow = __builtin_amdgcn_readfirstlane((unsigned)(((g * 4 + b) * 16 + h) * 2048 + blk * 128 + qw * 32));
    return d;
}
__device__ __forceinline__ void attn_phase(const bf16* QK, const bf16* VT, bf16* OG, float* LSE, int bx, int G, int wave, int lane, LAS unsigned char* lds) {
    const int q = lane & 31, hh = lane >> 5, grp = wave >> 2, qw = wave & 3;
    const int kperm = (q & 0x13) | ((q & 4) << 1) | ((q & 8) >> 1);
    const char* QKc = (const char*)QK; const char* VTc = (const char*)VT;
    LAS unsigned char* gl = lds + grp * (2 * ATT_BUF);
    const int L2 = (qw * 64 + lane) * 2, L1 = qw * 64 + lane;
    const unsigned kw0 = (unsigned)((L1 >> 3) * ATT_KP + (L1 & 7) * 16);
    const unsigned vw0 = (unsigned)(ATT_KB + (L2 >> 2) * ATT_VP + (L2 & 3) * 16), vw1 = (unsigned)(ATT_KB + ((L2 + 1) >> 2) * ATT_VP + ((L2 + 1) & 3) * 16);
    const unsigned kr = (unsigned)(kperm * ATT_KP + 8 * hh), vr = (unsigned)(ATT_KB + q * ATT_VP + 16 * hh);
    const unsigned lqo = (unsigned)(q * 128 + 8 * hh);
    int pi = bx; if (pi >= 1536) return;
    v4u st[4][3]; long qf[8], qn[8];
#define ATT_FETCH(P, J, D) do { const char* kp_ = QKc + ((P).uk + (unsigned)(J) * 4096u + (unsigned)L1 * 16u); const char* vp_ = VTc + ((P).uv + (unsigned)(J) * 131072u + (unsigned)L2 * 16u); \
            D[0] = *(const v4u*)kp_; D[1] = *(const v4u*)vp_; D[2] = *(const v4u*)(vp_ + 16); } while (0)
#define ATT_PARK(J, D) do { LAS unsigned char* wb_ = gl + ((J) & 1) * ATT_BUF; *(LAS v4u*)(wb_ + kw0) = D[0]; *(LAS v4u*)(wb_ + vw0) = D[1]; *(LAS v4u*)(wb_ + vw1) = D[2]; } while (0)
#define ATT_LDQ(P, D) do { const char* qp_ = QKc + ((P).uq + lqo); _Pragma("unroll") for (int c = 0; c < 8; ++c) D[c] = *(const long*)(qp_ + 16 * c); } while (0)
    AttPair cur = att_decode(pi, grp, qw);
    ATT_LDQ(cur, qf);
    ATT_FETCH(cur, cur.j0, st[0]); ATT_FETCH(cur, cur.j0 + 1, st[1]); ATT_FETCH(cur, cur.j0 + 2, st[2]); ATT_FETCH(cur, cur.j0 + 3, st[3]);
    ATT_PARK(0, st[0]);
    asm volatile("s_waitcnt lgkmcnt(0)\n\ts_barrier" ::: "memory");
    for (;;) {
        const bool has_next = pi + G < 1536;
        AttPair nxt = cur; if (has_next) nxt = att_decode(pi + G, grp, qw);
        const int j0 = cur.j0;
        f32x16 O[4];
#pragma unroll
        for (int db = 0; db < 4; ++db)
#pragma unroll
            for (int i = 0; i < 16; ++i) O[db][i] = 0.f;
        float m = -INFINITY, l = 0.f;
#pragma unroll
        for (int j = 0; j < 8; ++j) {
            if (j < 4 && cur.g == 2) continue;
            if (j < 4) { if (j0 == 0) ATT_FETCH(cur, j + 4, st[j & 3]); }
            else if (has_next) { ATT_FETCH(nxt, nxt.j0 + (j - 4), st[j & 3]); if (j == 4) ATT_LDQ(nxt, qn); }
            const int t = j - qw;
            if (j >= j0 && t >= 0 && t <= 4) {
                const LAS unsigned char* rb = gl + (j & 1) * ATT_BUF;
                f32x16 S;
#pragma unroll
                for (int i = 0; i < 16; ++i) S[i] = 0.f;
                long kf[8]; bf16x8 vf[4][2];
#pragma unroll
                for (int c = 0; c < 8; ++c) kf[c] = *(const LAS long*)(rb + kr + 16 * c);
#pragma unroll
                for (int db = 0; db < 4; ++db) { vf[db][0] = *(const LAS bf16x8*)(rb + vr + db * 32 * ATT_VP); vf[db][1] = *(const LAS bf16x8*)(rb + vr + db * 32 * ATT_VP + 32); }
                __builtin_amdgcn_sched_barrier(0);
#pragma unroll
                for (int c = 0; c < 8; ++c) S = __builtin_amdgcn_mfma_f32_32x32x16_fp8_fp8(kf[c], qf[c], S, 0, 0, 0);
                if (t == 0) {
#pragma unroll
                    for (int i = 0; i < 16; ++i) { const int kt = 16 * (i >> 3) + 8 * hh + (i & 7); if (kt < q) S[i] = -INFINITY; }
                }
                if (t == 4) {
#pragma unroll
                    for (int i = 0; i < 16; ++i) { const int kt = 16 * (i >> 3) + 8 * hh + (i & 7); if (kt > q) S[i] = -INFINITY; }
                }
                float mx = S[0];
#pragma unroll
                for (int i = 1; i < 16; ++i) mx = fmaxf(mx, S[i]);
                mx = fmaxf(mx, __shfl_xor(mx, 32)) * C2S;
                if (__builtin_amdgcn_ballot_w64(mx > m + 8.0f) != 0ull) { const float mn = fmaxf(m, mx), alpha = __builtin_amdgcn_exp2f(m - mn); l *= alpha; m = mn;
#pragma unroll
                    for (int db = 0; db < 4; ++db)
#pragma unroll
                        for (int i = 0; i < 16; ++i) O[db][i] *= alpha; }
                float rs = 0.f;
#pragma unroll
                for (int i = 0; i < 16; ++i) { S[i] = __builtin_amdgcn_exp2f(__builtin_fmaf(S[i], C2S, -m)); rs += S[i]; }
                l += rs;
                v4u w0, w1;
                w0.x = pk2(S[0], S[1]); w0.y = pk2(S[2], S[3]); w0.z = pk2(S[4], S[5]); w0.w = pk2(S[6], S[7]);
                w1.x = pk2(S[8], S[9]); w1.y = pk2(S[10], S[11]); w1.z = pk2(S[12], S[13]); w1.w = pk2(S[14], S[15]);
                const bf16x8 ps0 = __builtin_bit_cast(bf16x8, w0), ps1 = __builtin_bit_cast(bf16x8, w1);
#pragma unroll
                for (int db = 0; db < 4; ++db) { O[db] = MFMA32(vf[db][0], ps0, O[db]); O[db] = MFMA32(vf[db][1], ps1, O[db]); }
            }
            if (j < 7) { if (j + 1 >= j0 + 1) ATT_PARK(j + 1, st[(j + 1) & 3]); }
            else if (has_next) ATT_PARK(0, st[0]);
            asm volatile("s_waitcnt lgkmcnt(0)\n\ts_barrier" ::: "memory");
        }
        l += __shfl_xor(l, 32);
        const float inv = 1.0f / l, lse2 = m + __builtin_amdgcn_logf(l);
        { LAS unsigned char* ob = lds + 61440 + wave * (32 * 272);
#pragma unroll
          for (int db = 0; db < 4; ++db)
#pragma unroll
              for (int i4 = 0; i4 < 4; ++i4) { v2u w; w.x = pk2(O[db][4 * i4] * inv, O[db][4 * i4 + 1] * inv); w.y = pk2(O[db][4 * i4 + 2] * inv, O[db][4 * i4 + 3] * inv);
                  *(LAS v2u*)(ob + q * 272 + (db * 32 + 8 * i4 + 4 * hh) * 2) = w; }
          asm volatile("s_waitcnt lgkmcnt(0)" ::: "memory");
          __attribute__((address_space(1))) unsigned char* og = (__attribute__((address_space(1))) unsigned char*)OG + (size_t)cur.orow * 256;
          const unsigned lo = (unsigned)((lane >> 4) * 256 + (lane & 15) * 16), li = (unsigned)((lane >> 4) * 272 + (lane & 15) * 16);
#pragma unroll
          for (int k = 0; k < 8; ++k) { const v4u x = *(const LAS v4u*)(ob + li + k * (4 * 272)); *(__attribute__((address_space(1))) v4u*)(og + (lo + (unsigned)k * 1024u)) = x; }
          asm volatile("s_waitcnt lgkmcnt(0)" ::: "memory"); }
        if (hh == 0) LSE[cur.orow + q] = lse2;
        if (!has_next) break;
        cur = nxt; pi += G;
#pragma unroll
        for (int c = 0; c < 8; ++c) qf[c] = qn[c];
    }
#undef ATT_FETCH
#undef ATT_PARK
#undef ATT_LDQ
}
__device__ __forceinline__ void merge_phase(const bf16* OG, const float* LSE, const bf16* GATE, bf16* Y, int gw, int NGW, int lane) {
    for (int row = gw; row < MTOK; row += NGW) { const int b = row >> 11, s = row & 2047;
#pragma unroll
        for (int j = 0; j < 4; ++j) { const int col = lane * 8 + 512 * j, h = col >> 7, e = col & 127;
            size_t r[3]; float lg[3];
#pragma unroll
            for (int g = 0; g < 3; ++g) { const int dsh = 2 * g, p = ((s & ((1 << dsh) - 1)) << (11 - dsh)) | (s >> dsh); r[g] = ((size_t)(g * 4 + b) * 16 + h) * 2048 + p; lg[g] = LSE[r[g]]; }
            const float mx = fmaxf(lg[0], fmaxf(lg[1], lg[2]));
            float w0 = __builtin_amdgcn_exp2f(lg[0] - mx), w1 = __builtin_amdgcn_exp2f(lg[1] - mx), w2 = __builtin_amdgcn_exp2f(lg[2] - mx);
            const float inv = 1.0f / (w0 + w1 + w2); w0 *= inv; w1 *= inv; w2 *= inv;
            const v4u a = *(const v4u*)(OG + r[0] * 128 + e), bb = *(const v4u*)(OG + r[1] * 128 + e), c = *(const v4u*)(OG + r[2] * 128 + e), gt = *(const v4u*)(GATE + (size_t)row * 2048 + col);
            v4u o;
#pragma unroll
            for (int k = 0; k < 4; ++k) {
                const float ylo = (w0 * bflo(a[k]) + w1 * bflo(bb[k]) + w2 * bflo(c[k])) * bflo(gt[k]);
                const float yhi = (w0 * bfhi(a[k]) + w1 * bfhi(bb[k]) + w2 * bfhi(c[k])) * bfhi(gt[k]);
                o[k] = pk2(ylo, yhi); }
            *(v4u*)(Y + (size_t)row * 2048 + col) = o; }
    }
}
__device__ __forceinline__ void sgu_phase(const bf16* VTB, const float* STATS, const float* LNG, const float* LNB, const bf16* WM, const float* BS, const bf16* U, const bf16* ZS, bf16* Y,
                                          int gw, int NGW, int lane) {
    const int r = lane & 31, hh = lane >> 5;
    for (int wu = gw; wu < 4096; wu += NGW) {
        const int cblk = wu & 3, g = (wu >> 2) & 15, chunk = (wu >> 6) & 15, b = wu >> 10;
        const int ch = g * 128 + cblk * 32 + r, tok0 = b * 2048 + chunk * 128;
        v4u raw[8];
#pragma unroll
        for (int ks = 0; ks < 8; ++ks) raw[ks] = *(const v4u*)(VTB + (size_t)((tok0 + 16 * ks) >> 5) * 65536 + (size_t)ch * 32 + ((16 * ks) & 31) + 8 * hh);
        v2u uu[4][4], zz[4][4]; float bs[4];
        const size_t rowoff0 = (size_t)(tok0 + r) * 2048 + g * 128 + cblk * 32 + 4 * hh;
#pragma unroll
        for (int tb = 0; tb < 4; ++tb) { bs[tb] = BS[g * 128 + tb * 32 + r];
#pragma unroll
            for (int i4 = 0; i4 < 4; ++i4) { uu[tb][i4] = *(const v2u*)(U + rowoff0 + (size_t)tb * 32 * 2048 + 8 * i4); zz[tb][i4] = *(const v2u*)(ZS + rowoff0 + (size_t)tb * 32 * 2048 + 8 * i4); } }
        const float lng = LNG[ch], lnb = LNB[ch];
        bf16x8 af[8];
#pragma unroll
        for (int ks = 0; ks < 8; ++ks) { v4u o; const f32x4* sp = (const f32x4*)(STATS + 2 * (size_t)(tok0 + 16 * ks + 8 * hh));
#pragma unroll
            for (int k = 0; k < 4; ++k) { const f32x4 sv = sp[k];
                const float mu0 = sv.x * (1.0f / 2048), mu1 = sv.z * (1.0f / 2048);
                const float a0 = lng * __builtin_amdgcn_rsqf(fmaxf(sv.y * (1.0f / 2048) - mu0 * mu0, 0.f) + LN_EPS), a1 = lng * __builtin_amdgcn_rsqf(fmaxf(sv.w * (1.0f / 2048) - mu1 * mu1, 0.f) + LN_EPS);
                o[k] = pk2(bflo(raw[ks][k]) * a0 + (lnb - mu0 * a0), bfhi(raw[ks][k]) * a1 + (lnb - mu1 * a1)); }
            af[ks] = __builtin_bit_cast(bf16x8, o); }
        bf16x8 wf[2][8];
        { const bf16* wp = WM + (size_t)(g * 128 + r) * 128 + 8 * hh; wf[0][0] = *(const bf16x8*)wp; wf[0][1] = *(const bf16x8*)(wp + 16); }
#pragma unroll
        for (int tb = 0; tb < 4; ++tb) {
            f32x16 D;
#pragma unroll
            for (int i = 0; i < 16; ++i) D[i] = 0.f;
#pragma unroll
            for (int ks = 0; ks < 2 * tb + 2; ++ks) D = MFMA32(af[ks], wf[tb & 1][ks], D);
            __builtin_amdgcn_sched_barrier(0);
            if (tb < 3) { const bf16* wp = WM + (size_t)(g * 128 + (tb + 1) * 32 + r) * 128 + 8 * hh;
#pragma unroll
                for (int ks = 0; ks < 2 * tb + 4; ++ks) wf[(tb + 1) & 1][ks] = *(const bf16x8*)(wp + 16 * ks); }
            __builtin_amdgcn_sched_barrier(0);
#pragma unroll
            for (int i4 = 0; i4 < 4; ++i4) { const v2u u4 = uu[tb][i4], z4 = zz[tb][i4];
                v2u w; w.x = pk2(bflo(u4.x) * (D[4 * i4] + bs[tb]) * bflo(z4.x), bfhi(u4.x) * (D[4 * i4 + 1] + bs[tb]) * bfhi(z4.x));
                w.y = pk2(bflo(u4.y) * (D[4 * i4 + 2] + bs[tb]) * bflo(z4.y), bfhi(u4.y) * (D[4 * i4 + 3] + bs[tb]) * bfhi(z4.y));
                *(v2u*)(Y + rowoff0 + (size_t)tb * 32 * 2048 + 8 * i4) = w; }
        }
    }
}

constexpr int N_PHASES = 19;
__global__ void __launch_bounds__(NTHR) trunk_fwd(Args args) {
    extern __shared__ __attribute__((aligned(16))) unsigned char lds[];
    const int wave = __builtin_amdgcn_readfirstlane(threadIdx.x >> 6);
#define tid (wave * 64 + lane_id())
#define lane lane_id()
    const int G = gridDim.x, bx = blockIdx.x;
    const int gw = bx * NWAVES + wave, NGW = G * NWAVES;
    unsigned char* ws = args.ws;
#define WS_PTRS unsigned char* wl_ = ws; asm volatile("" : "+s"(wl_)); bf16* WAin = (bf16*)(wl_ + WS_WAIN); bf16* WAout = (bf16*)(wl_ + WS_WAOUT); bf16* WBin = (bf16*)(wl_ + WS_WBIN); bf16* WBout = (bf16*)(wl_ + WS_WBOUT); bf16* WM = (bf16*)(wl_ + WS_WM); float* COS = (float*)(wl_ + WS_COS); float* SIN = (float*)(wl_ + WS_SIN); float* STATS = (float*)(wl_ + WS_STATS); float* LSE = (float*)(wl_ + WS_LSE); float* X = (float*)(wl_ + WS_X); bf16* XN = (bf16*)(wl_ + WS_XN); bf16* QK = (bf16*)(wl_ + WS_QK); bf16* VT = (bf16*)(wl_ + WS_VT); bf16* GATE = (bf16*)(wl_ + WS_GATE); bf16* OG = (bf16*)(wl_ + WS_OG); bf16* Y = (bf16*)(wl_ + WS_Y); bf16* U = OG; bf16* ZS = OG + (size_t)MTOK * 2048; unsigned char* XN8 = wl_ + WS_XN8; float* RSS = (float*)(wl_ + WS_RSS); (void)RSS; (void)WAin; (void)WAout; (void)WBin; (void)WBout; (void)WM; (void)COS; (void)SIN; (void)STATS; (void)LSE; (void)X; (void)XN; (void)QK; (void)VT; (void)GATE; (void)OG; (void)Y; (void)U; (void)ZS; (void)XN8;
    const int lo = args.ph_lo, hi = args.ph_hi; (void)lo; (void)hi;
#if MK_PER_PHASE
#define IN(k) (lo <= (k) && (k) < hi)
#else
#define IN(k) true
#endif
    volatile LAS unsigned* MISC = (volatile LAS unsigned*)((LAS unsigned char*)lds + 131072 + 320);
    if (tid < 32) MISC[tid] = 0u;
    unsigned* barw = (unsigned*)(ws + WS_BAR);
#if !MK_PER_PHASE
    if (bx == 0) for (int i = tid; i < XCD_BAR_WORDS; i += NTHR) __hip_atomic_store(barw + i, 0u, __ATOMIC_RELAXED, __HIP_MEMORY_SCOPE_AGENT);
#endif
    __syncthreads();
    XcdBarrier xbar; xbar.w = wave; xbar.bar = barw; xbar.x = 0; xbar.st = MISC + 8;
#if MK_PER_PHASE
#define SEAM(k) do { } while (0)
#else
#define SEAM(k) do { if (IN(k) && IN((k) + 1)) xcd_barrier(xbar); } while (0)
#endif
    if (IN(0)) { WS_PTRS
        LAS float* scr = (LAS float*)((LAS unsigned char*)lds + wave * 16384);
        constexpr int I_AIN = 32 * (A_IN / 32), I_SQ = 32 * (DM / 32), I_BIN = 32 * (B_IN / 32);
        constexpr int NITEMS = 2 * (I_AIN + I_SQ + I_BIN + I_SQ);
        for (int it = gw; it < NITEMS; it += NGW) {
            int r = it; const int j = r / (NITEMS / 2); r -= j * (NITEMS / 2);
            if (r < I_AIN) { const int nblk = A_IN / 32, kb = r / nblk, nb = r % nblk, sb = (nb * 32) / 2048;
                unsigned char* W8 = (unsigned char*)WAin + (size_t)j * A_IN * DM * 2; bf16* W16 = (bf16*)(W8 + 48 * MiB);
                const float* src = args.a_w_in + (size_t)j * DM * A_IN;
                if (sb < 9 && (sb % 3) < 2) p0_transpose_item_f8(src, DM, A_IN, W8, (2 * (sb / 3) + (sb % 3) - sb) * 2048, scr, kb, nb, lane);
                else if (A_VG_FP8 && !(A_GATE_BF16 && sb == 9)) p0_transpose_item_f8(src, DM, A_IN, W8, ((sb == 9 ? 6 : 7 + sb / 3) - sb) * 2048, scr, kb, nb, lane);
                else p0_transpose_item(src, DM, A_IN, W16, ((sb == 9 ? 0 : 1 + sb / 3) - sb) * 2048, scr, kb, nb, lane);
                continue; } r -= I_AIN;
            if (r < I_SQ) { p0_transpose_item(args.a_w_out + (size_t)j * DM * DM, DM, DM, WAout + (size_t)j * DM * DM, 0, scr, r / (DM / 32), r % (DM / 32), lane); continue; } r -= I_SQ;
            if (r < I_BIN) { const int nblk = B_IN / 32, kb = r / nblk, nb = r % nblk, sb = (nb * 32) / 2048;
                const int db = sb == 0 ? 0 : (sb == 1 ? 2 : 1);
                p0_transpose_item(args.b_w_in + (size_t)j * DM * B_IN, DM, B_IN, WBin + (size_t)j * B_IN * DM, (db - sb) * 2048, scr, kb, nb, lane); continue; } r -= I_BIN;
            p0_transpose_item(args.b_w_out + (size_t)j * DM * DM, DM, DM, WBout + (size_t)j * DM * DM, 0, scr, r / (DM / 32), r % (DM / 32), lane);
        }
        const int gt = bx * NTHR + tid, NGT = G * NTHR;
        for (int i = gt; i < 2 * 16 * 128 * 128 / 2; i += NGT) { const int e = 2 * i, s = e & 127, t = (e >> 7) & 127;
            const f32x2v w = *(const f32x2v*)(args.b_w_s + e); ((unsigned*)WM)[i] = pk2(s <= t ? w.x : 0.f, s + 1 <= t ? w.y : 0.f); }
        for (int i = gt; i < MTOK * 16; i += NGT) { const int tok = i >> 4, f = i & 15; const double rev = (double)args.pos[tok] * args.invf[f]; const float fr = (float)(rev - floor(rev));
            COS[i] = __builtin_amdgcn_cosf(fr); SIN[i] = __builtin_amdgcn_sinf(fr); }
        for (int i = gt; i < 2 * MTOK * 2; i += NGT) STATS[i] = 0.f;
        for (int i = gt; i < 4 * MTOK; i += NGT) RSS[i] = i < MTOK ? 2048.0f * (1.0f - 1e-6f) : 0.f;
        for (int m = gw; m < MTOK; m += NGW) rms_row<(!A_VG_FP8 || A_GATE_BF16), false, true>(args.x + (size_t)m * DM, args.a_norm_g, XN + (size_t)m * DM, nullptr, XN8 + (size_t)m * DM, lane);
    }
#if !MK_PER_PHASE
    cg::this_grid().sync();
    xbar = xcd_barrier_post(barw, MISC + 8, wave);
#endif
    for (int rep = 0; rep < 2; ++rep) {
        const int P = 1 + 9 * rep;
        if (IN(P)) { WS_PTRS
            const char* W8 = (const char*)WAin + (size_t)rep * A_IN * DM * 2;
            const float* rssA = RSS + (size_t)(2 * rep) * MTOK;
            const pg8::EpiA1 e1{QK, GATE, COS, SIN, 1.0f / W8_SCALE, 0, rssA};
#if A_VG_FP8 && A_GATE_BF16
            { pg8::MultiOrder S{{(const char*)XN8, W8, 32, 48, 1}, {W8 + (size_t)14336 * DM, (const char*)XN8, 8, 32, 1}, {W8 + (size_t)16384 * DM, (const char*)XN8, 8, 32, 4},
                                {W8 + (size_t)18432 * DM, (const char*)XN8, 8, 32, 16}, 4, launder_s(G), launder_s(bx), DM};
              pg8::EpiAllA E{e1, pg8::EpiPlain{VT, 1.0f / W8_SCALE, rssA, 0}, 1};
              pg8::gemm_phase<pg8::EpiAllA, pg8::MultiOrder, true, true, true>((LAS unsigned char*)lds, DM, S, E, wave); }
            { const char* W16 = W8 + 48 * MiB;
              pg8::MultiOrder S{{(const char*)XN, W16, 32, 8, 1}, {nullptr, nullptr, 0, 0, 1}, {nullptr, nullptr, 0, 0, 1}, {nullptr, nullptr, 0, 0, 1}, 1, launder_s(G), launder_s(bx), DM * 2};
              const pg8::EpiA1 eg{QK, GATE, COS, SIN, 1.0f, 48, rssA};
              pg8::gemm_phase<pg8::EpiA1, pg8::MultiOrder, true, true, false>((LAS unsigned char*)lds, DM, S, eg, wave); }
#elif A_VG_FP8
            pg8::MultiOrder S{{(const char*)XN8, W8, 32, 56, 1}, {W8 + (size_t)14336 * DM, (const char*)XN8, 8, 32, 1}, {W8 + (size_t)16384 * DM, (const char*)XN8, 8, 32, 4},
                              {W8 + (size_t)18432 * DM, (const char*)XN8, 8, 32, 16}, 4, launder_s(G), launder_s(bx), DM};
            pg8::EpiAllA E{e1, pg8::EpiPlain{VT, 1.0f / W8_SCALE, rssA, 0}, 1};
            pg8::gemm_phase<pg8::EpiAllA, pg8::MultiOrder, true, true, true>((LAS unsigned char*)lds, DM, S, E, wave);
#else
            { pg8::MultiOrder S{{(const char*)XN8, W8, 32, 48, 1}, {nullptr, nullptr, 0, 0, 1}, {nullptr, nullptr, 0, 0, 1}, {nullptr, nullptr, 0, 0, 1}, 1, launder_s(G), launder_s(bx), DM};
              pg8::gemm_phase<pg8::EpiA1, pg8::MultiOrder, true, true, true>((LAS unsigned char*)lds, DM, S, e1, wave); }
            { const char* W16 = W8 + 48 * MiB;
              pg8::MultiOrder S{{(const char*)XN, W16, 32, 8, 1}, {W16 + (size_t)2048 * DM * 2, (const char*)XN, 8, 32, 1}, {W16 + (size_t)4096 * DM * 2, (const char*)XN, 8, 32, 4},
                                {W16 + (size_t)6144 * DM * 2, (const char*)XN, 8, 32, 16}, 4, launder_s(G), launder_s(bx), DM * 2};
              pg8::EpiAllA E{pg8::EpiA1{QK, GATE, COS, SIN, 1.0f, 48, rssA}, pg8::EpiPlain{VT, 1.0f, rssA, 0}, 1};
              pg8::gemm_phase<pg8::EpiAllA, pg8::MultiOrder, true, true, false>((LAS unsigned char*)lds, DM, S, E, wave); }
#endif
        }
        SEAM(P);
        if (IN(P + 1)) { WS_PTRS attn_phase(QK, VT, OG, LSE, bx, G, wave, launder(lane), (LAS unsigned char*)lds); }
        SEAM(P + 1);
        if (IN(P + 2)) { WS_PTRS merge_phase(OG, LSE, GATE, Y, gw, NGW, launder(lane)); }
        SEAM(P + 2);
        if (IN(P + 3)) { WS_PTRS pg8::MultiOrder S{{(const char*)Y, (const char*)(WAout + (size_t)rep * DM * DM), 32, 8, 1}, {nullptr, nullptr, 0, 0, 1}, {nullptr, nullptr, 0, 0, 1}, {nullptr, nullptr, 0, 0, 1}, 1, launder_s(G), launder_s(bx), DM * 2};
            pg8::EpiOut E{rep == 0 ? args.x : X, X, args.b_norm_g + (size_t)rep * DM, XN, nullptr, RSS + (size_t)(2 * rep + 1) * MTOK};
            pg8::gemm_phase<pg8::EpiOut, pg8::MultiOrder, true, true>((LAS unsigned char*)lds, DM, S, E, wave); }
        SEAM(P + 3);
        if (IN(P + 5)) { WS_PTRS
            const char* W = (const char*)(WBin + (size_t)rep * B_IN * DM);
            pg8::MultiOrder S{{(const char*)XN, W, 32, 16, 1}, {W + (size_t)4096 * DM * 2, (const char*)XN, 8, 32, 1}, {nullptr, nullptr, 0, 0, 1}, {nullptr, nullptr, 0, 0, 1}, 2, launder_s(G), launder_s(bx), DM * 2};
            const float* rssB = RSS + (size_t)(2 * rep + 1) * MTOK;
            pg8::EpiAllB E{pg8::EpiB1{U, ZS, rssB}, pg8::EpiB2{VT, STATS + (size_t)rep * MTOK * 2, rssB}};
            pg8::gemm_phase<pg8::EpiAllB, pg8::MultiOrder, true, true>((LAS unsigned char*)lds, DM, S, E, wave);
        }
        SEAM(P + 5);
        if (IN(P + 6)) { WS_PTRS sgu_phase(VT, STATS + (size_t)rep * MTOK * 2, args.b_ln_g + (size_t)rep * DM, args.b_ln_b + (size_t)rep * DM, WM + (size_t)rep * 16 * 128 * 128, args.b_b_s + (size_t)rep * 16 * 128, U, ZS, Y, gw, NGW, launder(lane)); }
        SEAM(P + 6);
        if (IN(P + 7)) { WS_PTRS pg8::MultiOrder S{{(const char*)Y, (const char*)(WBout + (size_t)rep * DM * DM), 32, 8, 1}, {nullptr, nullptr, 0, 0, 1}, {nullptr, nullptr, 0, 0, 1}, {nullptr, nullptr, 0, 0, 1}, 1, launder_s(G), launder_s(bx), DM * 2};
            pg8::EpiOut E{X, X, rep == 0 ? args.a_norm_g + DM : nullptr, XN, XN8, RSS + (size_t)2 * MTOK};
            pg8::gemm_phase<pg8::EpiOut, pg8::MultiOrder, true, true>((LAS unsigned char*)lds, DM, S, E, wave); }
        if (rep == 1) SEAM(P + 7);
        if (IN(P + 8)) { WS_PTRS const int ln = launder(lane);
            if (rep == 1) { for (int m = gw; m < MTOK; m += NGW) rms_row<false, true, false>(X + (size_t)m * DM, args.final_g, nullptr, args.out + (size_t)m * DM, nullptr, ln); }
        }
        if (rep == 0) SEAM(P + 8);
    }
#undef IN
#undef SEAM
#undef tid
#undef lane
}

extern "C" void kernel_launch(void* const* d_in, const int* in_sizes, int n_in, void* d_out, int out_size, void* d_ws, size_t ws_size, hipStream_t stream) {
    static int grid = 0;
    if (grid == 0) {
        if (n_in != 13 || in_sizes[0] != MTOK * DM || out_size != MTOK * DM || ws_size < WS_END) { fprintf(stderr, "kernel_launch: unexpected shapes / workspace (n_in %d, in0 %d, out %d, ws %zu, need %zu)\n", n_in, n_in > 0 ? in_sizes[0] : -1, out_size, ws_size, (size_t)WS_END); grid = -1; return; }
        int dev = 0, cus = 0, per_cu = 0;
        if (hipGetDevice(&dev) != hipSuccess || hipDeviceGetAttribute(&cus, hipDeviceAttributeMultiprocessorCount, dev) != hipSuccess) { grid = -1; return; }
        if (hipFuncSetAttribute((const void*)trunk_fwd, hipFuncAttributeMaxDynamicSharedMemorySize, LDS_BYTES) != hipSuccess) { fprintf(stderr, "kernel_launch: hipFuncSetAttribute failed\n"); grid = -1; return; }
        if (hipOccupancyMaxActiveBlocksPerMultiprocessor(&per_cu, (const void*)trunk_fwd, NTHR, LDS_BYTES) != hipSuccess || per_cu < 1) { fprintf(stderr, "kernel_launch: occupancy query failed (%d)\n", per_cu); (void)hipGetLastError(); grid = -1; return; }
        grid = cus * per_cu;
    }
    if (grid < 0) return;
    Args a{};
    a.x = (const float*)d_in[0]; a.pos = (const int*)d_in[1]; a.a_norm_g = (const float*)d_in[2]; a.a_w_in = (const float*)d_in[3]; a.a_w_out = (const float*)d_in[4];
    a.b_norm_g = (const float*)d_in[5]; a.b_w_in = (const float*)d_in[6]; a.b_ln_g = (const float*)d_in[7]; a.b_ln_b = (const float*)d_in[8]; a.b_w_s = (const float*)d_in[9];
    a.b_b_s = (const float*)d_in[10]; a.b_w_out = (const float*)d_in[11]; a.final_g = (const float*)d_in[12];
    a.out = (float*)d_out; a.ws = (unsigned char*)d_ws;
    for (int i = 0; i < 16; ++i) a.invf[i] = pow(500000.0, -(double)i / 16.0) / 6.283185307179586476925;
#if MK_PER_PHASE
    for (int p = 0; p < N_PHASES; ++p) { a.ph_lo = p; a.ph_hi = p + 1; hipLaunchKernelGGL(trunk_fwd, dim3(grid), dim3(NTHR), LDS_BYTES, stream, a); }
#else
    a.ph_lo = 0; a.ph_hi = N_PHASES;
    void* kargs[] = {&a};
    const hipError_t e = hipLaunchCooperativeKernel((const void*)trunk_fwd, dim3(grid), dim3(NTHR), kargs, LDS_BYTES, stream);
    if (e != hipSuccess) fprintf(stderr, "kernel_launch: cooperative launch failed: %s (grid %d)\n", hipGetErrorString(e), grid);
#endif
}
```

```cpp
#include <hip/hip_runtime.h>
#include <hip/hip_cooperative_groups.h>
#include <cstdio>
#include <cstdint>
#include <cmath>
namespace cg = cooperative_groups;
#ifndef A_VG_FP8
#define A_VG_FP8 1
#endif
#ifndef A_GATE_BF16
#define A_GATE_BF16 1
#endif
#ifndef MK_PER_PHASE
#define MK_PER_PHASE 0
#endif
__device__ __forceinline__ int lane_id() { int l; asm volatile("v_mbcnt_lo_u32_b32 %0, -1, 0\n\tv_mbcnt_hi_u32_b32 %0, -1, %0" : "=v"(l)); return l; }
namespace pg8 {
#define PG8_LAS __attribute__((address_space(3)))
typedef unsigned short bf16_t;
typedef short bf16x8 __attribute__((ext_vector_type(8)));
typedef float f32x4 __attribute__((ext_vector_type(4)));
typedef unsigned u32x4 __attribute__((ext_vector_type(4)));
typedef int i32x4 __attribute__((ext_vector_type(4)));
constexpr int BM = 256, BK = 64, HALF = 128, HTB = HALF * BK * 2  , STAGE_BYTES = 8 * HTB, NXCD = 8, WGM = 8;

__host__ __device__ __forceinline__ int lds_byte(int r, int c) { const int st = (r >> 4) * 2 + (c >> 5), rr = r & 15, cc = c & 31, ob = rr * 64 + cc * 2; return st * 1024 + (ob ^ (((ob >> 9) & 1) << 5)); }
__host__ __device__ __forceinline__ void stage_rc(int b, int& R, int& C) { const int st = b / 1024, sb = b % 1024, swz = sb ^ (((sb >> 9) & 1) << 5); R = (st >> 1) * 16 + swz / 64; C = (st & 1) * 32 + (swz % 64) / 2; }
__host__ __device__ __forceinline__ int perm32(int rho) { const int n = rho >> 4, i = rho & 15; return 8 * (i >> 2) + 4 * n + (i & 3); }

struct Unit { int pm, pn, k; };
struct Prob { const char* A; const char* B; int nM, nN, bdil; };
struct StaticOrder {
    int nM, nN, nwg, G, c;
    __host__ __device__ void init(int M, int N, int G_, int c_) { nM = M / BM; nN = N / BM; nwg = nM * nN; G = G_; c = c_; }
    __host__ __device__ bool next(int i, Unit& u) const {
        const long L = (long)i * G + c; if (L >= nwg) return false;
        int wgid = (int)L; { const int q = nwg / NXCD, r = nwg % NXCD, xcd = wgid % NXCD, off = wgid / NXCD; wgid = (xcd < r ? xcd * (q + 1) : r * (q + 1) + (xcd - r) * q) + off; }
        const int nig = WGM * nN, gid = wgid / nig, fm = gid * WGM, gsz = (nM - fm) < WGM ? (nM - fm) : WGM;
        u.pm = fm + ((wgid % nig) % gsz); u.pn = (wgid % nig) / gsz; return true;
    }
    __device__ __forceinline__ void a_ready(const Unit&) const {}
    __device__ __forceinline__ void done(const Unit&) const {}
};
struct MultiOrder {
    Prob p0, p1, p2, p3; int np, G, c, rowbytes;
    __device__ __forceinline__ static void map(const Prob& P, int wgid, Unit& u) {
        const int nM = P.nM, nN = P.nN, nwg = nM * nN;
        { const int q = nwg / NXCD, r = nwg % NXCD, xcd = wgid % NXCD, off = wgid / NXCD; wgid = (xcd < r ? xcd * (q + 1) : r * (q + 1) + (xcd - r) * q) + off; }
        const int nig = WGM * nN, gid = wgid / nig, fm = gid * WGM, gsz = (nM - fm) < WGM ? (nM - fm) : WGM;
        u.pm = fm + ((wgid % nig) % gsz); u.pn = (wgid % nig) / gsz;
    }
    __device__ __forceinline__ bool next(int i, Unit& u) const {
        long L = (long)i * G + c;
        { const int n = p0.nM * p0.nN; if (L < n) { map(p0, (int)L, u); u.k = 0; return true; } L -= n; }
        if (np > 1) { const int n = p1.nM * p1.nN; if (L < n) { map(p1, (int)L, u); u.k = 1; return true; } L -= n; }
        if (np > 2) { const int n = p2.nM * p2.nN; if (L < n) { map(p2, (int)L, u); u.k = 2; return true; } L -= n; }
        if (np > 3) { const int n = p3.nM * p3.nN; if (L < n) { map(p3, (int)L, u); u.k = 3; return true; } L -= n; }
        return false;
    }
    __device__ __forceinline__ const char* selA(int k) const { return k == 0 ? p0.A : (k == 1 ? p1.A : (k == 2 ? p2.A : p3.A)); }
    __device__ __forceinline__ const char* selB(int k) const { return k == 0 ? p0.B : (k == 1 ? p1.B : (k == 2 ? p2.B : p3.B)); }
    __device__ __forceinline__ int bdil(const Unit& u) const { return u.k == 0 ? p0.bdil : (u.k == 1 ? p1.bdil : (u.k == 2 ? p2.bdil : p3.bdil)); }
    __device__ __forceinline__ const char* a_base(const Unit& u) const { return selA(u.k) + (size_t)u.pm * 256 * rowbytes; }
    __device__ __forceinline__ const char* b_base(const Unit& u) const { const int d = bdil(u), t8 = u.pn & 7; const int r = (u.pn >> 3) * 2048 + (d == 1 ? 256 * t8 : (d == 4 ? 1024 * (t8 & 1) + (t8 >> 1) : 2 * t8)); return selB(u.k) + (size_t)r * rowbytes; }
    __device__ __forceinline__ void a_ready(const Unit&) const {}
    __device__ __forceinline__ void done(const Unit&) const {}
};


__device__ __forceinline__ unsigned cvt_pk_bf16(float lo, float hi) { unsigned r; asm volatile("v_cvt_pk_bf16_f32 %0, %1, %2" : "=v"(r) : "v"(lo), "v"(hi)); return r; }
typedef float f32x2 __attribute__((ext_vector_type(2)));
__device__ __forceinline__ f32x2 gelu_pk(f32x2 v) {
    const f32x2 av = __builtin_elementwise_abs(v), d = av * 0.2316418882f + 1.0f;
    f32x2 t; t.x = __builtin_amdgcn_rcpf(d.x); t.y = __builtin_amdgcn_rcpf(d.y);
    f32x2 q = t * 0.5307027145f + (-0.7265760135f); q = q * t + 0.7107068705f; q = q * t + (-0.142248368f); q = q * t + 0.127414796f; q = q * t;
    const f32x2 s = (v * v) * (-0.72134752044f);
    f32x2 e; e.x = __builtin_amdgcn_exp2f(s.x); e.y = __builtin_amdgcn_exp2f(s.y);
    const f32x2 m = v * (q * e), r = v - m;
    f32x2 o; o.x = v.x < 0.f ? m.x : r.x; o.y = v.y < 0.f ? m.y : r.y; return o;
}

constexpr float C2 = 0.08838834764831845f * 1.4426950408889634f;
__device__ __forceinline__ float silu_f(float x) { return x * __builtin_amdgcn_rcpf(1.0f + __builtin_amdgcn_exp2f(-1.4426950408889634f * x)); }
__device__ __forceinline__ u32x4 pack8(const f32x4& v0, const f32x4& v1) { u32x4 w; w.x = cvt_pk_bf16(v0[0], v0[1]); w.y = cvt_pk_bf16(v0[2], v0[3]); w.z = cvt_pk_bf16(v1[0], v1[1]); w.w = cvt_pk_bf16(v1[2], v1[3]); return w; }
__device__ __forceinline__ void gelu8(f32x4& v0, f32x4& v1) { f32x2 a = gelu_pk((f32x2){v0[0], v0[1]}), b = gelu_pk((f32x2){v0[2], v0[3]}), c = gelu_pk((f32x2){v1[0], v1[1]}), d = gelu_pk((f32x2){v1[2], v1[3]});
    v0 = (f32x4){a.x, a.y, b.x, b.y}; v1 = (f32x4){c.x, c.y, d.x, d.y}; }

struct EpiA1 {
    static constexpr bool PERM = true, AFTER_DRAIN = false;
    bf16_t* QK; bf16_t* GATE; const float* COS; const float* SIN; float osc; int pn0; const float* rss;
    __device__ __forceinline__ void operator()(const f32x4 (&acc)[2][2][4][2], const Unit& u, int wr, int wc, int fr, int fq) const {
        const int pn = u.pn + pn0; const int rowb = u.pm * BM + wr * 64 + fr;
        if (pn >= 48) {
            const int col0 = (pn - 48) * 256 + wc * 32 + 8 * fq;
#pragma unroll
            for (int ai = 0; ai < 2; ++ai)
#pragma unroll
                for (int m = 0; m < 4; ++m) { bf16_t* rowp = GATE + (size_t)(rowb + ai * HALF + m * 16) * 2048 + col0; const float rs = osc * __builtin_amdgcn_rsqf(rss[rowb + ai * HALF + m * 16] * (1.0f / 2048) + 1e-6f);
#pragma unroll
                    for (int bj = 0; bj < 2; ++bj) { f32x4 v0 = acc[ai][bj][m][0] * rs, v1 = acc[ai][bj][m][1] * rs;
#pragma unroll
                        for (int i = 0; i < 4; ++i) { v0[i] = silu_f(v0[i]); v1[i] = silu_f(v1[i]); }
                        *(u32x4*)(rowp + bj * HALF) = pack8(v0, v1); } }
        } else {
            const int g = pn >> 4, qk = (pn >> 3) & 1, hp = pn & 7, dsh = 2 * g, dm1 = (1 << dsh) - 1;
            const float sc = osc; const float sgn = fq < 2 ? -1.0f : 1.0f; const int e0 = wc * 32 + 8 * fq;
#pragma unroll
            for (int ai = 0; ai < 2; ++ai)
#pragma unroll
                for (int m = 0; m < 4; ++m) { const int row = rowb + ai * HALF + m * 16, b = row >> 11, s = row & 2047, p = ((s & dm1) << (11 - dsh)) | (s >> dsh);
                    f32x4 c0, c1, s0, s1; const float scr = sc * __builtin_amdgcn_rsqf(rss[row] * (1.0f / 2048) + 1e-6f);
                    if (wc == 0) { const float* cp = COS + (size_t)row * 16 + 8 * (fq & 1); const float* sp = SIN + (size_t)row * 16 + 8 * (fq & 1);
                        c0 = *(const f32x4*)cp; c1 = *(const f32x4*)(cp + 4); s0 = *(const f32x4*)sp; s1 = *(const f32x4*)(sp + 4);
                        }
#pragma unroll
                    for (int bj = 0; bj < 2; ++bj) { f32x4 v0 = acc[ai][bj][m][0], v1 = acc[ai][bj][m][1];
                        if (wc == 0) {
#pragma unroll
                            for (int i = 0; i < 4; ++i) { const float p0 = __shfl_xor(v0[i], 32), p1 = __shfl_xor(v1[i], 32);
                                v0[i] = v0[i] * c0[i] + sgn * p0 * s0[i]; v1[i] = v1[i] * c1[i] + sgn * p1 * s1[i]; } }
                        v0 = v0 * scr; v1 = v1 * scr;
                        unsigned char* dst = (unsigned char*)QK + ((((size_t)((g * 2 + qk) * 4 + b) * 16 + (2 * hp + bj)) * 2048 + p) * 128 + e0);
                        int w0 = 0, w1 = 0; w0 = __builtin_amdgcn_cvt_pk_fp8_f32(v0[0], v0[1], w0, false); w0 = __builtin_amdgcn_cvt_pk_fp8_f32(v0[2], v0[3], w0, true);
                        w1 = __builtin_amdgcn_cvt_pk_fp8_f32(v1[0], v1[1], w1, false); w1 = __builtin_amdgcn_cvt_pk_fp8_f32(v1[2], v1[3], w1, true);
                        *(unsigned long long*)dst = ((unsigned long long)(unsigned)w1 << 32) | (unsigned)w0; } }
        }
    }
};
struct EpiB1 {
    static constexpr bool PERM = true, AFTER_DRAIN = false;
    bf16_t* U; bf16_t* ZS; const float* rss;
    __device__ __forceinline__ void operator()(const f32x4 (&acc)[2][2][4][2], const Unit& u, int wr, int wc, int fr, int fq) const {
        const int pn = u.pn; const int rowb = u.pm * BM + wr * 64 + fr; const bool isz = pn >= 8;
        bf16_t* base = isz ? ZS : U; const int col0 = (pn & 7) * 256 + wc * 32 + 8 * fq;
#pragma unroll
        for (int ai = 0; ai < 2; ++ai)
#pragma unroll
            for (int m = 0; m < 4; ++m) { bf16_t* rowp = base + (size_t)(rowb + ai * HALF + m * 16) * 2048 + col0; const float rs = __builtin_amdgcn_rsqf(rss[rowb + ai * HALF + m * 16] * (1.0f / 2048) + 1e-6f);
#pragma unroll
                for (int bj = 0; bj < 2; ++bj) { f32x4 v0 = acc[ai][bj][m][0] * rs, v1 = acc[ai][bj][m][1] * rs;
                    if (isz) {
#pragma unroll
                        for (int i = 0; i < 4; ++i) { v0[i] = silu_f(v0[i]); v1[i] = silu_f(v1[i]); }
                    } else gelu8(v0, v1);
                    *(u32x4*)(rowp + bj * HALF) = pack8(v0, v1); } }
    }
};
struct EpiPlain {
    static constexpr bool PERM = true, AFTER_DRAIN = false;
    bf16_t* O; float osc; const float* rss; int dsh;
    __device__ __forceinline__ void operator()(const f32x4 (&acc)[2][2][4][2], const Unit& u, int wr, int wc, int fr, int fq) const {
        const int rowb = u.pm * BM + wr * 64 + fr; const int col0 = u.pn * BM + wc * 32 + 8 * fq;
#pragma unroll
        for (int bj = 0; bj < 2; ++bj) { const int c = col0 + bj * HALF, p = c & 2047, Lm1 = (2048 >> dsh) - 1; const float* rp = rss + (c & ~2047) + ((p & Lm1) << dsh) + (p >> (11 - dsh));
            f32x4 r0, r1;
#pragma unroll
            for (int k = 0; k < 4; ++k) { r0[k] = osc * __builtin_amdgcn_rsqf(rp[k << dsh] * (1.0f / 2048) + 1e-6f); r1[k] = osc * __builtin_amdgcn_rsqf(rp[(k + 4) << dsh] * (1.0f / 2048) + 1e-6f); }
#pragma unroll
            for (int ai = 0; ai < 2; ++ai)
#pragma unroll
                for (int m = 0; m < 4; ++m) { bf16_t* rowp = O + (size_t)((c >> 5)) * 65536 + (size_t)(rowb + ai * HALF + m * 16) * 32 + (c & 31);
                    *(u32x4*)rowp = pack8(acc[ai][bj][m][0] * r0, acc[ai][bj][m][1] * r1); } }
    }
};
struct EpiB2 {
    static constexpr bool PERM = true, AFTER_DRAIN = false;
    bf16_t* VT; float* STATS; const float* rss;
    __device__ __forceinline__ static float row16_sum(float v) {
        v += __builtin_bit_cast(float, __builtin_amdgcn_update_dpp(0, __builtin_bit_cast(int, v), 0xB1, 0xf, 0xf, true));
        v += __builtin_bit_cast(float, __builtin_amdgcn_update_dpp(0, __builtin_bit_cast(int, v), 0x4E, 0xf, 0xf, true));
        v += __builtin_bit_cast(float, __builtin_amdgcn_update_dpp(0, __builtin_bit_cast(int, v), 0x141, 0xf, 0xf, true));
        v += __builtin_bit_cast(float, __builtin_amdgcn_update_dpp(0, __builtin_bit_cast(int, v), 0x140, 0xf, 0xf, true));
        return v; }
    __device__ __forceinline__ void operator()(const f32x4 (&acc)[2][2][4][2], const Unit& u, int wr, int wc, int fr, int fq) const {
        const int rowb = u.pm * BM + wr * 64 + fr; const int col0 = u.pn * BM + wc * 32 + 8 * fq;
#pragma unroll
        for (int bj = 0; bj < 2; ++bj) {
            float s1[8], s2[8]; f32x4 r0 = *(const f32x4*)(rss + col0 + bj * HALF), r1 = *(const f32x4*)(rss + col0 + bj * HALF + 4);
#pragma unroll
            for (int k = 0; k < 4; ++k) { r0[k] = __builtin_amdgcn_rsqf(r0[k] * (1.0f / 2048) + 1e-6f); r1[k] = __builtin_amdgcn_rsqf(r1[k] * (1.0f / 2048) + 1e-6f); }
#pragma unroll
            for (int k = 0; k < 8; ++k) { s1[k] = 0.f; s2[k] = 0.f; }
#pragma unroll
            for (int ai = 0; ai < 2; ++ai)
#pragma unroll
                for (int m = 0; m < 4; ++m) { bf16_t* rowp = VT + (size_t)((col0 >> 5) + 4 * bj) * 65536 + (size_t)(rowb + ai * HALF + m * 16) * 32 + (col0 & 31);
                    f32x4 v0 = acc[ai][bj][m][0] * r0, v1 = acc[ai][bj][m][1] * r1; gelu8(v0, v1);
#pragma unroll
                    for (int i = 0; i < 4; ++i) { s1[i] += v0[i]; s2[i] += v0[i] * v0[i]; s1[4 + i] += v1[i]; s2[4 + i] += v1[i] * v1[i]; }
                    *(u32x4*)rowp = pack8(v0, v1); }
#pragma unroll
            for (int k = 0; k < 8; ++k) { const float a = row16_sum(s1[k]), b = row16_sum(s2[k]);
                if (fr == 0) { float* sp = STATS + 2 * (size_t)(col0 + bj * HALF + k); atomicAdd(sp, a); atomicAdd(sp + 1, b); } }
            asm volatile("" ::: "memory");
        }
    }
};
struct EpiAllA {
    static constexpr bool PERM = true, AFTER_DRAIN = false;
    EpiA1 e1; EpiPlain ev; int kv0;
    __device__ __forceinline__ void operator()(const f32x4 (&acc)[2][2][4][2], const Unit& u, int wr, int wc, int fr, int fq) const {
        if (u.k < kv0) e1(acc, u, wr, wc, fr, fq);
        else { EpiPlain e = ev; e.O += (size_t)(u.k - kv0) * 2048 * 8192; e.dsh = 2 * (u.k - kv0); e(acc, u, wr, wc, fr, fq); }
    }
};
struct EpiAllB {
    static constexpr bool PERM = true, AFTER_DRAIN = false;
    EpiB1 e1; EpiB2 e2;
    __device__ __forceinline__ void operator()(const f32x4 (&acc)[2][2][4][2], const Unit& u, int wr, int wc, int fr, int fq) const {
        if (u.k == 0) e1(acc, u, wr, wc, fr, fq); else e2(acc, u, wr, wc, fr, fq);
    }
};
struct EpiOut {
    static constexpr bool PERM = false, AFTER_DRAIN = false;
    const float* base; float* out; const float* gn; bf16_t* xb; unsigned char* x8; float* rss;
    __device__ __forceinline__ void operator()(const f32x4 (&acc)[2][2][4][2], const Unit& u, int wr, int wc, int fr, int fq) const {
        const int rowb = u.pm * BM + wr * 64 + fr; const int col0 = u.pn * BM + wc * 32 + 4 * fq;
        f32x4 gv[2][2];
        if (gn) {
#pragma unroll
            for (int bj = 0; bj < 2; ++bj)
#pragma unroll
                for (int n = 0; n < 2; ++n) gv[bj][n] = *(const f32x4*)(gn + col0 + bj * HALF + n * 16); }
#pragma unroll
        for (int ai = 0; ai < 2; ++ai)
#pragma unroll
            for (int m = 0; m < 4; ++m) { const int row = rowb + ai * HALF + m * 16; const size_t off = (size_t)row * 2048 + col0; float ss = 0.f;
#pragma unroll
                for (int bj = 0; bj < 2; ++bj)
#pragma unroll
                    for (int n = 0; n < 2; ++n) { const f32x4 bs = *(const f32x4*)(base + off + bj * HALF + n * 16); const f32x4 x = bs + acc[ai][bj][m][n]; *(f32x4*)(out + off + bj * HALF + n * 16) = x;
                        if (gn) { ss += (x[0] * x[0] + x[1] * x[1]) + (x[2] * x[2] + x[3] * x[3]); const f32x4 y = x * gv[bj][n];
                            unsigned lo = cvt_pk_bf16(y[0], y[1]), hi = cvt_pk_bf16(y[2], y[3]); *(unsigned long long*)(xb + off + bj * HALF + n * 16) = ((unsigned long long)hi << 32) | lo;
                            if (x8) { int w = 0; w = __builtin_amdgcn_cvt_pk_fp8_f32(y[0], y[1], w, false); w = __builtin_amdgcn_cvt_pk_fp8_f32(y[2], y[3], w, true); *(int*)(x8 + off + bj * HALF + n * 16) = w; } } }
                if (gn) { ss += __shfl_xor(ss, 16); ss += __shfl_xor(ss, 32); if (fq == 0) atomicAdd(rss + row, ss); } }
    }
};
template <class Epi, class Sched, bool ALIGN_EPI = false, bool SP2 = false, bool F8 = false>
__device__ __forceinline__ void gemm_phase(PG8_LAS unsigned char* lds, const int Kel, const Sched& S, const Epi& E, const int wave_) {
    const int tid = wave_ * 64 + ::lane_id(); const int wid = __builtin_amdgcn_readfirstlane(tid >> 6), lane = tid & 63, wr = wid >> 2, wc = wid & 3, fr = lane & 15, fq = lane >> 4;
    const int K = F8 ? Kel / 2 : Kel, nt = K / BK;
    unsigned voffA[2], voffB[2]; size_t hstepB;
#pragma unroll
    for (int i = 0; i < 2; ++i) { int R, C; stage_rc(tid * 16 + i * 8192, R, C); voffA[i] = (unsigned)(R * K + C) * 2u; }
#define PG8_SETB(dil) do { const int d_ = (dil); _Pragma("unroll") for (int i = 0; i < 2; ++i) { int R, C; stage_rc(tid * 16 + i * 8192, R, C); const int Rb = Epi::PERM ? ((R & ~31) + perm32(R & 31)) : R; \
        voffB[i] = (unsigned)(Rb * d_ * K + C) * 2u; } hstepB = (d_ == 16) ? (size_t)K * 2 : (size_t)HALF * d_ * K * 2; } while (0)
    const size_t kstep = (size_t)(BK * 2);
    const size_t hstep = (size_t)HALF * K * 2;
    const size_t tstep = 2 * hstep;
    const unsigned ldsw = (unsigned)wid * 1024u;
    const int aoff = lds_byte(wr * 64 + fr, fq * 8), boff = lds_byte(wc * 32 + fr, fq * 8);
#define PG8_SA(b, h) (((b) * 2 + (h)) * HTB)
#define PG8_SB(b, h) ((4 + (b) * 2 + (h)) * HTB)
#define PG8_STAGE(bufoff, gbase, voff) do { _Pragma("unroll") for (int _i = 0; _i < 2; ++_i) \
        __builtin_amdgcn_global_load_lds((const unsigned*)((const char*)(gbase) + (voff)[_i]), (PG8_LAS unsigned*)(lds + (bufoff) + ldsw + _i * 8192), 16, 0, 0); } while (0)
#define PG8_LDA(dst, b, h) do { _Pragma("unroll") for (int m = 0; m < 4; ++m) _Pragma("unroll") for (int k = 0; k < 2; ++k) dst[m][k] = *(const PG8_LAS bf16x8*)(lds + PG8_SA(b, h) + aoff + m * 2048 + k * 1024); } while (0)
#define PG8_LDB(dst, b, h) do { _Pragma("unroll") for (int n = 0; n < 2; ++n) _Pragma("unroll") for (int k = 0; k < 2; ++k) dst[n][k] = *(const PG8_LAS bf16x8*)(lds + PG8_SB(b, h) + boff + n * 2048 + k * 1024); } while (0)
#define PG8_CAT8(x) __builtin_shufflevector(__builtin_bit_cast(i32x4, (x)[0]), __builtin_bit_cast(i32x4, (x)[1]), 0, 1, 2, 3, 4, 5, 6, 7)
#define PG8_MMA(ai, bj, At, Bt) do { __builtin_amdgcn_s_setprio(1); \
        if constexpr (F8) { _Pragma("unroll") for (int m = 0; m < 4; ++m) _Pragma("unroll") for (int n = 0; n < 2; ++n) \
            asm volatile("v_mfma_f32_16x16x128_f8f6f4 %0, %1, %2, %0" : "+v"(acc[ai][bj][m][n]) : "v"(PG8_CAT8(Bt[n])), "v"(PG8_CAT8(At[m]))); } \
        else { _Pragma("unroll") for (int m = 0; m < 4; ++m) _Pragma("unroll") for (int n = 0; n < 2; ++n) _Pragma("unroll") for (int k = 0; k < 2; ++k) \
            acc[ai][bj][m][n] = __builtin_amdgcn_mfma_f32_16x16x32_bf16(Bt[n][k], At[m][k], acc[ai][bj][m][n], 0, 0, 0); } \
        __builtin_amdgcn_s_setprio(0); } while (0)
#define PG8_WAIT_V(n) asm volatile("s_waitcnt vmcnt(" #n ")" ::: "memory")
#define PG8_WAIT_L(n) asm volatile("s_waitcnt lgkmcnt(" #n ")" ::: "memory")
#define PG8_BAR __builtin_amdgcn_s_barrier()
#define PG8_SCHED __builtin_amdgcn_sched_barrier(0)
    Unit cur, nxt; int ui = 0;
    if (!S.next(0, cur)) return;
    f32x4 acc[2][2][4][2];
#pragma unroll
    for (int a = 0; a < 2; ++a)
#pragma unroll
        for (int b = 0; b < 2; ++b)
#pragma unroll
            for (int m = 0; m < 4; ++m)
#pragma unroll
                for (int n = 0; n < 2; ++n) acc[a][b][m][n] = (f32x4){0.f, 0.f, 0.f, 0.f};
    bf16x8 At[4][2], B0[2][2], B1[2][2];
    const char* cA = S.a_base(cur); const char* cB = S.b_base(cur); PG8_SETB(S.bdil(cur));
    S.a_ready(cur);
    if constexpr (SP2) {
        PG8_STAGE(PG8_SB(0, 0), cB, voffB); PG8_STAGE(PG8_SB(0, 1), cB + hstepB, voffB); PG8_STAGE(PG8_SA(0, 0), cA, voffA); PG8_STAGE(PG8_SA(0, 1), cA + hstep, voffA);
        if (wr == 1) PG8_BAR;
        PG8_WAIT_V(2); PG8_BAR;
        PG8_STAGE(PG8_SB(1, 0), cB + kstep, voffB); PG8_STAGE(PG8_SA(1, 0), cA + kstep, voffA); PG8_STAGE(PG8_SB(1, 1), cB + hstepB + kstep, voffB);
        PG8_WAIT_V(6); PG8_BAR;
    } else {
        PG8_STAGE(PG8_SB(0, 0), cB, voffB); PG8_STAGE(PG8_SA(0, 0), cA, voffA); PG8_STAGE(PG8_SB(0, 1), cB + hstepB, voffB); PG8_STAGE(PG8_SA(0, 1), cA + hstep, voffA);
        if (wr == 1) PG8_BAR;
        PG8_WAIT_V(4); PG8_BAR;
        PG8_STAGE(PG8_SB(1, 0), cB + kstep, voffB); PG8_STAGE(PG8_SA(1, 0), cA + kstep, voffA); PG8_STAGE(PG8_SB(1, 1), cB + hstepB + kstep, voffB);
        PG8_WAIT_V(6); PG8_BAR;
    }
    for (;;) {
        const bool has_next = S.next(ui + 1, nxt);
        const char* nA = has_next ? S.a_base(nxt) : cA; const char* nB = has_next ? S.b_base(nxt) : cB;
        for (int t = 0; t < nt; t += 2) {
            const bool last = (t == nt - 2);
            const char* a1 = cA + (size_t)(t + 1) * kstep;
            const char* a2 = last ? nA : cA + (size_t)(t + 2) * kstep; const char* b2 = last ? nB : cB + (size_t)(t + 2) * kstep;
            const char* a3 = a2 + kstep; const char* b3 = b2 + kstep;
            if (last && has_next) { S.a_ready(nxt); PG8_SETB(S.bdil(nxt)); }
            if constexpr (SP2) {
            PG8_LDB(B0, 0, 0); PG8_LDB(B1, 0, 1); PG8_SCHED; PG8_LDA(At, 0, 0); PG8_STAGE(PG8_SA(1, 1), a1 + hstep, voffA);
            PG8_WAIT_V(8); PG8_WAIT_L(0); PG8_BAR; PG8_MMA(0, 0, At, B0); PG8_MMA(0, 1, At, B1); PG8_BAR; PG8_SCHED;
            PG8_LDA(At, 0, 1); PG8_STAGE(PG8_SB(0, 0), b2, voffB); PG8_STAGE(PG8_SB(0, 1), b2 + hstepB, voffB); PG8_STAGE(PG8_SA(0, 0), a2, voffA);
            PG8_WAIT_V(8); PG8_WAIT_L(0); PG8_BAR; PG8_MMA(1, 0, At, B0); PG8_MMA(1, 1, At, B1); PG8_BAR; PG8_SCHED;
            PG8_LDB(B0, 1, 0); PG8_LDB(B1, 1, 1); PG8_SCHED; PG8_LDA(At, 1, 0); PG8_STAGE(PG8_SA(0, 1), a2 + hstep, voffA);
            PG8_WAIT_V(8); PG8_WAIT_L(0); PG8_BAR; PG8_MMA(0, 0, At, B0); PG8_MMA(0, 1, At, B1); PG8_BAR; PG8_SCHED;
            PG8_LDA(At, 1, 1); PG8_STAGE(PG8_SB(1, 0), b3, voffB); PG8_STAGE(PG8_SB(1, 1), b3 + hstepB, voffB); PG8_STAGE(PG8_SA(1, 0), a3, voffA);
            PG8_WAIT_V(8); PG8_WAIT_L(0); PG8_BAR; PG8_MMA(1, 0, At, B0); PG8_MMA(1, 1, At, B1); PG8_BAR; PG8_SCHED;
            } else {
            PG8_LDB(B0, 0, 0); PG8_SCHED; PG8_LDA(At, 0, 0); PG8_STAGE(PG8_SA(1, 1), a1 + hstep, voffA);
            PG8_WAIT_L(8); PG8_BAR; PG8_WAIT_L(0); PG8_MMA(0, 0, At, B0); PG8_BAR; PG8_SCHED;
            PG8_LDB(B1, 0, 1); PG8_STAGE(PG8_SB(0, 0), b2, voffB);
            PG8_BAR; PG8_WAIT_L(0); PG8_MMA(0, 1, At, B1); PG8_BAR;
            PG8_LDA(At, 0, 1); PG8_STAGE(PG8_SA(0, 0), a2, voffA);
            PG8_BAR; PG8_WAIT_L(0); PG8_MMA(1, 0, At, B0); PG8_BAR; PG8_SCHED;
            PG8_STAGE(PG8_SB(0, 1), b2 + hstepB, voffB);
            PG8_WAIT_V(6); PG8_BAR; PG8_MMA(1, 1, At, B1); PG8_BAR;
            PG8_LDB(B0, 1, 0); PG8_SCHED; PG8_LDA(At, 1, 0); PG8_STAGE(PG8_SA(0, 1), a2 + hstep, voffA);
            PG8_WAIT_L(8); PG8_BAR; PG8_WAIT_L(0); PG8_MMA(0, 0, At, B0); PG8_BAR; PG8_SCHED;
            PG8_LDB(B1, 1, 1); PG8_STAGE(PG8_SB(1, 0), b3, voffB);
            PG8_BAR; PG8_WAIT_L(0); PG8_MMA(0, 1, At, B1); PG8_BAR;
            PG8_LDA(At, 1, 1); PG8_STAGE(PG8_SA(1, 0), a3, voffA);
            PG8_BAR; PG8_WAIT_L(0); PG8_MMA(1, 0, At, B0); PG8_BAR; PG8_SCHED;
            PG8_STAGE(PG8_SB(1, 1), b3 + hstepB, voffB);
            PG8_WAIT_V(6); PG8_BAR; PG8_MMA(1, 1, At, B1); PG8_BAR;
            }
        }
        if constexpr (F8) asm volatile("s_nop 15\n\ts_nop 15" ::: "memory");
        if constexpr (ALIGN_EPI) { if (wr == 0) PG8_BAR; }
        if constexpr (!Epi::AFTER_DRAIN) { E(acc, cur, wr, wc, fr, fq); S.done(cur); }
        if (!has_next) break;
#pragma unroll
        for (int a = 0; a < 2; ++a)
#pragma unroll
            for (int b = 0; b < 2; ++b)
#pragma unroll
                for (int m = 0; m < 4; ++m)
#pragma unroll
                    for (int n = 0; n < 2; ++n) acc[a][b][m][n] = (f32x4){0.f, 0.f, 0.f, 0.f};
        cur = nxt; cA = nA; cB = nB; ++ui;
        if constexpr (ALIGN_EPI) { if (wr == 1) PG8_BAR; }
    }
    PG8_WAIT_V(0);
    if constexpr (!ALIGN_EPI) { if (wr == 0) PG8_BAR; }
    PG8_BAR;
    if constexpr (Epi::AFTER_DRAIN) { E.fused(acc, cur, wr, wc, fr, fq, lds, wid, lane); S.done(cur); }
#undef PG8_SA
#undef PG8_SB
#undef PG8_STAGE
#undef PG8_LDA
#undef PG8_LDB
#undef PG8_MMA
#undef PG8_SETB
#undef PG8_CAT8
#undef PG8_WAIT_V
#undef PG8_WAIT_L
#undef PG8_BAR
#undef PG8_SCHED
}
}

constexpr int NWAVES = 8, NTHR = NWAVES * 64;
constexpr int BATCH = 4, SEQ = 2048, DM = 2048, MTOK = BATCH * SEQ;
constexpr int A_IN = 20480, B_IN = 6144, NA1 = 14336;
constexpr float RMS_EPS = 1e-6f, LN_EPS = 1e-5f;
constexpr size_t MiB = 1u << 20;
constexpr size_t SZ_ACT = (size_t)MTOK * DM * 2;
constexpr size_t WS_WAIN = 2 * MiB;
constexpr size_t WS_WAOUT = WS_WAIN + 2 * (size_t)A_IN * DM * 2;
constexpr size_t WS_WBIN = WS_WAOUT + 2 * (size_t)DM * DM * 2;
constexpr size_t WS_WBOUT = WS_WBIN + 2 * (size_t)B_IN * DM * 2;
constexpr size_t WS_WM = WS_WBOUT + 2 * (size_t)DM * DM * 2;
constexpr size_t WS_COS = WS_WM + 2 * 16 * 128 * 128 * 2;
constexpr size_t WS_SIN = WS_COS + (size_t)MTOK * 16 * 4;
constexpr size_t WS_STATS = WS_SIN + (size_t)MTOK * 16 * 4;
constexpr size_t WS_LSE = WS_STATS + 2 * (size_t)MTOK * 2 * 4;
constexpr size_t WS_X = WS_LSE + 3 * (size_t)MTOK * 16 * 4;
constexpr size_t WS_XN = WS_X + 2 * SZ_ACT;
constexpr size_t WS_QK = WS_XN + SZ_ACT;
constexpr size_t WS_VT = WS_QK + 6 * SZ_ACT;
constexpr size_t WS_GATE = WS_VT + 3 * SZ_ACT;
constexpr size_t WS_OG = WS_GATE + SZ_ACT;
constexpr size_t WS_Y = WS_OG + 3 * SZ_ACT;
constexpr size_t WS_XN8 = WS_Y + SZ_ACT;
constexpr size_t WS_RSS = WS_XN8 + SZ_ACT / 2;
constexpr size_t WS_END = WS_RSS + 4 * (size_t)MTOK * 4;
constexpr size_t WS_BAR = 65536;
constexpr int LDS_BYTES = 147456;

typedef unsigned short bf16;
typedef unsigned v4u __attribute__((ext_vector_type(4)));
typedef unsigned v2u __attribute__((ext_vector_type(2)));
typedef float f32x4 __attribute__((ext_vector_type(4)));
typedef float f32x2v __attribute__((ext_vector_type(2)));
typedef float f32x16 __attribute__((ext_vector_type(16)));
typedef short bf16x8 __attribute__((ext_vector_type(8)));
typedef __bf16 bf16x2_t __attribute__((ext_vector_type(2)));
#define LAS __attribute__((address_space(3)))
#define MFMA32(a, b, c) __builtin_amdgcn_mfma_f32_32x32x16_bf16((a), (b), (c), 0, 0, 0)
__device__ __forceinline__ unsigned pk2(float lo, float hi) { f32x2v v = {lo, hi}; bf16x2_t b = __builtin_convertvector(v, bf16x2_t); return __builtin_bit_cast(unsigned, b); }
__device__ __forceinline__ float bflo(unsigned w) { return __builtin_bit_cast(float, w << 16); }
__device__ __forceinline__ float bfhi(unsigned w) { return __builtin_bit_cast(float, w & 0xffff0000u); }
__device__ __forceinline__ float wave_sum(float v) {
#pragma unroll
    for (int o = 1; o < 64; o <<= 1) v += __shfl_xor(v, o);
    return v;
}

#define XB_TMO      128
#define XB_XCNT(j)  (256  + 64 * (j))
#define XB_XSUB(j)  (1280 + 64 * (j))
#define XB_XGEN(j)  (2304 + 64 * (j))
#define XB_TOP      3328
#define XB_TOPGEN   3392
#define XCD_BAR_WORDS 3456
#define XB_SPIN_CAP (1u << 18)

__device__ __forceinline__ unsigned xb_ld(unsigned* p)              { return __hip_atomic_load(p, __ATOMIC_RELAXED, __HIP_MEMORY_SCOPE_AGENT); }
__device__ __forceinline__ unsigned xb_add(unsigned* p, unsigned v) { return __hip_atomic_fetch_add(p, v, __ATOMIC_RELAXED, __HIP_MEMORY_SCOPE_AGENT); }
__device__ __forceinline__ unsigned xb_xcc_id() { return (unsigned)__builtin_amdgcn_s_getreg((3 << 11) | 20) & 0xFu; }
#define XB_SPIN(cond, bar) do { unsigned _sp = 0; while (cond) { __builtin_amdgcn_s_sleep(1); \
    if ((++_sp & 255u) == 0u) { if (xb_ld(&(bar)[XB_TMO])) break; if (_sp > XB_SPIN_CAP) { atomicAdd(&(bar)[XB_TMO], 1u); break; } } } } while (0)

struct XcdBarrier {
    int w;
    unsigned* bar; unsigned x;
    volatile LAS unsigned* st;
};

__device__ __forceinline__ XcdBarrier xcd_barrier_post(unsigned* bar, volatile LAS unsigned* st, int w) {
    XcdBarrier b; b.w = w; b.bar = bar; b.x = xb_xcc_id(); b.st = st;
    if (w == 0 && lane_id() == 0) (void)xb_add(&bar[XB_XCNT(b.x)], 1u);
    return b;
}
__device__ __forceinline__ void xcd_barrier_complete(unsigned* bar, unsigned x, unsigned& nloc, unsigned& nx) {
    const unsigned G = gridDim.x * gridDim.y * gridDim.z;
    unsigned sum, cnt, mine, sp = 0u;
    for (;;) {
        sum = 0u; cnt = 0u; mine = 0u;
#pragma unroll
        for (unsigned j = 0; j < 16; ++j) { const unsigned c = xb_ld(&bar[XB_XCNT(j)]); sum += c; cnt += (c > 0u) ? 1u : 0u; mine = (j == x) ? c : mine; }
        if (sum == G) break;
        __builtin_amdgcn_s_sleep(1);
        if ((++sp & 255u) == 0u) { if (xb_ld(&bar[XB_TMO])) break; if (sp > XB_SPIN_CAP) { atomicAdd(&bar[XB_TMO], 1u); break; } }
    }
    nloc = mine > 0u ? mine : 1u; nx = cnt > 0u ? cnt : 1u;
}

__device__ __forceinline__ void xcd_barrier(const XcdBarrier& b) {
    asm volatile("s_waitcnt vmcnt(0)" ::: "memory");
    __syncthreads();
    if (b.w == 0 && lane_id() == 0) {
        unsigned* bar = b.bar;
        __builtin_amdgcn_s_waitcnt(0);
        unsigned nloc = b.st[0], nx = b.st[1];
        if (nloc == 0u) { xcd_barrier_complete(bar, b.x, nloc, nx); b.st[0] = nloc; b.st[1] = nx; }
        const unsigned old = xb_add(&bar[XB_XSUB(b.x)], 1u);
        const unsigned gen = old / nloc;
        if (old + 1u == (gen + 1u) * nloc) {
            __builtin_amdgcn_fence(__ATOMIC_RELEASE, "agent");
            asm volatile("s_waitcnt vmcnt(0)" ::: "memory");
            const unsigned og = xb_add(&bar[XB_TOP], 1u);
            const unsigned tg = og / nx;
            if (og + 1u == (tg + 1u) * nx) xb_add(&bar[XB_TOPGEN], 1u);
            else XB_SPIN(xb_ld(&bar[XB_TOPGEN]) == tg, bar);
            __builtin_amdgcn_fence(__ATOMIC_ACQUIRE, "agent");
            xb_add(&bar[XB_XGEN(b.x)], 1u);
            asm volatile("s_waitcnt vmcnt(0)" ::: "memory");
        } else {
            XB_SPIN(xb_ld(&bar[XB_XGEN(b.x)]) == gen, bar);
            __builtin_amdgcn_fence(__ATOMIC_ACQUIRE, "agent");
            asm volatile("s_waitcnt vmcnt(0)" ::: "memory");
        }
    }
    __syncthreads();
}

__device__ __forceinline__ int launder_s(int v) { asm volatile("" : "+s"(v)); return v; }
__device__ __forceinline__ int launder(int v) { asm volatile("" : "+v"(v)); return v; }
struct Args {
    const float* x; const int* pos; const float* a_norm_g; const float* a_w_in; const float* a_w_out; const float* b_norm_g; const float* b_w_in;
    const float* b_ln_g; const float* b_ln_b; const float* b_w_s; const float* b_b_s; const float* b_w_out; const float* final_g;
    float* out; unsigned char* ws; double invf[16];
    int ph_lo, ph_hi;
};

__device__ __forceinline__ void p0_transpose_item(const float* W, int K, int N, bf16* WT, int row_off, LAS float* scr, int kb, int nb, int lane) {
    const int k0 = 64 * kb, n0 = 32 * nb;
    float wv[32];
#pragma unroll
    for (int i = 0; i < 32; ++i) wv[i] = W[(size_t)(k0 + 2 * i + (lane >> 5)) * N + n0 + (lane & 31)];
#pragma unroll
    for (int i = 0; i < 32; ++i) scr[(2 * i + (lane >> 5)) * 33 + (lane & 31)] = wv[i];
    asm volatile("s_waitcnt lgkmcnt(0)" ::: "memory");
    const int c = lane & 7;
#pragma unroll
    for (int j = 0; j < 4; ++j) { const int n = (lane >> 3) + 8 * j; const LAS float* s = scr + (8 * c) * 33 + n;
        v4u o; o.x = pk2(s[0 * 33], s[1 * 33]); o.y = pk2(s[2 * 33], s[3 * 33]); o.z = pk2(s[4 * 33], s[5 * 33]); o.w = pk2(s[6 * 33], s[7 * 33]);
        *(v4u*)(WT + (size_t)(row_off + n0 + n) * K + k0 + 8 * c) = o; }
    asm volatile("s_waitcnt lgkmcnt(0)" ::: "memory");
}
constexpr float W8_SCALE = 32.0f;
__device__ __forceinline__ unsigned pk4_fp8(float a, float b, float c, float d) {
    a = fminf(fmaxf(a, -448.f), 448.f); b = fminf(fmaxf(b, -448.f), 448.f); c = fminf(fmaxf(c, -448.f), 448.f); d = fminf(fmaxf(d, -448.f), 448.f);
    int w = 0; w = __builtin_amdgcn_cvt_pk_fp8_f32(a, b, w, false); w = __builtin_amdgcn_cvt_pk_fp8_f32(c, d, w, true); return (unsigned)w; }
__device__ __forceinline__ void p0_transpose_item_f8(const float* W, int K, int N, unsigned char* WT, int row_off, LAS float* scr, int kb, int nb, int lane) {
    const int k0 = 64 * kb, n0 = 32 * nb;
    float wv[32];
#pragma unroll
    for (int i = 0; i < 32; ++i) wv[i] = W[(size_t)(k0 + 2 * i + (lane >> 5)) * N + n0 + (lane & 31)];
#pragma unroll
    for (int i = 0; i < 32; ++i) scr[(2 * i + (lane >> 5)) * 33 + (lane & 31)] = wv[i] * W8_SCALE;
    asm volatile("s_waitcnt lgkmcnt(0)" ::: "memory");
    const int c = lane & 7;
#pragma unroll
    for (int j = 0; j < 4; ++j) { const int n = (lane >> 3) + 8 * j; const LAS float* s = scr + (8 * c) * 33 + n;
        v2u o; o.x = pk4_fp8(s[0 * 33], s[1 * 33], s[2 * 33], s[3 * 33]); o.y = pk4_fp8(s[4 * 33], s[5 * 33], s[6 * 33], s[7 * 33]);
        *(v2u*)(WT + (size_t)(row_off + n0 + n) * K + k0 + 8 * c) = o; }
    asm volatile("s_waitcnt lgkmcnt(0)" ::: "memory");
}
template <bool OB16, bool OF32, bool OF8> __device__ __forceinline__ void rms_row(const float* xrow, const float* g, bf16* o16, float* o32, unsigned char* o8, int lane) {
    const f32x4* xr = (const f32x4*)xrow + lane; const f32x4* gr = (const f32x4*)g + lane;
    f32x4 v[8]; float s = 0.f;
#pragma unroll
    for (int j = 0; j < 8; ++j) { v[j] = xr[64 * j]; s += (v[j].x * v[j].x + v[j].y * v[j].y) + (v[j].z * v[j].z + v[j].w * v[j].w); }
    const float rstd = 1.0f / sqrtf(wave_sum(s) * (1.0f / DM) + RMS_EPS);
#pragma unroll
    for (int j = 0; j < 8; ++j) { const f32x4 gg = gr[64 * j]; const f32x4 y = v[j] * rstd * gg;
        if (OF32) ((f32x4*)o32 + lane)[64 * j] = y;
        if (OF8) ((unsigned*)o8 + lane)[64 * j] = pk4_fp8(y.x, y.y, y.z, y.w);
        if (OB16) { v2u w; w.x = pk2(y.x, y.y); w.y = pk2(y.z, y.w); ((v2u*)o16 + lane)[64 * j] = w; } }
}

constexpr float C2S = 0.08838834764831845f * 1.4426950408889634f;
constexpr int ATT_KP = 144, ATT_VP = 80;
constexpr int ATT_KB = 32 * ATT_KP, ATT_VB = 128 * ATT_VP, ATT_BUF = ATT_KB + ATT_VB;
__device__ __forceinline__ bf16x8 f8x8_to_bf16x8(v2u w) {
    const f32x2v a = __builtin_amdgcn_cvt_pk_f32_fp8((int)w.x, false), b = __builtin_amdgcn_cvt_pk_f32_fp8((int)w.x, true), c = __builtin_amdgcn_cvt_pk_f32_fp8((int)w.y, false), d = __builtin_amdgcn_cvt_pk_f32_fp8((int)w.y, true);
    v4u o; o.x = pk2(a.x, a.y); o.y = pk2(b.x, b.y); o.z = pk2(c.x, c.y); o.w = pk2(d.x, d.y); return __builtin_bit_cast(bf16x8, o); }
struct AttPair { unsigned uq, uk, uv, orow; int j0, g; };
__device__ __forceinline__ AttPair att_decode(int pi, int grp, int qw) {
    AttPair d; const int uid = 2 * pi + grp, g = 2 - (uid >> 10), rest = uid & 1023, blk = rest & 15, h = (rest >> 4) & 15, b = rest >> 8;
    const int dsh = 2 * g; const bool has_prev = (blk & ((16 >> dsh) - 1)) != 0;
    d.j0 = __builtin_amdgcn_readfirstlane(has_prev ? 0 : 4); d.g = __builtin_amdgcn_readfirstlane(g);
    d.uq = __builtin_amdgcn_readfirstlane((unsigned)((((g * 2 + 0) * 4 + b) * 16 + h) * 2048 + blk * 128 + qw * 32) * 128u);
    d.uk = __builtin_amdgcn_readfirstlane((unsigned)((((g * 2 + 1) * 4 + b) * 16 + h) * 2048 + blk * 128 - 128) * 128u);
    d.uv = __builtin_amdgcn_readfirstlane((unsigned)(g * 2048 * 8192 + (b * 64 + blk * 4 - 4) * 65536 + h * 128 * 32) * 2u);
    d.orow = __builtin_amdgcn_readfirstlane((unsigned)(((g * 4 + b) * 16 + h) * 2048 + blk * 128 + qw * 32));
    return d;
}
__device__ __forceinline__ void attn_phase(const bf16* QK, const bf16* VT, bf16* OG, float* LSE, int bx, int G, int wave, int lane, LAS unsigned char* lds) {
    const int q = lane & 31, hh = lane >> 5, grp = wave >> 2, qw = wave & 3;
    const int kperm = (q & 0x13) | ((q & 4) << 1) | ((q & 8) >> 1);
    const char* QKc = (const char*)QK; const char* VTc = (const char*)VT;
    LAS unsigned char* gl = lds + grp * (2 * ATT_BUF);
    const int L2 = (qw * 64 + lane) * 2, L1 = qw * 64 + lane;
    const unsigned kw0 = (unsigned)((L1 >> 3) * ATT_KP + (L1 & 7) * 16);
    const unsigned vw0 = (unsigned)(ATT_KB + (L2 >> 2) * ATT_VP + (L2 & 3) * 16), vw1 = (unsigned)(ATT_KB + ((L2 + 1) >> 2) * ATT_VP + ((L2 + 1) & 3) * 16);
    const unsigned kr = (unsigned)(kperm * ATT_KP + 8 * hh), vr = (unsigned)(ATT_KB + q * ATT_VP + 16 * hh);
    const unsigned lqo = (unsigned)(q * 128 + 8 * hh);
    int pi = bx; if (pi >= 1536) return;
    v4u st[4][3]; long qf[8], qn[8];
#define ATT_FETCH(P, J, D) do { const char* kp_ = QKc + ((P).uk + (unsigned)(J) * 4096u + (unsigned)L1 * 16u); const char* vp_ = VTc + ((P).uv + (unsigned)(J) * 131072u + (unsigned)L2 * 16u); \
            D[0] = *(const v4u*)kp_; D[1] = *(const v4u*)vp_; D[2] = *(const v4u*)(vp_ + 16); } while (0)
#define ATT_PARK(J, D) do { LAS unsigned char* wb_ = gl + ((J) & 1) * ATT_BUF; *(LAS v4u*)(wb_ + kw0) = D[0]; *(LAS v4u*)(wb_ + vw0) = D[1]; *(LAS v4u*)(wb_ + vw1) = D[2]; } while (0)
#define ATT_LDQ(P, D) do { const char* qp_ = QKc + ((P).uq + lqo); _Pragma("unroll") for (int c = 0; c < 8; ++c) D[c] = *(const long*)(qp_ + 16 * c); } while (0)
    AttPair cur = att_decode(pi, grp, qw);
    ATT_LDQ(cur, qf);
    ATT_FETCH(cur, cur.j0, st[0]); ATT_FETCH(cur, cur.j0 + 1, st[1]); ATT_FETCH(cur, cur.j0 + 2, st[2]); ATT_FETCH(cur, cur.j0 + 3, st[3]);
    ATT_PARK(0, st[0]);
    asm volatile("s_waitcnt lgkmcnt(0)\n\ts_barrier" ::: "memory");
    for (;;) {
        const bool has_next = pi + G < 1536;
        AttPair nxt = cur; if (has_next) nxt = att_decode(pi + G, grp, qw);
        const int j0 = cur.j0;
        f32x16 O[4];
#pragma unroll
        for (int db = 0; db < 4; ++db)
#pragma unroll
            for (int i = 0; i < 16; ++i) O[db][i] = 0.f;
        float m = -INFINITY, l = 0.f;
#pragma unroll
        for (int j = 0; j < 8; ++j) {
            if (j < 4 && cur.g == 2) continue;
            if (j < 4) { if (j0 == 0) ATT_FETCH(cur, j + 4, st[j & 3]); }
            else if (has_next) { ATT_FETCH(nxt, nxt.j0 + (j - 4), st[j & 3]); if (j == 4) ATT_LDQ(nxt, qn); }
            const int t = j - qw;
            if (j >= j0 && t >= 0 && t <= 4) {
                const LAS unsigned char* rb = gl + (j & 1) * ATT_BUF;
                f32x16 S;
#pragma unroll
                for (int i = 0; i < 16; ++i) S[i] = 0.f;
                long kf[8]; bf16x8 vf[4][2];
#pragma unroll
                for (int c = 0; c < 8; ++c) kf[c] = *(const LAS long*)(rb + kr + 16 * c);
#pragma unroll
                for (int db = 0; db < 4; ++db) { vf[db][0] = *(const LAS bf16x8*)(rb + vr + db * 32 * ATT_VP); vf[db][1] = *(const LAS bf16x8*)(rb + vr + db * 32 * ATT_VP + 32); }
                __builtin_amdgcn_sched_barrier(0);
#pragma unroll
                for (int c = 0; c < 8; ++c) S = __builtin_amdgcn_mfma_f32_32x32x16_fp8_fp8(kf[c], qf[c], S, 0, 0, 0);
                if (t == 0) {
#pragma unroll
                    for (int i = 0; i < 16; ++i) { const int kt = 16 * (i >> 3) + 8 * hh + (i & 7); if (kt < q) S[i] = -INFINITY; }
                }
                if (t == 4) {
#pragma unroll
                    for (int i = 0; i < 16; ++i) { const int kt = 16 * (i >> 3) + 8 * hh + (i & 7); if (kt > q) S[i] = -INFINITY; }
                }
                float mx = S[0];
#pragma unroll
                for (int i = 1; i < 16; ++i) mx = fmaxf(mx, S[i]);
                mx = fmaxf(mx, __shfl_xor(mx, 32)) * C2S;
                if (__builtin_amdgcn_ballot_w64(mx > m + 8.0f) != 0ull) { const float mn = fmaxf(m, mx), alpha = __builtin_amdgcn_exp2f(m - mn); l *= alpha; m = mn;
#pragma unroll
                    for (int db = 0; db < 4; ++db)
#pragma unroll
                        for (int i = 0; i < 16; ++i) O[db][i] *= alpha; }
                float rs = 0.f;
#pragma unroll
                for (int i = 0; i < 16; ++i) { S[i] = __builtin_amdgcn_exp2f(__builtin_fmaf(S[i], C2S, -m)); rs += S[i]; }
                l += rs;
                v4u w0, w1;
                w0.x = pk2(S[0], S[1]); w0.y = pk2(S[2], S[3]); w0.z = pk2(S[4], S[5]); w0.w = pk2(S[6], S[7]);
                w1.x = pk2(S[8], S[9]); w1.y = pk2(S[10], S[11]); w1.z = pk2(S[12], S[13]); w1.w = pk2(S[14], S[15]);
                const bf16x8 ps0 = __builtin_bit_cast(bf16x8, w0), ps1 = __builtin_bit_cast(bf16x8, w1);
#pragma unroll
                for (int db = 0; db < 4; ++db) { O[db] = MFMA32(vf[db][0], ps0, O[db]); O[db] = MFMA32(vf[db][1], ps1, O[db]); }
            }
            if (j < 7) { if (j + 1 >= j0 + 1) ATT_PARK(j + 1, st[(j + 1) & 3]); }
            else if (has_next) ATT_PARK(0, st[0]);
            asm volatile("s_waitcnt lgkmcnt(0)\n\ts_barrier" ::: "memory");
        }
        l += __shfl_xor(l, 32);
        const float inv = 1.0f / l, lse2 = m + __builtin_amdgcn_logf(l);
        { LAS unsigned char* ob = lds + 61440 + wave * (32 * 272);
#pragma unroll
          for (int db = 0; db < 4; ++db)
#pragma unroll
              for (int i4 = 0; i4 < 4; ++i4) { v2u w; w.x = pk2(O[db][4 * i4] * inv, O[db][4 * i4 + 1] * inv); w.y = pk2(O[db][4 * i4 + 2] * inv, O[db][4 * i4 + 3] * inv);
                  *(LAS v2u*)(ob + q * 272 + (db * 32 + 8 * i4 + 4 * hh) * 2) = w; }
          asm volatile("s_waitcnt lgkmcnt(0)" ::: "memory");
          __attribute__((address_space(1))) unsigned char* og = (__attribute__((address_space(1))) unsigned char*)OG + (size_t)cur.orow * 256;
          const unsigned lo = (unsigned)((lane >> 4) * 256 + (lane & 15) * 16), li = (unsigned)((lane >> 4) * 272 + (lane & 15) * 16);
#pragma unroll
          for (int k = 0; k < 8; ++k) { const v4u x = *(const LAS v4u*)(ob + li + k * (4 * 272)); *(__attribute__((address_space(1))) v4u*)(og + (lo + (unsigned)k * 1024u)) = x; }
          asm volatile("s_waitcnt lgkmcnt(0)" ::: "memory"); }
        if (hh == 0) LSE[cur.orow + q] = lse2;
        if (!has_next) break;
        cur = nxt; pi += G;
#pragma unroll
        for (int c = 0; c < 8; ++c) qf[c] = qn[c];
    }
#undef ATT_FETCH
#undef ATT_PARK
#undef ATT_LDQ
}
__device__ __forceinline__ void merge_phase(const bf16* OG, const float* LSE, const bf16* GATE, bf16* Y, int gw, int NGW, int lane) {
    for (int row = gw; row < MTOK; row += NGW) { const int b = row >> 11, s = row & 2047;
#pragma unroll
        for (int j = 0; j < 4; ++j) { const int col = lane * 8 + 512 * j, h = col >> 7, e = col & 127;
            size_t r[3]; float lg[3];
#pragma unroll
            for (int g = 0; g < 3; ++g) { const int dsh = 2 * g, p = ((s & ((1 << dsh) - 1)) << (11 - dsh)) | (s >> dsh); r[g] = ((size_t)(g * 4 + b) * 16 + h) * 2048 + p; lg[g] = LSE[r[g]]; }
            const float mx = fmaxf(lg[0], fmaxf(lg[1], lg[2]));
            float w0 = __builtin_amdgcn_exp2f(lg[0] - mx), w1 = __builtin_amdgcn_exp2f(lg[1] - mx), w2 = __builtin_amdgcn_exp2f(lg[2] - mx);
            const float inv = 1.0f / (w0 + w1 + w2); w0 *= inv; w1 *= inv; w2 *= inv;
            const v4u a = *(const v4u*)(OG + r[0] * 128 + e), bb = *(const v4u*)(OG + r[1] * 128 + e), c = *(const v4u*)(OG + r[2] * 128 + e), gt = *(const v4u*)(GATE + (size_t)row * 2048 + col);
            v4u o;
#pragma unroll
            for (int k = 0; k < 4; ++k) {
                const float ylo = (w0 * bflo(a[k]) + w1 * bflo(bb[k]) + w2 * bflo(c[k])) * bflo(gt[k]);
                const float yhi = (w0 * bfhi(a[k]) + w1 * bfhi(bb[k]) + w2 * bfhi(c[k])) * bfhi(gt[k]);
                o[k] = pk2(ylo, yhi); }
            *(v4u*)(Y + (size_t)row * 2048 + col) = o; }
    }
}
__device__ __forceinline__ void sgu_phase(const bf16* VTB, const float* STATS, const float* LNG, const float* LNB, const bf16* WM, const float* BS, const bf16* U, const bf16* ZS, bf16* Y,
                                          int gw, int NGW, int lane, LAS unsigned char* wl) {
    const int r = lane & 31, hh = lane >> 5;
    for (int wu = gw; wu < 4096; wu += NGW) {
        const int cblk = wu & 3, g = (wu >> 2) & 15, chunk = (wu >> 6) & 15, b = wu >> 10;
        const int ch = g * 128 + cblk * 32 + r, tok0 = b * 2048 + chunk * 128;
        v4u raw[8];
#pragma unroll
        for (int ks = 0; ks < 8; ++ks) raw[ks] = *(const v4u*)(VTB + (size_t)((tok0 + 16 * ks) >> 5) * 65536 + (size_t)ch * 32 + ((16 * ks) & 31) + 8 * hh);
        v2u uu[4][4], zz[4][4]; float bs[4];
        const size_t rowoff0 = (size_t)(tok0 + r) * 2048 + g * 128 + cblk * 32 + 4 * hh;
#pragma unroll
        for (int tb = 0; tb < 4; ++tb) { bs[tb] = BS[g * 128 + tb * 32 + r];
#pragma unroll
            for (int i4 = 0; i4 < 4; ++i4) { uu[tb][i4] = *(const v2u*)(U + rowoff0 + (size_t)tb * 32 * 2048 + 8 * i4); zz[tb][i4] = *(const v2u*)(ZS + rowoff0 + (size_t)tb * 32 * 2048 + 8 * i4); } }
        const float lng = LNG[ch], lnb = LNB[ch];
        bf16x8 af[8];
#pragma unroll
        for (int ks = 0; ks < 8; ++ks) { v4u o; const f32x4* sp = (const f32x4*)(STATS + 2 * (size_t)(tok0 + 16 * ks + 8 * hh));
#pragma unroll
            for (int k = 0; k < 4; ++k) { const f32x4 sv = sp[k];
                const float mu0 = sv.x * (1.0f / 2048), mu1 = sv.z * (1.0f / 2048);
                const float a0 = lng * __builtin_amdgcn_rsqf(fmaxf(sv.y * (1.0f / 2048) - mu0 * mu0, 0.f) + LN_EPS), a1 = lng * __builtin_amdgcn_rsqf(fmaxf(sv.w * (1.0f / 2048) - mu1 * mu1, 0.f) + LN_EPS);
                o[k] = pk2(bflo(raw[ks][k]) * a0 + (lnb - mu0 * a0), bfhi(raw[ks][k]) * a1 + (lnb - mu1 * a1)); }
            af[ks] = __builtin_bit_cast(bf16x8, o); }
        bf16x8 wf[2][8];
        { const bf16* wp = WM + (size_t)(g * 128 + r) * 128 + 8 * hh; wf[0][0] = *(const bf16x8*)wp; wf[0][1] = *(const bf16x8*)(wp + 16); }
#pragma unroll
        for (int tb = 0; tb < 4; ++tb) {
            f32x16 D;
#pragma unroll
            for (int i = 0; i < 16; ++i) D[i] = 0.f;
#pragma unroll
            for (int ks = 0; ks < 2 * tb + 2; ++ks) D = MFMA32(af[ks], wf[tb & 1][ks], D);
            __builtin_amdgcn_sched_barrier(0);
            if (tb < 3) { const bf16* wp = WM + (size_t)(g * 128 + (tb + 1) * 32 + r) * 128 + 8 * hh;
#pragma unroll
                for (int ks = 0; ks < 2 * tb + 4; ++ks) wf[(tb + 1) & 1][ks] = *(const bf16x8*)(wp + 16 * ks); }
            __builtin_amdgcn_sched_barrier(0);
#pragma unroll
            for (int i4 = 0; i4 < 4; ++i4) { const v2u u4 = uu[tb][i4], z4 = zz[tb][i4];
                v2u w; w.x = pk2(bflo(u4.x) * (D[4 * i4] + bs[tb]) * bflo(z4.x), bfhi(u4.x) * (D[4 * i4 + 1] + bs[tb]) * bfhi(z4.x));
                w.y = pk2(bflo(u4.y) * (D[4 * i4 + 2] + bs[tb]) * bflo(z4.y), bfhi(u4.y) * (D[4 * i4 + 3] + bs[tb]) * bfhi(z4.y));
                *(LAS v2u*)(wl + r * 80 + (8 * i4 + 4 * hh) * 2) = w; }
            asm volatile("s_waitcnt lgkmcnt(0)" ::: "memory");
            { __attribute__((address_space(1))) unsigned char* yb = (__attribute__((address_space(1))) unsigned char*)Y + ((size_t)(tok0 + tb * 32) * 2048 + g * 128 + cblk * 32) * 2;
              const unsigned lo = (unsigned)((lane >> 2) * 4096 + (lane & 3) * 16), li = (unsigned)((lane >> 2) * 80 + (lane & 3) * 16);
#pragma unroll
              for (int k = 0; k < 2; ++k) { const v4u x = *(const LAS v4u*)(wl + li + k * (16 * 80)); *(__attribute__((address_space(1))) v4u*)(yb + (lo + (unsigned)k * 65536u)) = x; } }
            asm volatile("s_waitcnt lgkmcnt(0)" ::: "memory");
        }
    }
}

constexpr int N_PHASES = 19;
__global__ void __launch_bounds__(NTHR) trunk_fwd(Args args) {
    extern __shared__ __attribute__((aligned(16))) unsigned char lds[];
    const int wave = __builtin_amdgcn_readfirstlane(threadIdx.x >> 6);
#define tid (wave * 64 + lane_id())
#define lane lane_id()
    const int G = gridDim.x, bx = blockIdx.x;
    const int gw = bx * NWAVES + wave, NGW = G * NWAVES;
    unsigned char* ws = args.ws;
#define WS_PTRS unsigned char* wl_ = ws; asm volatile("" : "+s"(wl_)); bf16* WAin = (bf16*)(wl_ + WS_WAIN); bf16* WAout = (bf16*)(wl_ + WS_WAOUT); bf16* WBin = (bf16*)(wl_ + WS_WBIN); bf16* WBout = (bf16*)(wl_ + WS_WBOUT); bf16* WM = (bf16*)(wl_ + WS_WM); float* COS = (float*)(wl_ + WS_COS); float* SIN = (float*)(wl_ + WS_SIN); float* STATS = (float*)(wl_ + WS_STATS); float* LSE = (float*)(wl_ + WS_LSE); float* X = (float*)(wl_ + WS_X); bf16* XN = (bf16*)(wl_ + WS_XN); bf16* QK = (bf16*)(wl_ + WS_QK); bf16* VT = (bf16*)(wl_ + WS_VT); bf16* GATE = (bf16*)(wl_ + WS_GATE); bf16* OG = (bf16*)(wl_ + WS_OG); bf16* Y = (bf16*)(wl_ + WS_Y); bf16* U = OG; bf16* ZS = OG + (size_t)MTOK * 2048; unsigned char* XN8 = wl_ + WS_XN8; float* RSS = (float*)(wl_ + WS_RSS); (void)RSS; (void)WAin; (void)WAout; (void)WBin; (void)WBout; (void)WM; (void)COS; (void)SIN; (void)STATS; (void)LSE; (void)X; (void)XN; (void)QK; (void)VT; (void)GATE; (void)OG; (void)Y; (void)U; (void)ZS; (void)XN8;
    const int lo = args.ph_lo, hi = args.ph_hi; (void)lo; (void)hi;
#if MK_PER_PHASE
#define IN(k) (lo <= (k) && (k) < hi)
#else
#define IN(k) true
#endif
    volatile LAS unsigned* MISC = (volatile LAS unsigned*)((LAS unsigned char*)lds + 131072 + 320);
    if (tid < 32) MISC[tid] = 0u;
    unsigned* barw = (unsigned*)(ws + WS_BAR);
#if !MK_PER_PHASE
    if (bx == 0) for (int i = tid; i < XCD_BAR_WORDS; i += NTHR) __hip_atomic_store(barw + i, 0u, __ATOMIC_RELAXED, __HIP_MEMORY_SCOPE_AGENT);
#endif
    __syncthreads();
    XcdBarrier xbar; xbar.w = wave; xbar.bar = barw; xbar.x = 0; xbar.st = MISC + 8;
#if MK_PER_PHASE
#define SEAM(k) do { } while (0)
#else
#define SEAM(k) do { if (IN(k) && IN((k) + 1)) xcd_barrier(xbar); } while (0)
#endif
    if (IN(0)) { WS_PTRS
        LAS float* scr = (LAS float*)((LAS unsigned char*)lds + wave * 16384);
        constexpr int I_AIN = 32 * (A_IN / 32), I_SQ = 32 * (DM / 32), I_BIN = 32 * (B_IN / 32);
        constexpr int NITEMS = 2 * (I_AIN + I_SQ + I_BIN + I_SQ);
        for (int it = gw; it < NITEMS; it += NGW) {
            int r = it; const int j = r / (NITEMS / 2); r -= j * (NITEMS / 2);
            if (r < I_AIN) { const int nblk = A_IN / 32, kb = r / nblk, nb = r % nblk, sb = (nb * 32) / 2048;
                unsigned char* W8 = (unsigned char*)WAin + (size_t)j * A_IN * DM * 2; bf16* W16 = (bf16*)(W8 + 48 * MiB);
                const float* src = args.a_w_in + (size_t)j * DM * A_IN;
                if (sb < 9 && (sb % 3) < 2) p0_transpose_item_f8(src, DM, A_IN, W8, (2 * (sb / 3) + (sb % 3) - sb) * 2048, scr, kb, nb, lane);
                else if (A_VG_FP8 && !(A_GATE_BF16 && sb == 9)) p0_transpose_item_f8(src, DM, A_IN, W8, ((sb == 9 ? 6 : 7 + sb / 3) - sb) * 2048, scr, kb, nb, lane);
                else p0_transpose_item(src, DM, A_IN, W16, ((sb == 9 ? 0 : 1 + sb / 3) - sb) * 2048, scr, kb, nb, lane);
                continue; } r -= I_AIN;
            if (r < I_SQ) { p0_transpose_item(args.a_w_out + (size_t)j * DM * DM, DM, DM, WAout + (size_t)j * DM * DM, 0, scr, r / (DM / 32), r % (DM / 32), lane); continue; } r -= I_SQ;
            if (r < I_BIN) { const int nblk = B_IN / 32, kb = r / nblk, nb = r % nblk, sb = (nb * 32) / 2048;
                const int db = sb == 0 ? 0 : (sb == 1 ? 2 : 1);
                p0_transpose_item(args.b_w_in + (size_t)j * DM * B_IN, DM, B_IN, WBin + (size_t)j * B_IN * DM, (db - sb) * 2048, scr, kb, nb, lane); continue; } r -= I_BIN;
            p0_transpose_item(args.b_w_out + (size_t)j * DM * DM, DM, DM, WBout + (size_t)j * DM * DM, 0, scr, r / (DM / 32), r % (DM / 32), lane);
        }
        const int gt = bx * NTHR + tid, NGT = G * NTHR;
        for (int i = gt; i < 2 * 16 * 128 * 128 / 2; i += NGT) { const int e = 2 * i, s = e & 127, t = (e >> 7) & 127;
            const f32x2v w = *(const f32x2v*)(args.b_w_s + e); ((unsigned*)WM)[i] = pk2(s <= t ? w.x : 0.f, s + 1 <= t ? w.y : 0.f); }
        for (int i = gt; i < MTOK * 16; i += NGT) { const int tok = i >> 4, f = i & 15; const double rev = (double)args.pos[tok] * args.invf[f]; const float fr = (float)(rev - floor(rev));
            COS[i] = __builtin_amdgcn_cosf(fr); SIN[i] = __builtin_amdgcn_sinf(fr); }
        for (int i = gt; i < 2 * MTOK * 2; i += NGT) STATS[i] = 0.f;
        for (int i = gt; i < 4 * MTOK; i += NGT) RSS[i] = i < MTOK ? 2048.0f * (1.0f - 1e-6f) : 0.f;
        for (int m = gw; m < MTOK; m += NGW) rms_row<(!A_VG_FP8 || A_GATE_BF16), false, true>(args.x + (size_t)m * DM, args.a_norm_g, XN + (size_t)m * DM, nullptr, XN8 + (size_t)m * DM, lane);
    }
#if !MK_PER_PHASE
    cg::this_grid().sync();
    xbar = xcd_barrier_post(barw, MISC + 8, wave);
#endif
    for (int rep = 0; rep < 2; ++rep) {
        const int P = 1 + 9 * rep;
        if (IN(P)) { WS_PTRS
            const char* W8 = (const char*)WAin + (size_t)rep * A_IN * DM * 2;
            const float* rssA = RSS + (size_t)(2 * rep) * MTOK;
            const pg8::EpiA1 e1{QK, GATE, COS, SIN, 1.0f / W8_SCALE, 0, rssA};
#if A_VG_FP8 && A_GATE_BF16
            { pg8::MultiOrder S{{(const char*)XN8, W8, 32, 48, 1}, {W8 + (size_t)14336 * DM, (const char*)XN8, 8, 32, 1}, {W8 + (size_t)16384 * DM, (const char*)XN8, 8, 32, 4},
                                {W8 + (size_t)18432 * DM, (const char*)XN8, 8, 32, 16}, 4, launder_s(G), launder_s(bx), DM};
              pg8::EpiAllA E{e1, pg8::EpiPlain{VT, 1.0f / W8_SCALE, rssA, 0}, 1};
              pg8::gemm_phase<pg8::EpiAllA, pg8::MultiOrder, true, true, true>((LAS unsigned char*)lds, DM, S, E, wave); }
            { const char* W16 = W8 + 48 * MiB;
              pg8::MultiOrder S{{(const char*)XN, W16, 32, 8, 1}, {nullptr, nullptr, 0, 0, 1}, {nullptr, nullptr, 0, 0, 1}, {nullptr, nullptr, 0, 0, 1}, 1, launder_s(G), launder_s(bx), DM * 2};
              const pg8::EpiA1 eg{QK, GATE, COS, SIN, 1.0f, 48, rssA};
              pg8::gemm_phase<pg8::EpiA1, pg8::MultiOrder, true, true, false>((LAS unsigned char*)lds, DM, S, eg, wave); }
#elif A_VG_FP8
            pg8::MultiOrder S{{(const char*)XN8, W8, 32, 56, 1}, {W8 + (size_t)14336 * DM, (const char*)XN8, 8, 32, 1}, {W8 + (size_t)16384 * DM, (const char*)XN8, 8, 32, 4},
                              {W8 + (size_t)18432 * DM, (const char*)XN8, 8, 32, 16}, 4, launder_s(G), launder_s(bx), DM};
            pg8::EpiAllA E{e1, pg8::EpiPlain{VT, 1.0f / W8_SCALE, rssA, 0}, 1};
            pg8::gemm_phase<pg8::EpiAllA, pg8::MultiOrder, true, true, true>((LAS unsigned char*)lds, DM, S, E, wave);
#else
            { pg8::MultiOrder S{{(const char*)XN8, W8, 32, 48, 1}, {nullptr, nullptr, 0, 0, 1}, {nullptr, nullptr, 0, 0, 1}, {nullptr, nullptr, 0, 0, 1}, 1, launder_s(G), launder_s(bx), DM};
              pg8::gemm_phase<pg8::EpiA1, pg8::MultiOrder, true, true, true>((LAS unsigned char*)lds, DM, S, e1, wave); }
            { const char* W16 = W8 + 48 * MiB;
              pg8::MultiOrder S{{(const char*)XN, W16, 32, 8, 1}, {W16 + (size_t)2048 * DM * 2, (const char*)XN, 8, 32, 1}, {W16 + (size_t)4096 * DM * 2, (const char*)XN, 8, 32, 4},
                                {W16 + (size_t)6144 * DM * 2, (const char*)XN, 8, 32, 16}, 4, launder_s(G), launder_s(bx), DM * 2};
              pg8::EpiAllA E{pg8::EpiA1{QK, GATE, COS, SIN, 1.0f, 48, rssA}, pg8::EpiPlain{VT, 1.0f, rssA, 0}, 1};
              pg8::gemm_phase<pg8::EpiAllA, pg8::MultiOrder, true, true, false>((LAS unsigned char*)lds, DM, S, E, wave); }
#endif
        }
        SEAM(P);
        if (IN(P + 1)) { WS_PTRS attn_phase(QK, VT, OG, LSE, bx, G, wave, launder(lane), (LAS unsigned char*)lds); }
        SEAM(P + 1);
        if (IN(P + 2)) { WS_PTRS merge_phase(OG, LSE, GATE, Y, gw, NGW, launder(lane)); }
        SEAM(P + 2);
        if (IN(P + 3)) { WS_PTRS pg8::MultiOrder S{{(const char*)Y, (const char*)(WAout + (size_t)rep * DM * DM), 32, 8, 1}, {nullptr, nullptr, 0, 0, 1}, {nullptr, nullptr, 0, 0, 1}, {nullptr, nullptr, 0, 0, 1}, 1, launder_s(G), launder_s(bx), DM * 2};
            pg8::EpiOut E{rep == 0 ? args.x : X, X, args.b_norm_g + (size_t)rep * DM, XN, nullptr, RSS + (size_t)(2 * rep + 1) * MTOK};
            pg8::gemm_phase<pg8::EpiOut, pg8::MultiOrder, true, true>((LAS unsigned char*)lds, DM, S, E, wave); }
        SEAM(P + 3);
        if (IN(P + 5)) { WS_PTRS
            const char* W = (const char*)(WBin + (size_t)rep * B_IN * DM);
            pg8::MultiOrder S{{(const char*)XN, W, 32, 16, 1}, {W + (size_t)4096 * DM * 2, (const char*)XN, 8, 32, 1}, {nullptr, nullptr, 0, 0, 1}, {nullptr, nullptr, 0, 0, 1}, 2, launder_s(G), launder_s(bx), DM * 2};
            const float* rssB = RSS + (size_t)(2 * rep + 1) * MTOK;
            pg8::EpiAllB E{pg8::EpiB1{U, ZS, rssB}, pg8::EpiB2{VT, STATS + (size_t)rep * MTOK * 2, rssB}};
            pg8::gemm_phase<pg8::EpiAllB, pg8::MultiOrder, true, true>((LAS unsigned char*)lds, DM, S, E, wave);
        }
        SEAM(P + 5);
        if (IN(P + 6)) { WS_PTRS sgu_phase(VT, STATS + (size_t)rep * MTOK * 2, args.b_ln_g + (size_t)rep * DM, args.b_ln_b + (size_t)rep * DM, WM + (size_t)rep * 16 * 128 * 128, args.b_b_s + (size_t)rep * 16 * 128, U, ZS, Y, gw, NGW, launder(lane), (LAS unsigned char*)lds + wave * 4096); }
        SEAM(P + 6);
        if (IN(P + 7)) { WS_PTRS pg8::MultiOrder S{{(const char*)Y, (const char*)(WBout + (size_t)rep * DM * DM), 32, 8, 1}, {nullptr, nullptr, 0, 0, 1}, {nullptr, nullptr, 0, 0, 1}, {nullptr, nullptr, 0, 0, 1}, 1, launder_s(G), launder_s(bx), DM * 2};
            pg8::EpiOut E{X, X, rep == 0 ? args.a_norm_g + DM : nullptr, XN, XN8, RSS + (size_t)2 * MTOK};
            pg8::gemm_phase<pg8::EpiOut, pg8::MultiOrder, true, true>((LAS unsigned char*)lds, DM, S, E, wave); }
        if (rep == 1) SEAM(P + 7);
        if (IN(P + 8)) { WS_PTRS const int ln = launder(lane);
            if (rep == 1) { for (int m = gw; m < MTOK; m += NGW) rms_row<false, true, false>(X + (size_t)m * DM, args.final_g, nullptr, args.out + (size_t)m * DM, nullptr, ln); }
        }
        if (rep == 0) SEAM(P + 8);
    }
#undef IN
#undef SEAM
#undef tid
#undef lane
}

extern "C" void kernel_launch(void* const* d_in, const int* in_sizes, int n_in, void* d_out, int out_size, void* d_ws, size_t ws_size, hipStream_t stream) {
    static int grid = 0;
    if (grid == 0) {
        if (n_in != 13 || in_sizes[0] != MTOK * DM || out_size != MTOK * DM || ws_size < WS_END) { fprintf(stderr, "kernel_launch: unexpected shapes / workspace (n_in %d, in0 %d, out %d, ws %zu, need %zu)\n", n_in, n_in > 0 ? in_sizes[0] : -1, out_size, ws_size, (size_t)WS_END); grid = -1; return; }
        int dev = 0, cus = 0, per_cu = 0;
        if (hipGetDevice(&dev) != hipSuccess || hipDeviceGetAttribute(&cus, hipDeviceAttributeMultiprocessorCount, dev) != hipSuccess) { grid = -1; return; }
        if (hipFuncSetAttribute((const void*)trunk_fwd, hipFuncAttributeMaxDynamicSharedMemorySize, LDS_BYTES) != hipSuccess) { fprintf(stderr, "kernel_launch: hipFuncSetAttribute failed\n"); grid = -1; return; }
        if (hipOccupancyMaxActiveBlocksPerMultiprocessor(&per_cu, (const void*)trunk_fwd, NTHR, LDS_BYTES) != hipSuccess || per_cu < 1) { fprintf(stderr, "kernel_launch: occupancy query failed (%d)\n", per_cu); (void)hipGetLastError(); grid = -1; return; }
        grid = cus * per_cu;
    }
    if (grid < 0) return;
    Args a{};
    a.x = (const float*)d_in[0]; a.pos = (const int*)d_in[1]; a.a_norm_g = (const float*)d_in[2]; a.a_w_in = (const float*)d_in[3]; a.a_w_out = (const float*)d_in[4];
    a.b_norm_g = (const float*)d_in[5]; a.b_w_in = (const float*)d_in[6]; a.b_ln_g = (const float*)d_in[7]; a.b_ln_b = (const float*)d_in[8]; a.b_w_s = (const float*)d_in[9];
    a.b_b_s = (const float*)d_in[10]; a.b_w_out = (const float*)d_in[11]; a.final_g = (const float*)d_in[12];
    a.out = (float*)d_out; a.ws = (unsigned char*)d_ws;
    for (int i = 0; i < 16; ++i) a.invf[i] = pow(500000.0, -(double)i / 16.0) / 6.283185307179586476925;
#if MK_PER_PHASE
    for (int p = 0; p < N_PHASES; ++p) { a.ph_lo = p; a.ph_hi = p + 1; hipLaunchKernelGGL(trunk_fwd, dim3(grid), dim3(NTHR), LDS_BYTES, stream, a); }
#else
    a.ph_lo = 0; a.ph_hi = N_PHASES;
    void* kargs[] = {&a};
    const hipError_t e = hipLaunchCooperativeKernel((const void*)trunk_fwd, dim3(grid), dim3(NTHR), kargs, LDS_BYTES, stream);
    if (e != hipSuccess) fprintf(stderr, "kernel_launch: cooperative launch failed: %s (grid %d)\n", hipGetErrorString(e), grid);
#endif
}
```

```cpp
#include <hip/hip_runtime.h>
#include <hip/hip_cooperative_groups.h>
#include <cstdio>
#include <cstdint>
#include <cmath>
namespace cg = cooperative_groups;
#ifndef A_VG_FP8
#define A_VG_FP8 1
#endif
#ifndef A_GATE_BF16
#define A_GATE_BF16 1
#endif
#ifndef MK_PER_PHASE
#define MK_PER_PHASE 0
#endif
__device__ __forceinline__ int lane_id() { int l; asm volatile("v_mbcnt_lo_u32_b32 %0, -1, 0\n\tv_mbcnt_hi_u32_b32 %0, -1, %0" : "=v"(l)); return l; }
namespace pg8 {
#define PG8_LAS __attribute__((address_space(3)))
typedef unsigned short bf16_t;
typedef short bf16x8 __attribute__((ext_vector_type(8)));
typedef float f32x4 __attribute__((ext_vector_type(4)));
typedef unsigned u32x4 __attribute__((ext_vector_type(4)));
typedef int i32x4 __attribute__((ext_vector_type(4)));
constexpr int BM = 256, BK = 64, HALF = 128, HTB = HALF * BK * 2  , STAGE_BYTES = 8 * HTB, NXCD = 8, WGM = 8;

__host__ __device__ __forceinline__ int lds_byte(int r, int c) { const int st = (r >> 4) * 2 + (c >> 5), rr = r & 15, cc = c & 31, ob = rr * 64 + cc * 2; return st * 1024 + (ob ^ (((ob >> 9) & 1) << 5)); }
__host__ __device__ __forceinline__ void stage_rc(int b, int& R, int& C) { const int st = b / 1024, sb = b % 1024, swz = sb ^ (((sb >> 9) & 1) << 5); R = (st >> 1) * 16 + swz / 64; C = (st & 1) * 32 + (swz % 64) / 2; }
__host__ __device__ __forceinline__ int perm32(int rho) { const int n = rho >> 4, i = rho & 15; return 8 * (i >> 2) + 4 * n + (i & 3); }

struct Unit { int pm, pn, k; };
struct Prob { const char* A; const char* B; int nM, nN, bdil; };
struct StaticOrder {
    int nM, nN, nwg, G, c;
    __host__ __device__ void init(int M, int N, int G_, int c_) { nM = M / BM; nN = N / BM; nwg = nM * nN; G = G_; c = c_; }
    __host__ __device__ bool next(int i, Unit& u) const {
        const long L = (long)i * G + c; if (L >= nwg) return false;
        int wgid = (int)L; { const int q = nwg / NXCD, r = nwg % NXCD, xcd = wgid % NXCD, off = wgid / NXCD; wgid = (xcd < r ? xcd * (q + 1) : r * (q + 1) + (xcd - r) * q) + off; }
        const int nig = WGM * nN, gid = wgid / nig, fm = gid * WGM, gsz = (nM - fm) < WGM ? (nM - fm) : WGM;
        u.pm = fm + ((wgid % nig) % gsz); u.pn = (wgid % nig) / gsz; return true;
    }
    __device__ __forceinline__ void a_ready(const Unit&) const {}
    __device__ __forceinline__ void done(const Unit&) const {}
};
struct MultiOrder {
    Prob p0, p1, p2, p3; int np, G, c, rowbytes;
    __device__ __forceinline__ static void map(const Prob& P, int wgid, Unit& u) {
        const int nM = P.nM, nN = P.nN, nwg = nM * nN;
        { const int q = nwg / NXCD, r = nwg % NXCD, xcd = wgid % NXCD, off = wgid / NXCD; wgid = (xcd < r ? xcd * (q + 1) : r * (q + 1) + (xcd - r) * q) + off; }
        const int nig = WGM * nN, gid = wgid / nig, fm = gid * WGM, gsz = (nM - fm) < WGM ? (nM - fm) : WGM;
        u.pm = fm + ((wgid % nig) % gsz); u.pn = (wgid % nig) / gsz;
    }
    __device__ __forceinline__ bool next(int i, Unit& u) const {
        long L = (long)i * G + c;
        { const int n = p0.nM * p0.nN; if (L < n) { map(p0, (int)L, u); u.k = 0; return true; } L -= n; }
        if (np > 1) { const int n = p1.nM * p1.nN; if (L < n) { map(p1, (int)L, u); u.k = 1; return true; } L -= n; }
        if (np > 2) { const int n = p2.nM * p2.nN; if (L < n) { map(p2, (int)L, u); u.k = 2; return true; } L -= n; }
        if (np > 3) { const int n = p3.nM * p3.nN; if (L < n) { map(p3, (int)L, u); u.k = 3; return true; } L -= n; }
        return false;
    }
    __device__ __forceinline__ const char* selA(int k) const { return k == 0 ? p0.A : (k == 1 ? p1.A : (k == 2 ? p2.A : p3.A)); }
    __device__ __forceinline__ const char* selB(int k) const { return k == 0 ? p0.B : (k == 1 ? p1.B : (k == 2 ? p2.B : p3.B)); }
    __device__ __forceinline__ int bdil(const Unit& u) const { return u.k == 0 ? p0.bdil : (u.k == 1 ? p1.bdil : (u.k == 2 ? p2.bdil : p3.bdil)); }
    __device__ __forceinline__ const char* a_base(const Unit& u) const { return selA(u.k) + (size_t)u.pm * 256 * rowbytes; }
    __device__ __forceinline__ const char* b_base(const Unit& u) const { const int d = bdil(u), t8 = u.pn & 7; const int r = (u.pn >> 3) * 2048 + (d == 1 ? 256 * t8 : (d == 4 ? 1024 * (t8 & 1) + (t8 >> 1) : 2 * t8)); return selB(u.k) + (size_t)r * rowbytes; }
    __device__ __forceinline__ void a_ready(const Unit&) const {}
    __device__ __forceinline__ void done(const Unit&) const {}
};


__device__ __forceinline__ unsigned cvt_pk_bf16(float lo, float hi) { unsigned r; asm volatile("v_cvt_pk_bf16_f32 %0, %1, %2" : "=v"(r) : "v"(lo), "v"(hi)); return r; }
typedef float f32x2 __attribute__((ext_vector_type(2)));
__device__ __forceinline__ f32x2 gelu_pk(f32x2 v) {
    const f32x2 av = __builtin_elementwise_abs(v), d = av * 0.2316418882f + 1.0f;
    f32x2 t; t.x = __builtin_amdgcn_rcpf(d.x); t.y = __builtin_amdgcn_rcpf(d.y);
    f32x2 q = t * 0.5307027145f + (-0.7265760135f); q = q * t + 0.7107068705f; q = q * t + (-0.142248368f); q = q * t + 0.127414796f; q = q * t;
    const f32x2 s = (v * v) * (-0.72134752044f);
    f32x2 e; e.x = __builtin_amdgcn_exp2f(s.x); e.y = __builtin_amdgcn_exp2f(s.y);
    const f32x2 m = v * (q * e), r = v - m;
    f32x2 o; o.x = v.x < 0.f ? m.x : r.x; o.y = v.y < 0.f ? m.y : r.y; return o;
}

constexpr float C2 = 0.08838834764831845f * 1.4426950408889634f;
__device__ __forceinline__ float silu_f(float x) { return x * __builtin_amdgcn_rcpf(1.0f + __builtin_amdgcn_exp2f(-1.4426950408889634f * x)); }
__device__ __forceinline__ u32x4 pack8(const f32x4& v0, const f32x4& v1) { u32x4 w; w.x = cvt_pk_bf16(v0[0], v0[1]); w.y = cvt_pk_bf16(v0[2], v0[3]); w.z = cvt_pk_bf16(v1[0], v1[1]); w.w = cvt_pk_bf16(v1[2], v1[3]); return w; }
__device__ __forceinline__ void gelu8(f32x4& v0, f32x4& v1) { f32x2 a = gelu_pk((f32x2){v0[0], v0[1]}), b = gelu_pk((f32x2){v0[2], v0[3]}), c = gelu_pk((f32x2){v1[0], v1[1]}), d = gelu_pk((f32x2){v1[2], v1[3]});
    v0 = (f32x4){a.x, a.y, b.x, b.y}; v1 = (f32x4){c.x, c.y, d.x, d.y}; }

struct EpiA1 {
    static constexpr bool PERM = true, AFTER_DRAIN = false;
    bf16_t* QK; bf16_t* GATE; const float* COS; const float* SIN; float osc; int pn0; const float* rss;
    __device__ __forceinline__ void operator()(const f32x4 (&acc)[2][2][4][2], const Unit& u, int wr, int wc, int fr, int fq) const {
        const int pn = u.pn + pn0; const int rowb = u.pm * BM + wr * 64 + fr;
        if (pn >= 48) {
            const int col0 = (pn - 48) * 256 + wc * 32 + 8 * fq;
#pragma unroll
            for (int ai = 0; ai < 2; ++ai)
#pragma unroll
                for (int m = 0; m < 4; ++m) { bf16_t* rowp = GATE + (size_t)(rowb + ai * HALF + m * 16) * 2048 + col0; const float rs = osc * __builtin_amdgcn_rsqf(rss[rowb + ai * HALF + m * 16] * (1.0f / 2048) + 1e-6f);
#pragma unroll
                    for (int bj = 0; bj < 2; ++bj) { f32x4 v0 = acc[ai][bj][m][0] * rs, v1 = acc[ai][bj][m][1] * rs;
#pragma unroll
                        for (int i = 0; i < 4; ++i) { v0[i] = silu_f(v0[i]); v1[i] = silu_f(v1[i]); }
                        *(u32x4*)(rowp + bj * HALF) = pack8(v0, v1); } }
        } else {
            const int g = pn >> 4, qk = (pn >> 3) & 1, hp = pn & 7, dsh = 2 * g, dm1 = (1 << dsh) - 1;
            const float sc = osc; const float sgn = fq < 2 ? -1.0f : 1.0f; const int e0 = wc * 32 + 8 * fq;
#pragma unroll
            for (int ai = 0; ai < 2; ++ai)
#pragma unroll
                for (int m = 0; m < 4; ++m) { const int row = rowb + ai * HALF + m * 16, b = row >> 11, s = row & 2047, p = ((s & dm1) << (11 - dsh)) | (s >> dsh);
                    f32x4 c0, c1, s0, s1; const float scr = sc * __builtin_amdgcn_rsqf(rss[row] * (1.0f / 2048) + 1e-6f);
                    if (wc == 0) { const float* cp = COS + (size_t)row * 16 + 8 * (fq & 1); const float* sp = SIN + (size_t)row * 16 + 8 * (fq & 1);
                        c0 = *(const f32x4*)cp; c1 = *(const f32x4*)(cp + 4); s0 = *(const f32x4*)sp; s1 = *(const f32x4*)(sp + 4);
                        }
#pragma unroll
                    for (int bj = 0; bj < 2; ++bj) { f32x4 v0 = acc[ai][bj][m][0], v1 = acc[ai][bj][m][1];
                        if (wc == 0) {
#pragma unroll
                            for (int i = 0; i < 4; ++i) { const float p0 = __shfl_xor(v0[i], 32), p1 = __shfl_xor(v1[i], 32);
                                v0[i] = v0[i] * c0[i] + sgn * p0 * s0[i]; v1[i] = v1[i] * c1[i] + sgn * p1 * s1[i]; } }
                        v0 = v0 * scr; v1 = v1 * scr;
                        unsigned char* dst = (unsigned char*)QK + ((((size_t)((g * 2 + qk) * 4 + b) * 16 + (2 * hp + bj)) * 2048 + p) * 128 + e0);
                        int w0 = 0, w1 = 0; w0 = __builtin_amdgcn_cvt_pk_fp8_f32(v0[0], v0[1], w0, false); w0 = __builtin_amdgcn_cvt_pk_fp8_f32(v0[2], v0[3], w0, true);
                        w1 = __builtin_amdgcn_cvt_pk_fp8_f32(v1[0], v1[1], w1, false); w1 = __builtin_amdgcn_cvt_pk_fp8_f32(v1[2], v1[3], w1, true);
                        *(unsigned long long*)dst = ((unsigned long long)(unsigned)w1 << 32) | (unsigned)w0; } }
        }
    }
};
struct EpiB1 {
    static constexpr bool PERM = true, AFTER_DRAIN = false;
    bf16_t* U; bf16_t* ZS; const float* rss;
    __device__ __forceinline__ void operator()(const f32x4 (&acc)[2][2][4][2], const Unit& u, int wr, int wc, int fr, int fq) const {
        const int pn = u.pn; const int rowb = u.pm * BM + wr * 64 + fr; const bool isz = pn >= 8;
        bf16_t* base = isz ? ZS : U; const int col0 = (pn & 7) * 256 + wc * 32 + 8 * fq;
#pragma unroll
        for (int ai = 0; ai < 2; ++ai)
#pragma unroll
            for (int m = 0; m < 4; ++m) { bf16_t* rowp = base + (size_t)(rowb + ai * HALF + m * 16) * 2048 + col0; const float rs = __builtin_amdgcn_rsqf(rss[rowb + ai * HALF + m * 16] * (1.0f / 2048) + 1e-6f);
#pragma unroll
                for (int bj = 0; bj < 2; ++bj) { f32x4 v0 = acc[ai][bj][m][0] * rs, v1 = acc[ai][bj][m][1] * rs;
                    if (isz) {
#pragma unroll
                        for (int i = 0; i < 4; ++i) { v0[i] = silu_f(v0[i]); v1[i] = silu_f(v1[i]); }
                    } else gelu8(v0, v1);
                    *(u32x4*)(rowp + bj * HALF) = pack8(v0, v1); } }
    }
};
struct EpiPlain {
    static constexpr bool PERM = true, AFTER_DRAIN = false;
    bf16_t* O; float osc; const float* rss; int dsh;
    __device__ __forceinline__ void operator()(const f32x4 (&acc)[2][2][4][2], const Unit& u, int wr, int wc, int fr, int fq) const {
        const int rowb = u.pm * BM + wr * 64 + fr; const int col0 = u.pn * BM + wc * 32 + 8 * fq;
#pragma unroll
        for (int bj = 0; bj < 2; ++bj) { const int c = col0 + bj * HALF, p = c & 2047, Lm1 = (2048 >> dsh) - 1; const float* rp = rss + (c & ~2047) + ((p & Lm1) << dsh) + (p >> (11 - dsh));
            f32x4 r0, r1;
#pragma unroll
            for (int k = 0; k < 4; ++k) { r0[k] = osc * __builtin_amdgcn_rsqf(rp[k << dsh] * (1.0f / 2048) + 1e-6f); r1[k] = osc * __builtin_amdgcn_rsqf(rp[(k + 4) << dsh] * (1.0f / 2048) + 1e-6f); }
#pragma unroll
            for (int ai = 0; ai < 2; ++ai)
#pragma unroll
                for (int m = 0; m < 4; ++m) { bf16_t* rowp = O + (size_t)((c >> 5)) * 65536 + (size_t)(rowb + ai * HALF + m * 16) * 32 + (c & 31);
                    *(u32x4*)rowp = pack8(acc[ai][bj][m][0] * r0, acc[ai][bj][m][1] * r1); } }
    }
};
struct EpiB2 {
    static constexpr bool PERM = true, AFTER_DRAIN = false;
    bf16_t* VT; float* STATS; const float* rss;
    __device__ __forceinline__ static float row16_sum(float v) {
        v += __builtin_bit_cast(float, __builtin_amdgcn_update_dpp(0, __builtin_bit_cast(int, v), 0xB1, 0xf, 0xf, true));
        v += __builtin_bit_cast(float, __builtin_amdgcn_update_dpp(0, __builtin_bit_cast(int, v), 0x4E, 0xf, 0xf, true));
        v += __builtin_bit_cast(float, __builtin_amdgcn_update_dpp(0, __builtin_bit_cast(int, v), 0x141, 0xf, 0xf, true));
        v += __builtin_bit_cast(float, __builtin_amdgcn_update_dpp(0, __builtin_bit_cast(int, v), 0x140, 0xf, 0xf, true));
        return v; }
    __device__ __forceinline__ void operator()(const f32x4 (&acc)[2][2][4][2], const Unit& u, int wr, int wc, int fr, int fq) const {
        const int rowb = u.pm * BM + wr * 64 + fr; const int col0 = u.pn * BM + wc * 32 + 8 * fq;
#pragma unroll
        for (int bj = 0; bj < 2; ++bj) {
            float s1[8], s2[8]; f32x4 r0 = *(const f32x4*)(rss + col0 + bj * HALF), r1 = *(const f32x4*)(rss + col0 + bj * HALF + 4);
#pragma unroll
            for (int k = 0; k < 4; ++k) { r0[k] = __builtin_amdgcn_rsqf(r0[k] * (1.0f / 2048) + 1e-6f); r1[k] = __builtin_amdgcn_rsqf(r1[k] * (1.0f / 2048) + 1e-6f); }
#pragma unroll
            for (int k = 0; k < 8; ++k) { s1[k] = 0.f; s2[k] = 0.f; }
#pragma unroll
            for (int ai = 0; ai < 2; ++ai)
#pragma unroll
                for (int m = 0; m < 4; ++m) { bf16_t* rowp = VT + (size_t)((col0 >> 5) + 4 * bj) * 65536 + (size_t)(rowb + ai * HALF + m * 16) * 32 + (col0 & 31);
                    f32x4 v0 = acc[ai][bj][m][0] * r0, v1 = acc[ai][bj][m][1] * r1; gelu8(v0, v1);
#pragma unroll
                    for (int i = 0; i < 4; ++i) { s1[i] += v0[i]; s2[i] += v0[i] * v0[i]; s1[4 + i] += v1[i]; s2[4 + i] += v1[i] * v1[i]; }
                    *(u32x4*)rowp = pack8(v0, v1); }
#pragma unroll
            for (int k = 0; k < 8; ++k) { const float a = row16_sum(s1[k]), b = row16_sum(s2[k]);
                if (fr == 0) { float* sp = STATS + 2 * (size_t)(col0 + bj * HALF + k); atomicAdd(sp, a); atomicAdd(sp + 1, b); } }
            asm volatile("" ::: "memory");
        }
    }
};
struct EpiAllA {
    static constexpr bool PERM = true, AFTER_DRAIN = false;
    EpiA1 e1; EpiPlain ev; int kv0;
    __device__ __forceinline__ void operator()(const f32x4 (&acc)[2][2][4][2], const Unit& u, int wr, int wc, int fr, int fq) const {
        if (u.k < kv0) e1(acc, u, wr, wc, fr, fq);
        else { EpiPlain e = ev; e.O += (size_t)(u.k - kv0) * 2048 * 8192; e.dsh = 2 * (u.k - kv0); e(acc, u, wr, wc, fr, fq); }
    }
};
struct EpiAllB {
    static constexpr bool PERM = true, AFTER_DRAIN = false;
    EpiB1 e1; EpiB2 e2;
    __device__ __forceinline__ void operator()(const f32x4 (&acc)[2][2][4][2], const Unit& u, int wr, int wc, int fr, int fq) const {
        if (u.k == 0) e1(acc, u, wr, wc, fr, fq); else e2(acc, u, wr, wc, fr, fq);
    }
};
struct EpiOut {
    static constexpr bool PERM = false, AFTER_DRAIN = false;
    const float* base; float* out; const float* gn; bf16_t* xb; unsigned char* x8; float* rss;
    __device__ __forceinline__ void operator()(const f32x4 (&acc)[2][2][4][2], const Unit& u, int wr, int wc, int fr, int fq) const {
        const int rowb = u.pm * BM + wr * 64 + fr; const int col0 = u.pn * BM + wc * 32 + 4 * fq;
        f32x4 gv[2][2];
        if (gn) {
#pragma unroll
            for (int bj = 0; bj < 2; ++bj)
#pragma unroll
                for (int n = 0; n < 2; ++n) gv[bj][n] = *(const f32x4*)(gn + col0 + bj * HALF + n * 16); }
#pragma unroll
        for (int ai = 0; ai < 2; ++ai)
#pragma unroll
            for (int m = 0; m < 4; ++m) { const int row = rowb + ai * HALF + m * 16; const size_t off = (size_t)row * 2048 + col0; float ss = 0.f;
#pragma unroll
                for (int bj = 0; bj < 2; ++bj)
#pragma unroll
                    for (int n = 0; n < 2; ++n) { const f32x4 bs = *(const f32x4*)(base + off + bj * HALF + n * 16); const f32x4 x = bs + acc[ai][bj][m][n]; *(f32x4*)(out + off + bj * HALF + n * 16) = x;
                        if (gn) { ss += (x[0] * x[0] + x[1] * x[1]) + (x[2] * x[2] + x[3] * x[3]); const f32x4 y = x * gv[bj][n];
                            unsigned lo = cvt_pk_bf16(y[0], y[1]), hi = cvt_pk_bf16(y[2], y[3]); *(unsigned long long*)(xb + off + bj * HALF + n * 16) = ((unsigned long long)hi << 32) | lo;
                            if (x8) { int w = 0; w = __builtin_amdgcn_cvt_pk_fp8_f32(y[0], y[1], w, false); w = __builtin_amdgcn_cvt_pk_fp8_f32(y[2], y[3], w, true); *(int*)(x8 + off + bj * HALF + n * 16) = w; } } }
                if (gn) { ss += __shfl_xor(ss, 16); ss += __shfl_xor(ss, 32); if (fq == 0) atomicAdd(rss + row, ss); } }
    }
};
template <class Epi, class Sched, bool ALIGN_EPI = false, bool SP2 = false, bool F8 = false>
__device__ __forceinline__ void gemm_phase(PG8_LAS unsigned char* lds, const int Kel, const Sched& S, const Epi& E, const int wave_) {
    const int tid = wave_ * 64 + ::lane_id(); const int wid = __builtin_amdgcn_readfirstlane(tid >> 6), lane = tid & 63, wr = wid >> 2, wc = wid & 3, fr = lane & 15, fq = lane >> 4;
    const int K = F8 ? Kel / 2 : Kel, nt = K / BK;
    unsigned voffA[2], voffB[2]; size_t hstepB;
#pragma unroll
    for (int i = 0; i < 2; ++i) { int R, C; stage_rc(tid * 16 + i * 8192, R, C); voffA[i] = (unsigned)(R * K + C) * 2u; }
#define PG8_SETB(dil) do { const int d_ = (dil); _Pragma("unroll") for (int i = 0; i < 2; ++i) { int R, C; stage_rc(tid * 16 + i * 8192, R, C); const int Rb = Epi::PERM ? ((R & ~31) + perm32(R & 31)) : R; \
        voffB[i] = (unsigned)(Rb * d_ * K + C) * 2u; } hstepB = (d_ == 16) ? (size_t)K * 2 : (size_t)HALF * d_ * K * 2; } while (0)
    const size_t kstep = (size_t)(BK * 2);
    const size_t hstep = (size_t)HALF * K * 2;
    const size_t tstep = 2 * hstep;
    const unsigned ldsw = (unsigned)wid * 1024u;
    const int aoff = lds_byte(wr * 64 + fr, fq * 8), boff = lds_byte(wc * 32 + fr, fq * 8);
#define PG8_SA(b, h) (((b) * 2 + (h)) * HTB)
#define PG8_SB(b, h) ((4 + (b) * 2 + (h)) * HTB)
#define PG8_STAGE(bufoff, gbase, voff) do { _Pragma("unroll") for (int _i = 0; _i < 2; ++_i) \
        __builtin_amdgcn_global_load_lds((const unsigned*)((const char*)(gbase) + (voff)[_i]), (PG8_LAS unsigned*)(lds + (bufoff) + ldsw + _i * 8192), 16, 0, 0); } while (0)
#define PG8_LDA(dst, b, h) do { _Pragma("unroll") for (int m = 0; m < 4; ++m) _Pragma("unroll") for (int k = 0; k < 2; ++k) dst[m][k] = *(const PG8_LAS bf16x8*)(lds + PG8_SA(b, h) + aoff + m * 2048 + k * 1024); } while (0)
#define PG8_LDB(dst, b, h) do { _Pragma("unroll") for (int n = 0; n < 2; ++n) _Pragma("unroll") for (int k = 0; k < 2; ++k) dst[n][k] = *(const PG8_LAS bf16x8*)(lds + PG8_SB(b, h) + boff + n * 2048 + k * 1024); } while (0)
#define PG8_CAT8(x) __builtin_shufflevector(__builtin_bit_cast(i32x4, (x)[0]), __builtin_bit_cast(i32x4, (x)[1]), 0, 1, 2, 3, 4, 5, 6, 7)
#define PG8_MMA(ai, bj, At, Bt) do { __builtin_amdgcn_s_setprio(1); \
        if constexpr (F8) { _Pragma("unroll") for (int m = 0; m < 4; ++m) _Pragma("unroll") for (int n = 0; n < 2; ++n) \
            asm volatile("v_mfma_f32_16x16x128_f8f6f4 %0, %1, %2, %0" : "+v"(acc[ai][bj][m][n]) : "v"(PG8_CAT8(Bt[n])), "v"(PG8_CAT8(At[m]))); } \
        else { _Pragma("unroll") for (int m = 0; m < 4; ++m) _Pragma("unroll") for (int n = 0; n < 2; ++n) _Pragma("unroll") for (int k = 0; k < 2; ++k) \
            acc[ai][bj][m][n] = __builtin_amdgcn_mfma_f32_16x16x32_bf16(Bt[n][k], At[m][k], acc[ai][bj][m][n], 0, 0, 0); } \
        __builtin_amdgcn_s_setprio(0); } while (0)
#define PG8_WAIT_V(n) asm volatile("s_waitcnt vmcnt(" #n ")" ::: "memory")
#define PG8_WAIT_L(n) asm volatile("s_waitcnt lgkmcnt(" #n ")" ::: "memory")
#define PG8_BAR __builtin_amdgcn_s_barrier()
#define PG8_SCHED __builtin_amdgcn_sched_barrier(0)
    Unit cur, nxt; int ui = 0;
    if (!S.next(0, cur)) return;
    f32x4 acc[2][2][4][2];
#pragma unroll
    for (int a = 0; a < 2; ++a)
#pragma unroll
        for (int b = 0; b < 2; ++b)
#pragma unroll
            for (int m = 0; m < 4; ++m)
#pragma unroll
                for (int n = 0; n < 2; ++n) acc[a][b][m][n] = (f32x4){0.f, 0.f, 0.f, 0.f};
    bf16x8 At[4][2], B0[2][2], B1[2][2];
    const char* cA = S.a_base(cur); const char* cB = S.b_base(cur); PG8_SETB(S.bdil(cur));
    S.a_ready(cur);
    if constexpr (SP2) {
        PG8_STAGE(PG8_SB(0, 0), cB, voffB); PG8_STAGE(PG8_SB(0, 1), cB + hstepB, voffB); PG8_STAGE(PG8_SA(0, 0), cA, voffA); PG8_STAGE(PG8_SA(0, 1), cA + hstep, voffA);
        if (wr == 1) PG8_BAR;
        PG8_WAIT_V(2); PG8_BAR;
        PG8_STAGE(PG8_SB(1, 0), cB + kstep, voffB); PG8_STAGE(PG8_SA(1, 0), cA + kstep, voffA); PG8_STAGE(PG8_SB(1, 1), cB + hstepB + kstep, voffB);
        PG8_WAIT_V(6); PG8_BAR;
    } else {
        PG8_STAGE(PG8_SB(0, 0), cB, voffB); PG8_STAGE(PG8_SA(0, 0), cA, voffA); PG8_STAGE(PG8_SB(0, 1), cB + hstepB, voffB); PG8_STAGE(PG8_SA(0, 1), cA + hstep, voffA);
        if (wr == 1) PG8_BAR;
        PG8_WAIT_V(4); PG8_BAR;
        PG8_STAGE(PG8_SB(1, 0), cB + kstep, voffB); PG8_STAGE(PG8_SA(1, 0), cA + kstep, voffA); PG8_STAGE(PG8_SB(1, 1), cB + hstepB + kstep, voffB);
        PG8_WAIT_V(6); PG8_BAR;
    }
    for (;;) {
        const bool has_next = S.next(ui + 1, nxt);
        const char* nA = has_next ? S.a_base(nxt) : cA; const char* nB = has_next ? S.b_base(nxt) : cB;
        for (int t = 0; t < nt; t += 2) {
            const bool last = (t == nt - 2);
            const char* a1 = cA + (size_t)(t + 1) * kstep;
            const char* a2 = last ? nA : cA + (size_t)(t + 2) * kstep; const char* b2 = last ? nB : cB + (size_t)(t + 2) * kstep;
            const char* a3 = a2 + kstep; const char* b3 = b2 + kstep;
            if (last && has_next) { S.a_ready(nxt); PG8_SETB(S.bdil(nxt)); }
            if constexpr (SP2) {
            PG8_LDB(B0, 0, 0); PG8_LDB(B1, 0, 1); PG8_SCHED; PG8_LDA(At, 0, 0); PG8_STAGE(PG8_SA(1, 1), a1 + hstep, voffA);
            PG8_WAIT_V(8); PG8_WAIT_L(0); PG8_BAR; PG8_MMA(0, 0, At, B0); PG8_MMA(0, 1, At, B1); PG8_BAR; PG8_SCHED;
            PG8_LDA(At, 0, 1); PG8_STAGE(PG8_SB(0, 0), b2, voffB); PG8_STAGE(PG8_SB(0, 1), b2 + hstepB, voffB); PG8_STAGE(PG8_SA(0, 0), a2, voffA);
            PG8_WAIT_V(8); PG8_WAIT_L(0); PG8_BAR; PG8_MMA(1, 0, At, B0); PG8_MMA(1, 1, At, B1); PG8_BAR; PG8_SCHED;
            PG8_LDB(B0, 1, 0); PG8_LDB(B1, 1, 1); PG8_SCHED; PG8_LDA(At, 1, 0); PG8_STAGE(PG8_SA(0, 1), a2 + hstep, voffA);
            PG8_WAIT_V(8); PG8_WAIT_L(0); PG8_BAR; PG8_MMA(0, 0, At, B0); PG8_MMA(0, 1, At, B1); PG8_BAR; PG8_SCHED;
            PG8_LDA(At, 1, 1); PG8_STAGE(PG8_SB(1, 0), b3, voffB); PG8_STAGE(PG8_SB(1, 1), b3 + hstepB, voffB); PG8_STAGE(PG8_SA(1, 0), a3, voffA);
            PG8_WAIT_V(8); PG8_WAIT_L(0); PG8_BAR; PG8_MMA(1, 0, At, B0); PG8_MMA(1, 1, At, B1); PG8_BAR; PG8_SCHED;
            } else {
            PG8_LDB(B0, 0, 0); PG8_SCHED; PG8_LDA(At, 0, 0); PG8_STAGE(PG8_SA(1, 1), a1 + hstep, voffA);
            PG8_WAIT_L(8); PG8_BAR; PG8_WAIT_L(0); PG8_MMA(0, 0, At, B0); PG8_BAR; PG8_SCHED;
            PG8_LDB(B1, 0, 1); PG8_STAGE(PG8_SB(0, 0), b2, voffB);
            PG8_BAR; PG8_WAIT_L(0); PG8_MMA(0, 1, At, B1); PG8_BAR;
            PG8_LDA(At, 0, 1); PG8_STAGE(PG8_SA(0, 0), a2, voffA);
            PG8_BAR; PG8_WAIT_L(0); PG8_MMA(1, 0, At, B0); PG8_BAR; PG8_SCHED;
            PG8_STAGE(PG8_SB(0, 1), b2 + hstepB, voffB);
            PG8_WAIT_V(6); PG8_BAR; PG8_MMA(1, 1, At, B1); PG8_BAR;
            PG8_LDB(B0, 1, 0); PG8_SCHED; PG8_LDA(At, 1, 0); PG8_STAGE(PG8_SA(0, 1), a2 + hstep, voffA);
            PG8_WAIT_L(8); PG8_BAR; PG8_WAIT_L(0); PG8_MMA(0, 0, At, B0); PG8_BAR; PG8_SCHED;
            PG8_LDB(B1, 1, 1); PG8_STAGE(PG8_SB(1, 0), b3, voffB);
            PG8_BAR; PG8_WAIT_L(0); PG8_MMA(0, 1, At, B1); PG8_BAR;
            PG8_LDA(At, 1, 1); PG8_STAGE(PG8_SA(1, 0), a3, voffA);
            PG8_BAR; PG8_WAIT_L(0); PG8_MMA(1, 0, At, B0); PG8_BAR; PG8_SCHED;
            PG8_STAGE(PG8_SB(1, 1), b3 + hstepB, voffB);
            PG8_WAIT_V(6); PG8_BAR; PG8_MMA(1, 1, At, B1); PG8_BAR;
            }
        }
        if constexpr (F8) asm volatile("s_nop 15\n\ts_nop 15" ::: "memory");
        if constexpr (ALIGN_EPI) { if (wr == 0) PG8_BAR; }
        if constexpr (!Epi::AFTER_DRAIN) { E(acc, cur, wr, wc, fr, fq); S.done(cur); }
        if (!has_next) break;
#pragma unroll
        for (int a = 0; a < 2; ++a)
#pragma unroll
            for (int b = 0; b < 2; ++b)
#pragma unroll
                for (int m = 0; m < 4; ++m)
#pragma unroll
                    for (int n = 0; n < 2; ++n) acc[a][b][m][n] = (f32x4){0.f, 0.f, 0.f, 0.f};
        cur = nxt; cA = nA; cB = nB; ++ui;
        if constexpr (ALIGN_EPI) { if (wr == 1) PG8_BAR; }
    }
    PG8_WAIT_V(0);
    if constexpr (!ALIGN_EPI) { if (wr == 0) PG8_BAR; }
    PG8_BAR;
    if constexpr (Epi::AFTER_DRAIN) { E.fused(acc, cur, wr, wc, fr, fq, lds, wid, lane); S.done(cur); }
#undef PG8_SA
#undef PG8_SB
#undef PG8_STAGE
#undef PG8_LDA
#undef PG8_LDB
#undef PG8_MMA
#undef PG8_SETB
#undef PG8_CAT8
#undef PG8_WAIT_V
#undef PG8_WAIT_L
#undef PG8_BAR
#undef PG8_SCHED
}
}

constexpr int NWAVES = 8, NTHR = NWAVES * 64;
constexpr int BATCH = 4, SEQ = 2048, DM = 2048, MTOK = BATCH * SEQ;
constexpr int A_IN = 20480, B_IN = 6144, NA1 = 14336;
constexpr float RMS_EPS = 1e-6f, LN_EPS = 1e-5f;
constexpr size_t MiB = 1u << 20;
constexpr size_t SZ_ACT = (size_t)MTOK * DM * 2;
constexpr size_t WS_WAIN = 2 * MiB;
constexpr size_t WS_WAOUT = WS_WAIN + 2 * (size_t)A_IN * DM * 2;
constexpr size_t WS_WBIN = WS_WAOUT + 2 * (size_t)DM * DM * 2;
constexpr size_t WS_WBOUT = WS_WBIN + 2 * (size_t)B_IN * DM * 2;
constexpr size_t WS_WM = WS_WBOUT + 2 * (size_t)DM * DM * 2;
constexpr size_t WS_COS = WS_WM + 2 * 16 * 128 * 128 * 2;
constexpr size_t WS_SIN = WS_COS + (size_t)MTOK * 16 * 4;
constexpr size_t WS_STATS = WS_SIN + (size_t)MTOK * 16 * 4;
constexpr size_t WS_LSE = WS_STATS + 2 * (size_t)MTOK * 2 * 4;
constexpr size_t WS_X = WS_LSE + 3 * (size_t)MTOK * 16 * 4;
constexpr size_t WS_XN = WS_X + 2 * SZ_ACT;
constexpr size_t WS_QK = WS_XN + SZ_ACT;
constexpr size_t WS_VT = WS_QK + 6 * SZ_ACT;
constexpr size_t WS_GATE = WS_VT + 3 * SZ_ACT;
constexpr size_t WS_OG = WS_GATE + SZ_ACT;
constexpr size_t WS_Y = WS_OG + 3 * SZ_ACT;
constexpr size_t WS_XN8 = WS_Y + SZ_ACT;
constexpr size_t WS_RSS = WS_XN8 + SZ_ACT / 2;
constexpr size_t WS_END = WS_RSS + 4 * (size_t)MTOK * 4;
constexpr size_t WS_BAR = 65536;
constexpr int LDS_BYTES = 147456;

typedef unsigned short bf16;
typedef unsigned v4u __attribute__((ext_vector_type(4)));
typedef unsigned v2u __attribute__((ext_vector_type(2)));
typedef float f32x4 __attribute__((ext_vector_type(4)));
typedef float f32x2v __attribute__((ext_vector_type(2)));
typedef float f32x16 __attribute__((ext_vector_type(16)));
typedef short bf16x8 __attribute__((ext_vector_type(8)));
typedef __bf16 bf16x2_t __attribute__((ext_vector_type(2)));
#define LAS __attribute__((address_space(3)))
#define MFMA32(a, b, c) __builtin_amdgcn_mfma_f32_32x32x16_bf16((a), (b), (c), 0, 0, 0)
__device__ __forceinline__ unsigned pk2(float lo, float hi) { f32x2v v = {lo, hi}; bf16x2_t b = __builtin_convertvector(v, bf16x2_t); return __builtin_bit_cast(unsigned, b); }
__device__ __forceinline__ float bflo(unsigned w) { return __builtin_bit_cast(float, w << 16); }
__device__ __forceinline__ float bfhi(unsigned w) { return __builtin_bit_cast(float, w & 0xffff0000u); }
__device__ __forceinline__ float wave_sum(float v) {
#pragma unroll
    for (int o = 1; o < 64; o <<= 1) v += __shfl_xor(v, o);
    return v;
}

#define XB_TMO      128
#define XB_XCNT(j)  (256  + 64 * (j))
#define XB_XSUB(j)  (1280 + 64 * (j))
#define XB_XGEN(j)  (2304 + 64 * (j))
#define XB_TOP      3328
#define XB_TOPGEN   3392
#define XCD_BAR_WORDS 3456
#define XB_SPIN_CAP (1u << 18)

__device__ __forceinline__ unsigned xb_ld(unsigned* p)              { return __hip_atomic_load(p, __ATOMIC_RELAXED, __HIP_MEMORY_SCOPE_AGENT); }
__device__ __forceinline__ unsigned xb_add(unsigned* p, unsigned v) { return __hip_atomic_fetch_add(p, v, __ATOMIC_RELAXED, __HIP_MEMORY_SCOPE_AGENT); }
__device__ __forceinline__ unsigned xb_xcc_id() { return (unsigned)__builtin_amdgcn_s_getreg((3 << 11) | 20) & 0xFu; }
#define XB_SPIN(cond, bar) do { unsigned _sp = 0; while (cond) { __builtin_amdgcn_s_sleep(1); \
    if ((++_sp & 255u) == 0u) { if (xb_ld(&(bar)[XB_TMO])) break; if (_sp > XB_SPIN_CAP) { atomicAdd(&(bar)[XB_TMO], 1u); break; } } } } while (0)

struct XcdBarrier {
    int w;
    unsigned* bar; unsigned x;
    volatile LAS unsigned* st;
};

__device__ __forceinline__ XcdBarrier xcd_barrier_post(unsigned* bar, volatile LAS unsigned* st, int w) {
    XcdBarrier b; b.w = w; b.bar = bar; b.x = xb_xcc_id(); b.st = st;
    if (w == 0 && lane_id() == 0) (void)xb_add(&bar[XB_XCNT(b.x)], 1u);
    return b;
}
__device__ __forceinline__ void xcd_barrier_complete(unsigned* bar, unsigned x, unsigned& nloc, unsigned& nx) {
    const unsigned G = gridDim.x * gridDim.y * gridDim.z;
    unsigned sum, cnt, mine, sp = 0u;
    for (;;) {
        sum = 0u; cnt = 0u; mine = 0u;
#pragma unroll
        for (unsigned j = 0; j < 16; ++j) { const unsigned c = xb_ld(&bar[XB_XCNT(j)]); sum += c; cnt += (c > 0u) ? 1u : 0u; mine = (j == x) ? c : mine; }
        if (sum == G) break;
        __builtin_amdgcn_s_sleep(1);
        if ((++sp & 255u) == 0u) { if (xb_ld(&bar[XB_TMO])) break; if (sp > XB_SPIN_CAP) { atomicAdd(&bar[XB_TMO], 1u); break; } }
    }
    nloc = mine > 0u ? mine : 1u; nx = cnt > 0u ? cnt : 1u;
}

__device__ __forceinline__ void xcd_barrier(const XcdBarrier& b) {
    asm volatile("s_waitcnt vmcnt(0)" ::: "memory");
    __syncthreads();
    if (b.w == 0 && lane_id() == 0) {
        unsigned* bar = b.bar;
        __builtin_amdgcn_s_waitcnt(0);
        unsigned nloc = b.st[0], nx = b.st[1];
        if (nloc == 0u) { xcd_barrier_complete(bar, b.x, nloc, nx); b.st[0] = nloc; b.st[1] = nx; }
        const unsigned old = xb_add(&bar[XB_XSUB(b.x)], 1u);
        const unsigned gen = old / nloc;
        if (old + 1u == (gen + 1u) * nloc) {
            __builtin_amdgcn_fence(__ATOMIC_RELEASE, "agent");
            asm volatile("s_waitcnt vmcnt(0)" ::: "memory");
            const unsigned og = xb_add(&bar[XB_TOP], 1u);
            const unsigned tg = og / nx;
            if (og + 1u == (tg + 1u) * nx) xb_add(&bar[XB_TOPGEN], 1u);
            else XB_SPIN(xb_ld(&bar[XB_TOPGEN]) == tg, bar);
            __builtin_amdgcn_fence(__ATOMIC_ACQUIRE, "agent");
            xb_add(&bar[XB_XGEN(b.x)], 1u);
            asm volatile("s_waitcnt vmcnt(0)" ::: "memory");
        } else {
            XB_SPIN(xb_ld(&bar[XB_XGEN(b.x)]) == gen, bar);
            __builtin_amdgcn_fence(__ATOMIC_ACQUIRE, "agent");
            asm volatile("s_waitcnt vmcnt(0)" ::: "memory");
        }
    }
    __syncthreads();
}

__device__ __forceinline__ int launder_s(int v) { asm volatile("" : "+s"(v)); return v; }
__device__ __forceinline__ int launder(int v) { asm volatile("" : "+v"(v)); return v; }
struct Args {
    const float* x; const int* pos; const float* a_norm_g; const float* a_w_in; const float* a_w_out; const float* b_norm_g; const float* b_w_in;
    const float* b_ln_g; const float* b_ln_b; const float* b_w_s; const float* b_b_s; const float* b_w_out; const float* final_g;
    float* out; unsigned char* ws; double invf[16];
    int ph_lo, ph_hi;
};

__device__ __forceinline__ void p0_transpose_item(const float* W, int K, int N, bf16* WT, int row_off, LAS float* scr, int kb, int nb, int lane) {
    const int k0 = 64 * kb, n0 = 32 * nb;
    float wv[32];
#pragma unroll
    for (int i = 0; i < 32; ++i) wv[i] = W[(size_t)(k0 + 2 * i + (lane >> 5)) * N + n0 + (lane & 31)];
#pragma unroll
    for (int i = 0; i < 32; ++i) scr[(2 * i + (lane >> 5)) * 33 + (lane & 31)] = wv[i];
    asm volatile("s_waitcnt lgkmcnt(0)" ::: "memory");
    const int c = lane & 7;
#pragma unroll
    for (int j = 0; j < 4; ++j) { const int n = (lane >> 3) + 8 * j; const LAS float* s = scr + (8 * c) * 33 + n;
        v4u o; o.x = pk2(s[0 * 33], s[1 * 33]); o.y = pk2(s[2 * 33], s[3 * 33]); o.z = pk2(s[4 * 33], s[5 * 33]); o.w = pk2(s[6 * 33], s[7 * 33]);
        *(v4u*)(WT + (size_t)(row_off + n0 + n) * K + k0 + 8 * c) = o; }
    asm volatile("s_waitcnt lgkmcnt(0)" ::: "memory");
}
constexpr float W8_SCALE = 32.0f;
__device__ __forceinline__ unsigned pk4_fp8(float a, float b, float c, float d) {
    a = fminf(fmaxf(a, -448.f), 448.f); b = fminf(fmaxf(b, -448.f), 448.f); c = fminf(fmaxf(c, -448.f), 448.f); d = fminf(fmaxf(d, -448.f), 448.f);
    int w = 0; w = __builtin_amdgcn_cvt_pk_fp8_f32(a, b, w, false); w = __builtin_amdgcn_cvt_pk_fp8_f32(c, d, w, true); return (unsigned)w; }
__device__ __forceinline__ void p0_transpose_item_f8(const float* W, int K, int N, unsigned char* WT, int row_off, LAS float* scr, int kb, int nb, int lane) {
    const int k0 = 64 * kb, n0 = 32 * nb;
    float wv[32];
#pragma unroll
    for (int i = 0; i < 32; ++i) wv[i] = W[(size_t)(k0 + 2 * i + (lane >> 5)) * N + n0 + (lane & 31)];
#pragma unroll
    for (int i = 0; i < 32; ++i) scr[(2 * i + (lane >> 5)) * 33 + (lane & 31)] = wv[i] * W8_SCALE;
    asm volatile("s_waitcnt lgkmcnt(0)" ::: "memory");
    const int c = lane & 7;
#pragma unroll
    for (int j = 0; j < 4; ++j) { const int n = (lane >> 3) + 8 * j; const LAS float* s = scr + (8 * c) * 33 + n;
        v2u o; o.x = pk4_fp8(s[0 * 33], s[1 * 33], s[2 * 33], s[3 * 33]); o.y = pk4_fp8(s[4 * 33], s[5 * 33], s[6 * 33], s[7 * 33]);
        *(v2u*)(WT + (size_t)(row_off + n0 + n) * K + k0 + 8 * c) = o; }
    asm volatile("s_waitcnt lgkmcnt(0)" ::: "memory");
}
template <bool OB16, bool OF32, bool OF8> __device__ __forceinline__ void rms_row(const float* xrow, const float* g, bf16* o16, float* o32, unsigned char* o8, int lane) {
    const f32x4* xr = (const f32x4*)xrow + lane; const f32x4* gr = (const f32x4*)g + lane;
    f32x4 v[8]; float s = 0.f;
#pragma unroll
    for (int j = 0; j < 8; ++j) { v[j] = xr[64 * j]; s += (v[j].x * v[j].x + v[j].y * v[j].y) + (v[j].z * v[j].z + v[j].w * v[j].w); }
    const float rstd = 1.0f / sqrtf(wave_sum(s) * (1.0f / DM) + RMS_EPS);
#pragma unroll
    for (int j = 0; j < 8; ++j) { const f32x4 gg = gr[64 * j]; const f32x4 y = v[j] * rstd * gg;
        if (OF32) ((f32x4*)o32 + lane)[64 * j] = y;
        if (OF8) ((unsigned*)o8 + lane)[64 * j] = pk4_fp8(y.x, y.y, y.z, y.w);
        if (OB16) { v2u w; w.x = pk2(y.x, y.y); w.y = pk2(y.z, y.w); ((v2u*)o16 + lane)[64 * j] = w; } }
}

constexpr float C2S = 0.08838834764831845f * 1.4426950408889634f;
constexpr int ATT_KP = 144, ATT_VP = 80;
constexpr int ATT_KB = 32 * ATT_KP, ATT_VB = 128 * ATT_VP, ATT_BUF = ATT_KB + ATT_VB;
__device__ __forceinline__ bf16x8 f8x8_to_bf16x8(v2u w) {
    const f32x2v a = __builtin_amdgcn_cvt_pk_f32_fp8((int)w.x, false), b = __builtin_amdgcn_cvt_pk_f32_fp8((int)w.x, true), c = __builtin_amdgcn_cvt_pk_f32_fp8((int)w.y, false), d = __builtin_amdgcn_cvt_pk_f32_fp8((int)w.y, true);
    v4u o; o.x = pk2(a.x, a.y); o.y = pk2(b.x, b.y); o.z = pk2(c.x, c.y); o.w = pk2(d.x, d.y); return __builtin_bit_cast(bf16x8, o); }
struct AttPair { unsigned uq, uk, uv, orow; int j0, g; };
__device__ __forceinline__ AttPair att_decode(int pi, int grp, int qw) {
    AttPair d; const int uid = 2 * pi + grp, g = 2 - (uid >> 10), rest = uid & 1023, blk = rest & 15, h = (rest >> 4) & 15, b = rest >> 8;
    const int dsh = 2 * g; const bool has_prev = (blk & ((16 >> dsh) - 1)) != 0;
    d.j0 = __builtin_amdgcn_readfirstlane(has_prev ? 0 : 4); d.g = __builtin_amdgcn_readfirstlane(g);
    d.uq = __builtin_amdgcn_readfirstlane((unsigned)((((g * 2 + 0) * 4 + b) * 16 + h) * 2048 + blk * 128 + qw * 32) * 128u);
    d.uk = __builtin_amdgcn_readfirstlane((unsigned)((((g * 2 + 1) * 4 + b) * 16 + h) * 2048 + blk * 128 - 128) * 128u);
    d.uv = __builtin_amdgcn_readfirstlane((unsigned)(g * 2048 * 8192 + (b * 64 + blk * 4 - 4) * 65536 + h * 128 * 32) * 2u);
    d.orow = __builtin_amdgcn_readfirstlane((unsigned)(((g * 4 + b) * 16 + h) * 2048 + blk * 128 + qw * 32));
    return d;
}
__device__ __forceinline__ void attn_phase(const bf16* QK, const bf16* VT, bf16* OG, float* LSE, int bx, int G, int wave, int lane, LAS unsigned char* lds) {
    const int q = lane & 31, hh = lane >> 5, grp = wave >> 2, qw = wave & 3;
    const int kperm = (q & 0x13) | ((q & 4) << 1) | ((q & 8) >> 1);
    const char* QKc = (const char*)QK; const char* VTc = (const char*)VT;
    LAS unsigned char* gl = lds + grp * (2 * ATT_BUF);
    const int L2 = (qw * 64 + lane) * 2, L1 = qw * 64 + lane;
    const unsigned kw0 = (unsigned)((L1 >> 3) * ATT_KP + (L1 & 7) * 16);
    const unsigned vw0 = (unsigned)(ATT_KB + (L2 >> 2) * ATT_VP + (L2 & 3) * 16), vw1 = (unsigned)(ATT_KB + ((L2 + 1) >> 2) * ATT_VP + ((L2 + 1) & 3) * 16);
    const unsigned kr = (unsigned)(kperm * ATT_KP + 8 * hh), vr = (unsigned)(ATT_KB + q * ATT_VP + 16 * hh);
    const unsigned lqo = (unsigned)(q * 128 + 8 * hh);
    int pi = bx; if (pi >= 1536) return;
    v4u st[4][3]; long qf[8], qn[8];
#define ATT_FETCH(P, J, D) do { const char* kp_ = QKc + ((P).uk + (unsigned)(J) * 4096u + (unsigned)L1 * 16u); const char* vp_ = VTc + ((P).uv + (unsigned)(J) * 131072u + (unsigned)L2 * 16u); \
            D[0] = *(const v4u*)kp_; D[1] = *(const v4u*)vp_; D[2] = *(const v4u*)(vp_ + 16); } while (0)
#define ATT_PARK(J, D) do { LAS unsigned char* wb_ = gl + ((J) & 1) * ATT_BUF; *(LAS v4u*)(wb_ + kw0) = D[0]; *(LAS v4u*)(wb_ + vw0) = D[1]; *(LAS v4u*)(wb_ + vw1) = D[2]; } while (0)
#define ATT_LDQ(P, D) do { const char* qp_ = QKc + ((P).uq + lqo); _Pragma("unroll") for (int c = 0; c < 8; ++c) D[c] = *(const long*)(qp_ + 16 * c); } while (0)
    AttPair cur = att_decode(pi, grp, qw);
    ATT_LDQ(cur, qf);
    ATT_FETCH(cur, cur.j0, st[0]); ATT_FETCH(cur, cur.j0 + 1, st[1]); ATT_FETCH(cur, cur.j0 + 2, st[2]); ATT_FETCH(cur, cur.j0 + 3, st[3]);
    ATT_PARK(0, st[0]);
    asm volatile("s_waitcnt lgkmcnt(0)\n\ts_barrier" ::: "memory");
    for (;;) {
        const bool has_next = pi + G < 1536;
        AttPair nxt = cur; if (has_next) nxt = att_decode(pi + G, grp, qw);
        const int j0 = cur.j0;
        f32x16 O[4];
#pragma unroll
        for (int db = 0; db < 4; ++db)
#pragma unroll
            for (int i = 0; i < 16; ++i) O[db][i] = 0.f;
        float m = -INFINITY, l = 0.f;
#pragma unroll
        for (int j = 0; j < 8; ++j) {
            if (j < 4 && cur.g == 2) continue;
            if (j < 4) { if (j0 == 0) ATT_FETCH(cur, j + 4, st[j & 3]); }
            else if (has_next) { ATT_FETCH(nxt, nxt.j0 + (j - 4), st[j & 3]); if (j == 4) ATT_LDQ(nxt, qn); }
            const int t = j - qw;
            if (j >= j0 && t >= 0 && t <= 4) {
                const LAS unsigned char* rb = gl + (j & 1) * ATT_BUF;
                f32x16 S;
#pragma unroll
                for (int i = 0; i < 16; ++i) S[i] = 0.f;
                long kf[8]; bf16x8 vf[4][2];
#pragma unroll
                for (int c = 0; c < 8; ++c) kf[c] = *(const LAS long*)(rb + kr + 16 * c);
#pragma unroll
                for (int db = 0; db < 4; ++db) { vf[db][0] = *(const LAS bf16x8*)(rb + vr + db * 32 * ATT_VP); vf[db][1] = *(const LAS bf16x8*)(rb + vr + db * 32 * ATT_VP + 32); }
                __builtin_amdgcn_sched_barrier(0);
#pragma unroll
                for (int c = 0; c < 8; ++c) S = __builtin_amdgcn_mfma_f32_32x32x16_fp8_fp8(kf[c], qf[c], S, 0, 0, 0);
                if (t == 0) {
#pragma unroll
                    for (int i = 0; i < 16; ++i) { const int kt = 16 * (i >> 3) + 8 * hh + (i & 7); if (kt < q) S[i] = -INFINITY; }
                }
                if (t == 4) {
#pragma unroll
                    for (int i = 0; i < 16; ++i) { const int kt = 16 * (i >> 3) + 8 * hh + (i & 7); if (kt > q) S[i] = -INFINITY; }
                }
                float mx = S[0];
#pragma unroll
                for (int i = 1; i < 16; ++i) mx = fmaxf(mx, S[i]);
                mx = fmaxf(mx, __shfl_xor(mx, 32)) * C2S;
                if (__builtin_amdgcn_ballot_w64(mx > m + 8.0f) != 0ull) { const float mn = fmaxf(m, mx), alpha = __builtin_amdgcn_exp2f(m - mn); l *= alpha; m = mn;
#pragma unroll
                    for (int db = 0; db < 4; ++db)
#pragma unroll
                        for (int i = 0; i < 16; ++i) O[db][i] *= alpha; }
                float rs = 0.f;
#pragma unroll
                for (int i = 0; i < 16; ++i) { S[i] = __builtin_amdgcn_exp2f(__builtin_fmaf(S[i], C2S, -m)); rs += S[i]; }
                l += rs;
                v4u w0, w1;
                w0.x = pk2(S[0], S[1]); w0.y = pk2(S[2], S[3]); w0.z = pk2(S[4], S[5]); w0.w = pk2(S[6], S[7]);
                w1.x = pk2(S[8], S[9]); w1.y = pk2(S[10], S[11]); w1.z = pk2(S[12], S[13]); w1.w = pk2(S[14], S[15]);
                const bf16x8 ps0 = __builtin_bit_cast(bf16x8, w0), ps1 = __builtin_bit_cast(bf16x8, w1);
#pragma unroll
                for (int db = 0; db < 4; ++db) { O[db] = MFMA32(vf[db][0], ps0, O[db]); O[db] = MFMA32(vf[db][1], ps1, O[db]); }
            }
            if (j < 7) { if (j + 1 >= j0 + 1) ATT_PARK(j + 1, st[(j + 1) & 3]); }
            else if (has_next) ATT_PARK(0, st[0]);
            asm volatile("s_waitcnt lgkmcnt(0)\n\ts_barrier" ::: "memory");
        }
        l += __shfl_xor(l, 32);
        const float inv = 1.0f / l, lse2 = m + __builtin_amdgcn_logf(l);
        { LAS unsigned char* ob = lds + 61440 + wave * (32 * 272);
#pragma unroll
          for (int db = 0; db < 4; ++db)
#pragma unroll
              for (int i4 = 0; i4 < 4; ++i4) { v2u w; w.x = pk2(O[db][4 * i4] * inv, O[db][4 * i4 + 1] * inv); w.y = pk2(O[db][4 * i4 + 2] * inv, O[db][4 * i4 + 3] * inv);
                  *(LAS v2u*)(ob + q * 272 + (db * 32 + 8 * i4 + 4 * hh) * 2) = w; }
          asm volatile("s_waitcnt lgkmcnt(0)" ::: "memory");
          __attribute__((address_space(1))) unsigned char* og = (__attribute__((address_space(1))) unsigned char*)OG + (size_t)cur.orow * 256;
          const unsigned lo = (unsigned)((lane >> 4) * 256 + (lane & 15) * 16), li = (unsigned)((lane >> 4) * 272 + (lane & 15) * 16);
#pragma unroll
          for (int k = 0; k < 8; ++k) { const v4u x = *(const LAS v4u*)(ob + li + k * (4 * 272)); *(__attribute__((address_space(1))) v4u*)(og + (lo + (unsigned)k * 1024u)) = x; }
          asm volatile("s_waitcnt lgkmcnt(0)" ::: "memory"); }
        if (hh == 0) LSE[cur.orow + q] = lse2;
        if (!has_next) break;
        cur = nxt; pi += G;
#pragma unroll
        for (int c = 0; c < 8; ++c) qf[c] = qn[c];
    }
#undef ATT_FETCH
#undef ATT_PARK
#undef ATT_LDQ
}
__device__ __forceinline__ void merge_phase(const bf16* OG, const float* LSE, const bf16* GATE, bf16* Y, int gw, int NGW, int lane) {
    for (int row = gw; row < MTOK; row += NGW) { const int b = row >> 11, s = row & 2047;
#pragma unroll
        for (int j = 0; j < 4; ++j) { const int col = lane * 8 + 512 * j, h = col >> 7, e = col & 127;
            size_t r[3]; float lg[3];
#pragma unroll
            for (int g = 0; g < 3; ++g) { const int dsh = 2 * g, p = ((s & ((1 << dsh) - 1)) << (11 - dsh)) | (s >> dsh); r[g] = ((size_t)(g * 4 + b) * 16 + h) * 2048 + p; lg[g] = LSE[r[g]]; }
            const float mx = fmaxf(lg[0], fmaxf(lg[1], lg[2]));
            float w0 = __builtin_amdgcn_exp2f(lg[0] - mx), w1 = __builtin_amdgcn_exp2f(lg[1] - mx), w2 = __builtin_amdgcn_exp2f(lg[2] - mx);
            const float inv = 1.0f / (w0 + w1 + w2); w0 *= inv; w1 *= inv; w2 *= inv;
            const v4u a = *(const v4u*)(OG + r[0] * 128 + e), bb = *(const v4u*)(OG + r[1] * 128 + e), c = *(const v4u*)(OG + r[2] * 128 + e), gt = *(const v4u*)(GATE + (size_t)row * 2048 + col);
            v4u o;
#pragma unroll
            for (int k = 0; k < 4; ++k) {
                const float ylo = (w0 * bflo(a[k]) + w1 * bflo(bb[k]) + w2 * bflo(c[k])) * bflo(gt[k]);
                const float yhi = (w0 * bfhi(a[k]) + w1 * bfhi(bb[k]) + w2 * bfhi(c[k])) * bfhi(gt[k]);
                o[k] = pk2(ylo, yhi); }
            *(v4u*)(Y + (size_t)row * 2048 + col) = o; }
    }
}
__device__ __forceinline__ void sgu_phase(const bf16* VTB, const float* STATS, const float* LNG, const float* LNB, const bf16* WM, const float* BS, const bf16* U, const bf16* ZS, bf16* Y,
                                          int gw, int NGW, int lane, LAS unsigned char* wl) {
    const int r = lane & 31, hh = lane >> 5;
    for (int wu = gw; wu < 4096; wu += NGW) {
        const int cblk = wu & 3, g = (wu >> 2) & 15, chunk = (wu >> 6) & 15, b = wu >> 10;
        const int ch = g * 128 + cblk * 32 + r, tok0 = b * 2048 + chunk * 128;
        v4u raw[8];
#pragma unroll
        for (int ks = 0; ks < 8; ++ks) raw[ks] = *(const v4u*)(VTB + (size_t)((tok0 + 16 * ks) >> 5) * 65536 + (size_t)ch * 32 + ((16 * ks) & 31) + 8 * hh);
        v4u ur[4][2], zr[4][2]; float bs[4];
        { const __attribute__((address_space(1))) unsigned char* ub = (const __attribute__((address_space(1))) unsigned char*)U + ((size_t)tok0 * 2048 + g * 128 + cblk * 32) * 2;
          const __attribute__((address_space(1))) unsigned char* zb = (const __attribute__((address_space(1))) unsigned char*)ZS + ((size_t)tok0 * 2048 + g * 128 + cblk * 32) * 2;
          const unsigned lo = (unsigned)((lane >> 2) * 4096 + (lane & 3) * 16);
#pragma unroll
          for (int tb = 0; tb < 4; ++tb) { bs[tb] = BS[g * 128 + tb * 32 + r];
#pragma unroll
              for (int k = 0; k < 2; ++k) { ur[tb][k] = *(const __attribute__((address_space(1))) v4u*)(ub + (lo + (unsigned)(tb * 32 + k * 16) * 4096u)); zr[tb][k] = *(const __attribute__((address_space(1))) v4u*)(zb + (lo + (unsigned)(tb * 32 + k * 16) * 4096u)); } } }
        const float lng = LNG[ch], lnb = LNB[ch];
        bf16x8 af[8];
#pragma unroll
        for (int ks = 0; ks < 8; ++ks) { v4u o; const f32x4* sp = (const f32x4*)(STATS + 2 * (size_t)(tok0 + 16 * ks + 8 * hh));
#pragma unroll
            for (int k = 0; k < 4; ++k) { const f32x4 sv = sp[k];
                const float mu0 = sv.x * (1.0f / 2048), mu1 = sv.z * (1.0f / 2048);
                const float a0 = lng * __builtin_amdgcn_rsqf(fmaxf(sv.y * (1.0f / 2048) - mu0 * mu0, 0.f) + LN_EPS), a1 = lng * __builtin_amdgcn_rsqf(fmaxf(sv.w * (1.0f / 2048) - mu1 * mu1, 0.f) + LN_EPS);
                o[k] = pk2(bflo(raw[ks][k]) * a0 + (lnb - mu0 * a0), bfhi(raw[ks][k]) * a1 + (lnb - mu1 * a1)); }
            af[ks] = __builtin_bit_cast(bf16x8, o); }
        bf16x8 wf[2][8];
        { const bf16* wp = WM + (size_t)(g * 128 + r) * 128 + 8 * hh; wf[0][0] = *(const bf16x8*)wp; wf[0][1] = *(const bf16x8*)(wp + 16); }
#pragma unroll
        for (int tb = 0; tb < 4; ++tb) {
            f32x16 D;
#pragma unroll
            for (int i = 0; i < 16; ++i) D[i] = 0.f;
#pragma unroll
            for (int ks = 0; ks < 2 * tb + 2; ++ks) D = MFMA32(af[ks], wf[tb & 1][ks], D);
            __builtin_amdgcn_sched_barrier(0);
            if (tb < 3) { const bf16* wp = WM + (size_t)(g * 128 + (tb + 1) * 32 + r) * 128 + 8 * hh;
#pragma unroll
                for (int ks = 0; ks < 2 * tb + 4; ++ks) wf[(tb + 1) & 1][ks] = *(const bf16x8*)(wp + 16 * ks); }
            __builtin_amdgcn_sched_barrier(0);
            { const unsigned li = (unsigned)((lane >> 2) * 80 + (lane & 3) * 16);
#pragma unroll
              for (int k = 0; k < 2; ++k) { *(LAS v4u*)(wl + 2560 + li + k * (16 * 80)) = ur[tb][k]; *(LAS v4u*)(wl + 5120 + li + k * (16 * 80)) = zr[tb][k]; } }
            asm volatile("s_waitcnt lgkmcnt(0)" ::: "memory");
            v2u uq4[4], zq4[4];
#pragma unroll
            for (int i4 = 0; i4 < 4; ++i4) { uq4[i4] = *(const LAS v2u*)(wl + 2560 + r * 80 + (8 * i4 + 4 * hh) * 2); zq4[i4] = *(const LAS v2u*)(wl + 5120 + r * 80 + (8 * i4 + 4 * hh) * 2); }
            asm volatile("s_waitcnt lgkmcnt(0)" ::: "memory");
#pragma unroll
            for (int i4 = 0; i4 < 4; ++i4) { const v2u u4 = uq4[i4], z4 = zq4[i4];
                v2u w; w.x = pk2(bflo(u4.x) * (D[4 * i4] + bs[tb]) * bflo(z4.x), bfhi(u4.x) * (D[4 * i4 + 1] + bs[tb]) * bfhi(z4.x));
                w.y = pk2(bflo(u4.y) * (D[4 * i4 + 2] + bs[tb]) * bflo(z4.y), bfhi(u4.y) * (D[4 * i4 + 3] + bs[tb]) * bfhi(z4.y));
                *(LAS v2u*)(wl + r * 80 + (8 * i4 + 4 * hh) * 2) = w; }
            asm volatile("s_waitcnt lgkmcnt(0)" ::: "memory");
            { __attribute__((address_space(1))) unsigned char* yb = (__attribute__((address_space(1))) unsigned char*)Y + ((size_t)(tok0 + tb * 32) * 2048 + g * 128 + cblk * 32) * 2;
              const unsigned lo = (unsigned)((lane >> 2) * 4096 + (lane & 3) * 16), li = (unsigned)((lane >> 2) * 80 + (lane & 3) * 16);
#pragma unroll
              for (int k = 0; k < 2; ++k) { const v4u x = *(const LAS v4u*)(wl + li + k * (16 * 80)); *(__attribute__((address_space(1))) v4u*)(yb + (lo + (unsigned)k * 65536u)) = x; } }
            asm volatile("s_waitcnt lgkmcnt(0)" ::: "memory");
        }
    }
}

constexpr int N_PHASES = 19;
__global__ void __launch_bounds__(NTHR) trunk_fwd(Args args) {
    extern __shared__ __attribute__((aligned(16))) unsigned char lds[];
    const int wave = __builtin_amdgcn_readfirstlane(threadIdx.x >> 6);
#define tid (wave * 64 + lane_id())
#define lane lane_id()
    const int G = gridDim.x, bx = blockIdx.x;
    const int gw = bx * NWAVES + wave, NGW = G * NWAVES;
    unsigned char* ws = args.ws;
#define WS_PTRS unsigned char* wl_ = ws; asm volatile("" : "+s"(wl_)); bf16* WAin = (bf16*)(wl_ + WS_WAIN); bf16* WAout = (bf16*)(wl_ + WS_WAOUT); bf16* WBin = (bf16*)(wl_ + WS_WBIN); bf16* WBout = (bf16*)(wl_ + WS_WBOUT); bf16* WM = (bf16*)(wl_ + WS_WM); float* COS = (float*)(wl_ + WS_COS); float* SIN = (float*)(wl_ + WS_SIN); float* STATS = (float*)(wl_ + WS_STATS); float* LSE = (float*)(wl_ + WS_LSE); float* X = (float*)(wl_ + WS_X); bf16* XN = (bf16*)(wl_ + WS_XN); bf16* QK = (bf16*)(wl_ + WS_QK); bf16* VT = (bf16*)(wl_ + WS_VT); bf16* GATE = (bf16*)(wl_ + WS_GATE); bf16* OG = (bf16*)(wl_ + WS_OG); bf16* Y = (bf16*)(wl_ + WS_Y); bf16* U = OG; bf16* ZS = OG + (size_t)MTOK * 2048; unsigned char* XN8 = wl_ + WS_XN8; float* RSS = (float*)(wl_ + WS_RSS); (void)RSS; (void)WAin; (void)WAout; (void)WBin; (void)WBout; (void)WM; (void)COS; (void)SIN; (void)STATS; (void)LSE; (void)X; (void)XN; (void)QK; (void)VT; (void)GATE; (void)OG; (void)Y; (void)U; (void)ZS; (void)XN8;
    const int lo = args.ph_lo, hi = args.ph_hi; (void)lo; (void)hi;
#if MK_PER_PHASE
#define IN(k) (lo <= (k) && (k) < hi)
#else
#define IN(k) true
#endif
    volatile LAS unsigned* MISC = (volatile LAS unsigned*)((LAS unsigned char*)lds + 131072 + 320);
    if (tid < 32) MISC[tid] = 0u;
    unsigned* barw = (unsigned*)(ws + WS_BAR);
#if !MK_PER_PHASE
    if (bx == 0) for (int i = tid; i < XCD_BAR_WORDS; i += NTHR) __hip_atomic_store(barw + i, 0u, __ATOMIC_RELAXED, __HIP_MEMORY_SCOPE_AGENT);
#endif
    __syncthreads();
    XcdBarrier xbar; xbar.w = wave; xbar.bar = barw; xbar.x = 0; xbar.st = MISC + 8;
#if MK_PER_PHASE
#define SEAM(k) do { } while (0)
#else
#define SEAM(k) do { if (IN(k) && IN((k) + 1)) xcd_barrier(xbar); } while (0)
#endif
    if (IN(0)) { WS_PTRS
        LAS float* scr = (LAS float*)((LAS unsigned char*)lds + wave * 16384);
        constexpr int I_AIN = 32 * (A_IN / 32), I_SQ = 32 * (DM / 32), I_BIN = 32 * (B_IN / 32);
        constexpr int NITEMS = 2 * (I_AIN + I_SQ + I_BIN + I_SQ);
        for (int it = gw; it < NITEMS; it += NGW) {
            int r = it; const int j = r / (NITEMS / 2); r -= j * (NITEMS / 2);
            if (r < I_AIN) { const int nblk = A_IN / 32, kb = r / nblk, nb = r % nblk, sb = (nb * 32) / 2048;
                unsigned char* W8 = (unsigned char*)WAin + (size_t)j * A_IN * DM * 2; bf16* W16 = (bf16*)(W8 + 48 * MiB);
                const float* src = args.a_w_in + (size_t)j * DM * A_IN;
                if (sb < 9 && (sb % 3) < 2) p0_transpose_item_f8(src, DM, A_IN, W8, (2 * (sb / 3) + (sb % 3) - sb) * 2048, scr, kb, nb, lane);
                else if (A_VG_FP8 && !(A_GATE_BF16 && sb == 9)) p0_transpose_item_f8(src, DM, A_IN, W8, ((sb == 9 ? 6 : 7 + sb / 3) - sb) * 2048, scr, kb, nb, lane);
                else p0_transpose_item(src, DM, A_IN, W16, ((sb == 9 ? 0 : 1 + sb / 3) - sb) * 2048, scr, kb, nb, lane);
                continue; } r -= I_AIN;
            if (r < I_SQ) { p0_transpose_item(args.a_w_out + (size_t)j * DM * DM, DM, DM, WAout + (size_t)j * DM * DM, 0, scr, r / (DM / 32), r % (DM / 32), lane); continue; } r -= I_SQ;
            if (r < I_BIN) { const int nblk = B_IN / 32, kb = r / nblk, nb = r % nblk, sb = (nb * 32) / 2048;
                const int db = sb == 0 ? 0 : (sb == 1 ? 2 : 1);
                p0_transpose_item(args.b_w_in + (size_t)j * DM * B_IN, DM, B_IN, WBin + (size_t)j * B_IN * DM, (db - sb) * 2048, scr, kb, nb, lane); continue; } r -= I_BIN;
            p0_transpose_item(args.b_w_out + (size_t)j * DM * DM, DM, DM, WBout + (size_t)j * DM * DM, 0, scr, r / (DM / 32), r % (DM / 32), lane);
        }
        const int gt = bx * NTHR + tid, NGT = G * NTHR;
        for (int i = gt; i < 2 * 16 * 128 * 128 / 2; i += NGT) { const int e = 2 * i, s = e & 127, t = (e >> 7) & 127;
            const f32x2v w = *(const f32x2v*)(args.b_w_s + e); ((unsigned*)WM)[i] = pk2(s <= t ? w.x : 0.f, s + 1 <= t ? w.y : 0.f); }
        for (int i = gt; i < MTOK * 16; i += NGT) { const int tok = i >> 4, f = i & 15; const double rev = (double)args.pos[tok] * args.invf[f]; const float fr = (float)(rev - floor(rev));
            COS[i] = __builtin_amdgcn_cosf(fr); SIN[i] = __builtin_amdgcn_sinf(fr); }
        for (int i = gt; i < 2 * MTOK * 2; i += NGT) STATS[i] = 0.f;
        for (int i = gt; i < 4 * MTOK; i += NGT) RSS[i] = i < MTOK ? 2048.0f * (1.0f - 1e-6f) : 0.f;
        for (int m = gw; m < MTOK; m += NGW) rms_row<(!A_VG_FP8 || A_GATE_BF16), false, true>(args.x + (size_t)m * DM, args.a_norm_g, XN + (size_t)m * DM, nullptr, XN8 + (size_t)m * DM, lane);
    }
#if !MK_PER_PHASE
    cg::this_grid().sync();
    xbar = xcd_barrier_post(barw, MISC + 8, wave);
#endif
    for (int rep = 0; rep < 2; ++rep) {
        const int P = 1 + 9 * rep;
        if (IN(P)) { WS_PTRS
            const char* W8 = (const char*)WAin + (size_t)rep * A_IN * DM * 2;
            const float* rssA = RSS + (size_t)(2 * rep) * MTOK;
            const pg8::EpiA1 e1{QK, GATE, COS, SIN, 1.0f / W8_SCALE, 0, rssA};
#if A_VG_FP8 && A_GATE_BF16
            { pg8::MultiOrder S{{(const char*)XN8, W8, 32, 48, 1}, {W8 + (size_t)14336 * DM, (const char*)XN8, 8, 32, 1}, {W8 + (size_t)16384 * DM, (const char*)XN8, 8, 32, 4},
                                {W8 + (size_t)18432 * DM, (const char*)XN8, 8, 32, 16}, 4, launder_s(G), launder_s(bx), DM};
              pg8::EpiAllA E{e1, pg8::EpiPlain{VT, 1.0f / W8_SCALE, rssA, 0}, 1};
              pg8::gemm_phase<pg8::EpiAllA, pg8::MultiOrder, true, true, true>((LAS unsigned char*)lds, DM, S, E, wave); }
            { const char* W16 = W8 + 48 * MiB;
              pg8::MultiOrder S{{(const char*)XN, W16, 32, 8, 1}, {nullptr, nullptr, 0, 0, 1}, {nullptr, nullptr, 0, 0, 1}, {nullptr, nullptr, 0, 0, 1}, 1, launder_s(G), launder_s(bx), DM * 2};
              const pg8::EpiA1 eg{QK, GATE, COS, SIN, 1.0f, 48, rssA};
              pg8::gemm_phase<pg8::EpiA1, pg8::MultiOrder, true, true, false>((LAS unsigned char*)lds, DM, S, eg, wave); }
#elif A_VG_FP8
            pg8::MultiOrder S{{(const char*)XN8, W8, 32, 56, 1}, {W8 + (size_t)14336 * DM, (const char*)XN8, 8, 32, 1}, {W8 + (size_t)16384 * DM, (const char*)XN8, 8, 32, 4},
                              {W8 + (size_t)18432 * DM, (const char*)XN8, 8, 32, 16}, 4, launder_s(G), launder_s(bx), DM};
            pg8::EpiAllA E{e1, pg8::EpiPlain{VT, 1.0f / W8_SCALE, rssA, 0}, 1};
            pg8::gemm_phase<pg8::EpiAllA, pg8::MultiOrder, true, true, true>((LAS unsigned char*)lds, DM, S, E, wave);
#else
            { pg8::MultiOrder S{{(const char*)XN8, W8, 32, 48, 1}, {nullptr, nullptr, 0, 0, 1}, {nullptr, nullptr, 0, 0, 1}, {nullptr, nullptr, 0, 0, 1}, 1, launder_s(G), launder_s(bx), DM};
              pg8::gemm_phase<pg8::EpiA1, pg8::MultiOrder, true, true, true>((LAS unsigned char*)lds, DM, S, e1, wave); }
            { const char* W16 = W8 + 48 * MiB;
              pg8::MultiOrder S{{(const char*)XN, W16, 32, 8, 1}, {W16 + (size_t)2048 * DM * 2, (const char*)XN, 8, 32, 1}, {W16 + (size_t)4096 * DM * 2, (const char*)XN, 8, 32, 4},
                                {W16 + (size_t)6144 * DM * 2, (const char*)XN, 8, 32, 16}, 4, launder_s(G), launder_s(bx), DM * 2};
              pg8::EpiAllA E{pg8::EpiA1{QK, GATE, COS, SIN, 1.0f, 48, rssA}, pg8::EpiPlain{VT, 1.0f, rssA, 0}, 1};
              pg8::gemm_phase<pg8::EpiAllA, pg8::MultiOrder, true, true, false>((LAS unsigned char*)lds, DM, S, E, wave); }
#endif
        }
        SEAM(P);
        if (IN(P + 1)) { WS_PTRS attn_phase(QK, VT, OG, LSE, bx, G, wave, launder(lane), (LAS unsigned char*)lds); }
        SEAM(P + 1);
        if (IN(P + 2)) { WS_PTRS merge_phase(OG, LSE, GATE, Y, gw, NGW, launder(lane)); }
        SEAM(P + 2);
        if (IN(P + 3)) { WS_PTRS pg8::MultiOrder S{{(const char*)Y, (const char*)(WAout + (size_t)rep * DM * DM), 32, 8, 1}, {nullptr, nullptr, 0, 0, 1}, {nullptr, nullptr, 0, 0, 1}, {nullptr, nullptr, 0, 0, 1}, 1, launder_s(G), launder_s(bx), DM * 2};
            pg8::EpiOut E{rep == 0 ? args.x : X, X, args.b_norm_g + (size_t)rep * DM, XN, nullptr, RSS + (size_t)(2 * rep + 1) * MTOK};
            pg8::gemm_phase<pg8::EpiOut, pg8::MultiOrder, true, true>((LAS unsigned char*)lds, DM, S, E, wave); }
        SEAM(P + 3);
        if (IN(P + 5)) { WS_PTRS
            const char* W = (const char*)(WBin + (size_t)rep * B_IN * DM);
            pg8::MultiOrder S{{(const char*)XN, W, 32, 16, 1}, {W + (size_t)4096 * DM * 2, (const char*)XN, 8, 32, 1}, {nullptr, nullptr, 0, 0, 1}, {nullptr, nullptr, 0, 0, 1}, 2, launder_s(G), launder_s(bx), DM * 2};
            const float* rssB = RSS + (size_t)(2 * rep + 1) * MTOK;
            pg8::EpiAllB E{pg8::EpiB1{U, ZS, rssB}, pg8::EpiB2{VT, STATS + (size_t)rep * MTOK * 2, rssB}};
            pg8::gemm_phase<pg8::EpiAllB, pg8::MultiOrder, true, true>((LAS unsigned char*)lds, DM, S, E, wave);
        }
        SEAM(P + 5);
        if (IN(P + 6)) { WS_PTRS sgu_phase(VT, STATS + (size_t)rep * MTOK * 2, args.b_ln_g + (size_t)rep * DM, args.b_ln_b + (size_t)rep * DM, WM + (size_t)rep * 16 * 128 * 128, args.b_b_s + (size_t)rep * 16 * 128, U, ZS, Y, gw, NGW, launder(lane), (LAS unsigned char*)lds + wave * 8192); }
        SEAM(P + 6);
        if (IN(P + 7)) { WS_PTRS pg8::MultiOrder S{{(const char*)Y, (const char*)(WBout + (size_t)rep * DM * DM), 32, 8, 1}, {nullptr, nullptr, 0, 0, 1}, {nullptr, nullptr, 0, 0, 1}, {nullptr, nullptr, 0, 0, 1}, 1, launder_s(G), launder_s(bx), DM * 2};
            pg8::EpiOut E{X, X, rep == 0 ? args.a_norm_g + DM : nullptr, XN, XN8, RSS + (size_t)2 * MTOK};
            pg8::gemm_phase<pg8::EpiOut, pg8::MultiOrder, true, true>((LAS unsigned char*)lds, DM, S, E, wave); }
        if (rep == 1) SEAM(P + 7);
        if (IN(P + 8)) { WS_PTRS const int ln = launder(lane);
            if (rep == 1) { for (int m = gw; m < MTOK; m += NGW) rms_row<false, true, false>(X + (size_t)m * DM, args.final_g, nullptr, args.out + (size_t)m * DM, nullptr, ln); }
        }
        if (rep == 0) SEAM(P + 8);
    }
#undef IN
#undef SEAM
#undef tid
#undef lane
}

extern "C" void kernel_launch(void* const* d_in, const int* in_sizes, int n_in, void* d_out, int out_size, void* d_ws, size_t ws_size, hipStream_t stream) {
    static int grid = 0;
    if (grid == 0) {
        if (n_in != 13 || in_sizes[0] != MTOK * DM || out_size != MTOK * DM || ws_size < WS_END) { fprintf(stderr, "kernel_launch: unexpected shapes / workspace (n_in %d, in0 %d, out %d, ws %zu, need %zu)\n", n_in, n_in > 0 ? in_sizes[0] : -1, out_size, ws_size, (size_t)WS_END); grid = -1; return; }
        int dev = 0, cus = 0, per_cu = 0;
        if (hipGetDevice(&dev) != hipSuccess || hipDeviceGetAttribute(&cus, hipDeviceAttributeMultiprocessorCount, dev) != hipSuccess) { grid = -1; return; }
        if (hipFuncSetAttribute((const void*)trunk_fwd, hipFuncAttributeMaxDynamicSharedMemorySize, LDS_BYTES) != hipSuccess) { fprintf(stderr, "kernel_launch: hipFuncSetAttribute failed\n"); grid = -1; return; }
        if (hipOccupancyMaxActiveBlocksPerMultiprocessor(&per_cu, (const void*)trunk_fwd, NTHR, LDS_BYTES) != hipSuccess || per_cu < 1) { fprintf(stderr, "kernel_launch: occupancy query failed (%d)\n", per_cu); (void)hipGetLastError(); grid = -1; return; }
        grid = cus * per_cu;
    }
    if (grid < 0) return;
    Args a{};
    a.x = (const float*)d_in[0]; a.pos = (const int*)d_in[1]; a.a_norm_g = (const float*)d_in[2]; a.a_w_in = (const float*)d_in[3]; a.a_w_out = (const float*)d_in[4];
    a.b_norm_g = (const float*)d_in[5]; a.b_w_in = (const float*)d_in[6]; a.b_ln_g = (const float*)d_in[7]; a.b_ln_b = (const float*)d_in[8]; a.b_w_s = (const float*)d_in[9];
    a.b_b_s = (const float*)d_in[10]; a.b_w_out = (const float*)d_in[11]; a.final_g = (const float*)d_in[12];
    a.out = (float*)d_out; a.ws = (unsigned char*)d_ws;
    for (int i = 0; i < 16; ++i) a.invf[i] = pow(500000.0, -(double)i / 16.0) / 6.283185307179586476925;
#if MK_PER_PHASE
    for (int p = 0; p < N_PHASES; ++p) { a.ph_lo = p; a.ph_hi = p + 1; hipLaunchKernelGGL(trunk_fwd, dim3(grid), dim3(NTHR), LDS_BYTES, stream, a); }
#else
    a.ph_lo = 0; a.ph_hi = N_PHASES;
    void* kargs[] = {&a};
    const hipError_t e = hipLaunchCooperativeKernel((const void*)trunk_fwd, dim3(grid), dim3(NTHR), kargs, LDS_BYTES, stream);
    if (e != hipSuccess) fprintf(stderr, "kernel_launch: cooperative launch failed: %s (grid %d)\n", hipGetErrorString(e), grid);
#endif
}
```

```cpp
#include <hip/hip_runtime.h>
#include <hip/hip_cooperative_groups.h>
#include <cstdio>
#include <cstdint>
#include <cmath>
namespace cg = cooperative_groups;
#ifndef A_VG_FP8
#define A_VG_FP8 1
#endif
#ifndef A_GATE_BF16
#define A_GATE_BF16 1
#endif
#ifndef MK_PER_PHASE
#define MK_PER_PHASE 0
#endif
__device__ __forceinline__ int lane_id() { int l; asm volatile("v_mbcnt_lo_u32_b32 %0, -1, 0\n\tv_mbcnt_hi_u32_b32 %0, -1, %0" : "=v"(l)); return l; }
namespace pg8 {
#define PG8_LAS __attribute__((address_space(3)))
typedef unsigned short bf16_t;
typedef short bf16x8 __attribute__((ext_vector_type(8)));
typedef float f32x4 __attribute__((ext_vector_type(4)));
typedef unsigned u32x4 __attribute__((ext_vector_type(4)));
typedef int i32x4 __attribute__((ext_vector_type(4)));
constexpr int BM = 256, BK = 64, HALF = 128, HTB = HALF * BK * 2  , STAGE_BYTES = 8 * HTB, NXCD = 8, WGM = 8;

__host__ __device__ __forceinline__ int lds_byte(int r, int c) { const int st = (r >> 4) * 2 + (c >> 5), rr = r & 15, cc = c & 31, ob = rr * 64 + cc * 2; return st * 1024 + (ob ^ (((ob >> 9) & 1) << 5)); }
__host__ __device__ __forceinline__ void stage_rc(int b, int& R, int& C) { const int st = b / 1024, sb = b % 1024, swz = sb ^ (((sb >> 9) & 1) << 5); R = (st >> 1) * 16 + swz / 64; C = (st & 1) * 32 + (swz % 64) / 2; }
__host__ __device__ __forceinline__ int perm32(int rho) { const int n = rho >> 4, i = rho & 15; return 8 * (i >> 2) + 4 * n + (i & 3); }

struct Unit { int pm, pn, k; };
struct Prob { const char* A; const char* B; int nM, nN, bdil; };
struct StaticOrder {
    int nM, nN, nwg, G, c;
    __host__ __device__ void init(int M, int N, int G_, int c_) { nM = M / BM; nN = N / BM; nwg = nM * nN; G = G_; c = c_; }
    __host__ __device__ bool next(int i, Unit& u) const {
        const long L = (long)i * G + c; if (L >= nwg) return false;
        int wgid = (int)L; { const int q = nwg / NXCD, r = nwg % NXCD, xcd = wgid % NXCD, off = wgid / NXCD; wgid = (xcd < r ? xcd * (q + 1) : r * (q + 1) + (xcd - r) * q) + off; }
        const int nig = WGM * nN, gid = wgid / nig, fm = gid * WGM, gsz = (nM - fm) < WGM ? (nM - fm) : WGM;
        u.pm = fm + ((wgid % nig) % gsz); u.pn = (wgid % nig) / gsz; return true;
    }
    __device__ __forceinline__ void a_ready(const Unit&) const {}
    __device__ __forceinline__ void done(const Unit&) const {}
};
struct MultiOrder {
    Prob p0, p1, p2, p3; int np, G, c, rowbytes;
    __device__ __forceinline__ static void map(const Prob& P, int wgid, Unit& u) {
        const int nM = P.nM, nN = P.nN, nwg = nM * nN;
        { const int q = nwg / NXCD, r = nwg % NXCD, xcd = wgid % NXCD, off = wgid / NXCD; wgid = (xcd < r ? xcd * (q + 1) : r * (q + 1) + (xcd - r) * q) + off; }
        const int nig = WGM * nN, gid = wgid / nig, fm = gid * WGM, gsz = (nM - fm) < WGM ? (nM - fm) : WGM;
        u.pm = fm + ((wgid % nig) % gsz); u.pn = (wgid % nig) / gsz;
    }
    __device__ __forceinline__ bool next(int i, Unit& u) const {
        long L = (long)i * G + c;
        { const int n = p0.nM * p0.nN; if (L < n) { map(p0, (int)L, u); u.k = 0; return true; } L -= n; }
        if (np > 1) { const int n = p1.nM * p1.nN; if (L < n) { map(p1, (int)L, u); u.k = 1; return true; } L -= n; }
        if (np > 2) { const int n = p2.nM * p2.nN; if (L < n) { map(p2, (int)L, u); u.k = 2; return true; } L -= n; }
        if (np > 3) { const int n = p3.nM * p3.nN; if (L < n) { map(p3, (int)L, u); u.k = 3; return true; } L -= n; }
        return false;
    }
    __device__ __forceinline__ const char* selA(int k) const { return k == 0 ? p0.A : (k == 1 ? p1.A : (k == 2 ? p2.A : p3.A)); }
    __device__ __forceinline__ const char* selB(int k) const { return k == 0 ? p0.B : (k == 1 ? p1.B : (k == 2 ? p2.B : p3.B)); }
    __device__ __forceinline__ int bdil(const Unit& u) const { return u.k == 0 ? p0.bdil : (u.k == 1 ? p1.bdil : (u.k == 2 ? p2.bdil : p3.bdil)); }
    __device__ __forceinline__ const char* a_base(const Unit& u) const { return selA(u.k) + (size_t)u.pm * 256 * rowbytes; }
    __device__ __forceinline__ const char* b_base(const Unit& u) const { const int d = bdil(u), t8 = u.pn & 7; const int r = (u.pn >> 3) * 2048 + (d == 1 ? 256 * t8 : (d == 4 ? 1024 * (t8 & 1) + (t8 >> 1) : 2 * t8)); return selB(u.k) + (size_t)r * rowbytes; }
    __device__ __forceinline__ void a_ready(const Unit&) const {}
    __device__ __forceinline__ void done(const Unit&) const {}
};


__device__ __forceinline__ unsigned cvt_pk_bf16(float lo, float hi) { unsigned r; asm volatile("v_cvt_pk_bf16_f32 %0, %1, %2" : "=v"(r) : "v"(lo), "v"(hi)); return r; }
typedef float f32x2 __attribute__((ext_vector_type(2)));
__device__ __forceinline__ f32x2 gelu_pk(f32x2 v) {
    const f32x2 av = __builtin_elementwise_abs(v), d = av * 0.2316418882f + 1.0f;
    f32x2 t; t.x = __builtin_amdgcn_rcpf(d.x); t.y = __builtin_amdgcn_rcpf(d.y);
    f32x2 q = t * 0.5307027145f + (-0.7265760135f); q = q * t + 0.7107068705f; q = q * t + (-0.142248368f); q = q * t + 0.127414796f; q = q * t;
    const f32x2 s = (v * v) * (-0.72134752044f);
    f32x2 e; e.x = __builtin_amdgcn_exp2f(s.x); e.y = __builtin_amdgcn_exp2f(s.y);
    const f32x2 m = v * (q * e), r = v - m;
    f32x2 o; o.x = v.x < 0.f ? m.x : r.x; o.y = v.y < 0.f ? m.y : r.y; return o;
}

constexpr float C2 = 0.08838834764831845f * 1.4426950408889634f;
__device__ __forceinline__ float silu_f(float x) { return x * __builtin_amdgcn_rcpf(1.0f + __builtin_amdgcn_exp2f(-1.4426950408889634f * x)); }
__device__ __forceinline__ u32x4 pack8(const f32x4& v0, const f32x4& v1) { u32x4 w; w.x = cvt_pk_bf16(v0[0], v0[1]); w.y = cvt_pk_bf16(v0[2], v0[3]); w.z = cvt_pk_bf16(v1[0], v1[1]); w.w = cvt_pk_bf16(v1[2], v1[3]); return w; }
__device__ __forceinline__ void gelu8(f32x4& v0, f32x4& v1) { f32x2 a = gelu_pk((f32x2){v0[0], v0[1]}), b = gelu_pk((f32x2){v0[2], v0[3]}), c = gelu_pk((f32x2){v1[0], v1[1]}), d = gelu_pk((f32x2){v1[2], v1[3]});
    v0 = (f32x4){a.x, a.y, b.x, b.y}; v1 = (f32x4){c.x, c.y, d.x, d.y}; }

struct EpiA1 {
    static constexpr bool PERM = true, AFTER_DRAIN = false;
    bf16_t* QK; bf16_t* GATE; const float* COS; const float* SIN; float osc; int pn0; const float* rss;
    __device__ __forceinline__ void operator()(const f32x4 (&acc)[2][2][4][2], const Unit& u, int wr, int wc, int fr, int fq) const {
        const int pn = u.pn + pn0; const int rowb = u.pm * BM + wr * 64 + fr;
        if (pn >= 48) {
            const int col0 = (pn - 48) * 256 + wc * 32 + 8 * fq;
#pragma unroll
            for (int ai = 0; ai < 2; ++ai)
#pragma unroll
                for (int m = 0; m < 4; ++m) { bf16_t* rowp = GATE + (size_t)(rowb + ai * HALF + m * 16) * 2048 + col0; const float rs = osc * __builtin_amdgcn_rsqf(rss[rowb + ai * HALF + m * 16] * (1.0f / 2048) + 1e-6f);
#pragma unroll
                    for (int bj = 0; bj < 2; ++bj) { f32x4 v0 = acc[ai][bj][m][0] * rs, v1 = acc[ai][bj][m][1] * rs;
#pragma unroll
                        for (int i = 0; i < 4; ++i) { v0[i] = silu_f(v0[i]); v1[i] = silu_f(v1[i]); }
                        *(u32x4*)(rowp + bj * HALF) = pack8(v0, v1); } }
        } else {
            const int g = pn >> 4, qk = (pn >> 3) & 1, hp = pn & 7, dsh = 2 * g, dm1 = (1 << dsh) - 1;
            const float sc = osc; const float sgn = fq < 2 ? -1.0f : 1.0f; const int e0 = wc * 32 + 8 * fq;
#pragma unroll
            for (int ai = 0; ai < 2; ++ai)
#pragma unroll
                for (int m = 0; m < 4; ++m) { const int row = rowb + ai * HALF + m * 16, b = row >> 11, s = row & 2047, p = ((s & dm1) << (11 - dsh)) | (s >> dsh);
                    f32x4 c0, c1, s0, s1; const float scr = sc * __builtin_amdgcn_rsqf(rss[row] * (1.0f / 2048) + 1e-6f);
                    if (wc == 0) { const float* cp = COS + (size_t)row * 16 + 8 * (fq & 1); const float* sp = SIN + (size_t)row * 16 + 8 * (fq & 1);
                        c0 = *(const f32x4*)cp; c1 = *(const f32x4*)(cp + 4); s0 = *(const f32x4*)sp; s1 = *(const f32x4*)(sp + 4);
                        }
#pragma unroll
                    for (int bj = 0; bj < 2; ++bj) { f32x4 v0 = acc[ai][bj][m][0], v1 = acc[ai][bj][m][1];
                        if (wc == 0) {
#pragma unroll
                            for (int i = 0; i < 4; ++i) { const float p0 = __shfl_xor(v0[i], 32), p1 = __shfl_xor(v1[i], 32);
                                v0[i] = v0[i] * c0[i] + sgn * p0 * s0[i]; v1[i] = v1[i] * c1[i] + sgn * p1 * s1[i]; } }
                        v0 = v0 * scr; v1 = v1 * scr;
                        unsigned char* dst = (unsigned char*)QK + ((((size_t)((g * 2 + qk) * 4 + b) * 16 + (2 * hp + bj)) * 2048 + p) * 128 + e0);
                        int w0 = 0, w1 = 0; w0 = __builtin_amdgcn_cvt_pk_fp8_f32(v0[0], v0[1], w0, false); w0 = __builtin_amdgcn_cvt_pk_fp8_f32(v0[2], v0[3], w0, true);
                        w1 = __builtin_amdgcn_cvt_pk_fp8_f32(v1[0], v1[1], w1, false); w1 = __builtin_amdgcn_cvt_pk_fp8_f32(v1[2], v1[3], w1, true);
                        *(unsigned long long*)dst = ((unsigned long long)(unsigned)w1 << 32) | (unsigned)w0; } }
        }
    }
};
struct EpiB1 {
    static constexpr bool PERM = true, AFTER_DRAIN = false;
    bf16_t* U; bf16_t* ZS; const float* rss;
    __device__ __forceinline__ void operator()(const f32x4 (&acc)[2][2][4][2], const Unit& u, int wr, int wc, int fr, int fq) const {
        const int pn = u.pn; const int rowb = u.pm * BM + wr * 64 + fr; const bool isz = pn >= 8;
        bf16_t* base = isz ? ZS : U; const int col0 = (pn & 7) * 256 + wc * 32 + 8 * fq;
#pragma unroll
        for (int ai = 0; ai < 2; ++ai)
#pragma unroll
            for (int m = 0; m < 4; ++m) { bf16_t* rowp = base + (size_t)(rowb + ai * HALF + m * 16) * 2048 + col0; const float rs = __builtin_amdgcn_rsqf(rss[rowb + ai * HALF + m * 16] * (1.0f / 2048) + 1e-6f);
#pragma unroll
                for (int bj = 0; bj < 2; ++bj) { f32x4 v0 = acc[ai][bj][m][0] * rs, v1 = acc[ai][bj][m][1] * rs;
                    if (isz) {
#pragma unroll
                        for (int i = 0; i < 4; ++i) { v0[i] = silu_f(v0[i]); v1[i] = silu_f(v1[i]); }
                    } else gelu8(v0, v1);
                    *(u32x4*)(rowp + bj * HALF) = pack8(v0, v1); } }
    }
};
struct EpiPlain {
    static constexpr bool PERM = true, AFTER_DRAIN = false;
    bf16_t* O; float osc; const float* rss; int dsh;
    __device__ __forceinline__ void operator()(const f32x4 (&acc)[2][2][4][2], const Unit& u, int wr, int wc, int fr, int fq) const {
        const int rowb = u.pm * BM + wr * 64 + fr; const int col0 = u.pn * BM + wc * 32 + 8 * fq;
#pragma unroll
        for (int bj = 0; bj < 2; ++bj) { const int c = col0 + bj * HALF, p = c & 2047, Lm1 = (2048 >> dsh) - 1; const float* rp = rss + (c & ~2047) + ((p & Lm1) << dsh) + (p >> (11 - dsh));
            f32x4 r0, r1;
#pragma unroll
            for (int k = 0; k < 4; ++k) { r0[k] = osc * __builtin_amdgcn_rsqf(rp[k << dsh] * (1.0f / 2048) + 1e-6f); r1[k] = osc * __builtin_amdgcn_rsqf(rp[(k + 4) << dsh] * (1.0f / 2048) + 1e-6f); }
#pragma unroll
            for (int ai = 0; ai < 2; ++ai)
#pragma unroll
                for (int m = 0; m < 4; ++m) { bf16_t* rowp = O + (size_t)((c >> 5)) * 65536 + (size_t)(rowb + ai * HALF + m * 16) * 32 + (c & 31);
                    *(u32x4*)rowp = pack8(acc[ai][bj][m][0] * r0, acc[ai][bj][m][1] * r1); } }
    }
};
struct EpiB2 {
    static constexpr bool PERM = true, AFTER_DRAIN = false;
    bf16_t* VT; float* STATS; const float* rss;
    __device__ __forceinline__ static float row16_sum(float v) {
        v += __builtin_bit_cast(float, __builtin_amdgcn_update_dpp(0, __builtin_bit_cast(int, v), 0xB1, 0xf, 0xf, true));
        v += __builtin_bit_cast(float, __builtin_amdgcn_update_dpp(0, __builtin_bit_cast(int, v), 0x4E, 0xf, 0xf, true));
        v += __builtin_bit_cast(float, __builtin_amdgcn_update_dpp(0, __builtin_bit_cast(int, v), 0x141, 0xf, 0xf, true));
        v += __builtin_bit_cast(float, __builtin_amdgcn_update_dpp(0, __builtin_bit_cast(int, v), 0x140, 0xf, 0xf, true));
        return v; }
    __device__ __forceinline__ void operator()(const f32x4 (&acc)[2][2][4][2], const Unit& u, int wr, int wc, int fr, int fq) const {
        const int rowb = u.pm * BM + wr * 64 + fr; const int col0 = u.pn * BM + wc * 32 + 8 * fq;
#pragma unroll
        for (int bj = 0; bj < 2; ++bj) {
            float s1[8], s2[8]; f32x4 r0 = *(const f32x4*)(rss + col0 + bj * HALF), r1 = *(const f32x4*)(rss + col0 + bj * HALF + 4);
#pragma unroll
            for (int k = 0; k < 4; ++k) { r0[k] = __builtin_amdgcn_rsqf(r0[k] * (1.0f / 2048) + 1e-6f); r1[k] = __builtin_amdgcn_rsqf(r1[k] * (1.0f / 2048) + 1e-6f); }
#pragma unroll
            for (int k = 0; k < 8; ++k) { s1[k] = 0.f; s2[k] = 0.f; }
#pragma unroll
            for (int ai = 0; ai < 2; ++ai)
#pragma unroll
                for (int m = 0; m < 4; ++m) { bf16_t* rowp = VT + (size_t)((col0 >> 5) + 4 * bj) * 65536 + (size_t)(rowb + ai * HALF + m * 16) * 32 + (col0 & 31);
                    f32x4 v0 = acc[ai][bj][m][0] * r0, v1 = acc[ai][bj][m][1] * r1; gelu8(v0, v1);
#pragma unroll
                    for (int i = 0; i < 4; ++i) { s1[i] += v0[i]; s2[i] += v0[i] * v0[i]; s1[4 + i] += v1[i]; s2[4 + i] += v1[i] * v1[i]; }
                    *(u32x4*)rowp = pack8(v0, v1); }
#pragma unroll
            for (int k = 0; k < 8; ++k) { const float a = row16_sum(s1[k]), b = row16_sum(s2[k]);
                if (fr == 0) { float* sp = STATS + 2 * (size_t)(col0 + bj * HALF + k); atomicAdd(sp, a); atomicAdd(sp + 1, b); } }
            asm volatile("" ::: "memory");
        }
    }
};
struct EpiAllA {
    static constexpr bool PERM = true, AFTER_DRAIN = false;
    EpiA1 e1; EpiPlain ev; int kv0;
    __device__ __forceinline__ void operator()(const f32x4 (&acc)[2][2][4][2], const Unit& u, int wr, int wc, int fr, int fq) const {
        if (u.k < kv0) e1(acc, u, wr, wc, fr, fq);
        else { EpiPlain e = ev; e.O += (size_t)(u.k - kv0) * 2048 * 8192; e.dsh = 2 * (u.k - kv0); e(acc, u, wr, wc, fr, fq); }
    }
};
struct EpiAllB {
    static constexpr bool PERM = true, AFTER_DRAIN = false;
    EpiB1 e1; EpiB2 e2;
    __device__ __forceinline__ void operator()(const f32x4 (&acc)[2][2][4][2], const Unit& u, int wr, int wc, int fr, int fq) const {
        if (u.k == 0) e1(acc, u, wr, wc, fr, fq); else e2(acc, u, wr, wc, fr, fq);
    }
};
struct EpiOut {
    static constexpr bool PERM = true, AFTER_DRAIN = false;
    const float* base; float* out; const float* gn; bf16_t* xb; unsigned char* x8; float* rss;
    __device__ __forceinline__ void operator()(const f32x4 (&acc)[2][2][4][2], const Unit& u, int wr, int wc, int fr, int fq) const {
        const int rowb = u.pm * BM + wr * 64 + fr; const int col0 = u.pn * BM + wc * 32 + 8 * fq;
        f32x4 gv[2][2];
        if (gn) {
#pragma unroll
            for (int bj = 0; bj < 2; ++bj)
#pragma unroll
                for (int n = 0; n < 2; ++n) gv[bj][n] = *(const f32x4*)(gn + col0 + bj * HALF + n * 4); }
#pragma unroll
        for (int ai = 0; ai < 2; ++ai)
#pragma unroll
            for (int m = 0; m < 4; ++m) { const int row = rowb + ai * HALF + m * 16; const size_t off = (size_t)row * 2048 + col0; float ss = 0.f;
#pragma unroll
                for (int bj = 0; bj < 2; ++bj) { const f32x4 b0 = *(const f32x4*)(base + off + bj * HALF), b1 = *(const f32x4*)(base + off + bj * HALF + 4);
                    const f32x4 x0 = b0 + acc[ai][bj][m][0], x1 = b1 + acc[ai][bj][m][1];
                    *(f32x4*)(out + off + bj * HALF) = x0; *(f32x4*)(out + off + bj * HALF + 4) = x1;
                    if (gn) { ss += ((x0[0] * x0[0] + x0[1] * x0[1]) + (x0[2] * x0[2] + x0[3] * x0[3])) + ((x1[0] * x1[0] + x1[1] * x1[1]) + (x1[2] * x1[2] + x1[3] * x1[3]));
                        const f32x4 y0 = x0 * gv[bj][0], y1 = x1 * gv[bj][1];
                        *(u32x4*)(xb + off + bj * HALF) = pack8(y0, y1);
                        if (x8) { int w0 = 0, w1 = 0; w0 = __builtin_amdgcn_cvt_pk_fp8_f32(y0[0], y0[1], w0, false); w0 = __builtin_amdgcn_cvt_pk_fp8_f32(y0[2], y0[3], w0, true);
                            w1 = __builtin_amdgcn_cvt_pk_fp8_f32(y1[0], y1[1], w1, false); w1 = __builtin_amdgcn_cvt_pk_fp8_f32(y1[2], y1[3], w1, true);
                            *(unsigned long long*)(x8 + off + bj * HALF) = ((unsigned long long)(unsigned)w1 << 32) | (unsigned)w0; } } }
                if (gn) { ss += __shfl_xor(ss, 16); ss += __shfl_xor(ss, 32); if (fq == 0) atomicAdd(rss + row, ss); } }
    }
};
template <class Epi, class Sched, bool ALIGN_EPI = false, bool SP2 = false, bool F8 = false>
__device__ __forceinline__ void gemm_phase(PG8_LAS unsigned char* lds, const int Kel, const Sched& S, const Epi& E, const int wave_) {
    const int tid = wave_ * 64 + ::lane_id(); const int wid = __builtin_amdgcn_readfirstlane(tid >> 6), lane = tid & 63, wr = wid >> 2, wc = wid & 3, fr = lane & 15, fq = lane >> 4;
    const int K = F8 ? Kel / 2 : Kel, nt = K / BK;
    unsigned voffA[2], voffB[2]; size_t hstepB;
#pragma unroll
    for (int i = 0; i < 2; ++i) { int R, C; stage_rc(tid * 16 + i * 8192, R, C); voffA[i] = (unsigned)(R * K + C) * 2u; }
#define PG8_SETB(dil) do { const int d_ = (dil); _Pragma("unroll") for (int i = 0; i < 2; ++i) { int R, C; stage_rc(tid * 16 + i * 8192, R, C); const int Rb = Epi::PERM ? ((R & ~31) + perm32(R & 31)) : R; \
        voffB[i] = (unsigned)(Rb * d_ * K + C) * 2u; } hstepB = (d_ == 16) ? (size_t)K * 2 : (size_t)HALF * d_ * K * 2; } while (0)
    const size_t kstep = (size_t)(BK * 2);
    const size_t hstep = (size_t)HALF * K * 2;
    const size_t tstep = 2 * hstep;
    const unsigned ldsw = (unsigned)wid * 1024u;
    const int aoff = lds_byte(wr * 64 + fr, fq * 8), boff = lds_byte(wc * 32 + fr, fq * 8);
#define PG8_SA(b, h) (((b) * 2 + (h)) * HTB)
#define PG8_SB(b, h) ((4 + (b) * 2 + (h)) * HTB)
#define PG8_STAGE(bufoff, gbase, voff) do { _Pragma("unroll") for (int _i = 0; _i < 2; ++_i) \
        __builtin_amdgcn_global_load_lds((const unsigned*)((const char*)(gbase) + (voff)[_i]), (PG8_LAS unsigned*)(lds + (bufoff) + ldsw + _i * 8192), 16, 0, 0); } while (0)
#define PG8_LDA(dst, b, h) do { _Pragma("unroll") for (int m = 0; m < 4; ++m) _Pragma("unroll") for (int k = 0; k < 2; ++k) dst[m][k] = *(const PG8_LAS bf16x8*)(lds + PG8_SA(b, h) + aoff + m * 2048 + k * 1024); } while (0)
#define PG8_LDB(dst, b, h) do { _Pragma("unroll") for (int n = 0; n < 2; ++n) _Pragma("unroll") for (int k = 0; k < 2; ++k) dst[n][k] = *(const PG8_LAS bf16x8*)(lds + PG8_SB(b, h) + boff + n * 2048 + k * 1024); } while (0)
#define PG8_CAT8(x) __builtin_shufflevector(__builtin_bit_cast(i32x4, (x)[0]), __builtin_bit_cast(i32x4, (x)[1]), 0, 1, 2, 3, 4, 5, 6, 7)
#define PG8_MMA(ai, bj, At, Bt) do { __builtin_amdgcn_s_setprio(1); \
        if constexpr (F8) { _Pragma("unroll") for (int m = 0; m < 4; ++m) _Pragma("unroll") for (int n = 0; n < 2; ++n) \
            asm volatile("v_mfma_f32_16x16x128_f8f6f4 %0, %1, %2, %0" : "+v"(acc[ai][bj][m][n]) : "v"(PG8_CAT8(Bt[n])), "v"(PG8_CAT8(At[m]))); } \
        else { _Pragma("unroll") for (int m = 0; m < 4; ++m) _Pragma("unroll") for (int n = 0; n < 2; ++n) _Pragma("unroll") for (int k = 0; k < 2; ++k) \
            acc[ai][bj][m][n] = __builtin_amdgcn_mfma_f32_16x16x32_bf16(Bt[n][k], At[m][k], acc[ai][bj][m][n], 0, 0, 0); } \
        __builtin_amdgcn_s_setprio(0); } while (0)
#define PG8_WAIT_V(n) asm volatile("s_waitcnt vmcnt(" #n ")" ::: "memory")
#define PG8_WAIT_L(n) asm volatile("s_waitcnt lgkmcnt(" #n ")" ::: "memory")
#define PG8_BAR __builtin_amdgcn_s_barrier()
#define PG8_SCHED __builtin_amdgcn_sched_barrier(0)
    Unit cur, nxt; int ui = 0;
    if (!S.next(0, cur)) return;
    f32x4 acc[2][2][4][2];
#pragma unroll
    for (int a = 0; a < 2; ++a)
#pragma unroll
        for (int b = 0; b < 2; ++b)
#pragma unroll
            for (int m = 0; m < 4; ++m)
#pragma unroll
                for (int n = 0; n < 2; ++n) acc[a][b][m][n] = (f32x4){0.f, 0.f, 0.f, 0.f};
    bf16x8 At[4][2], B0[2][2], B1[2][2];
    const char* cA = S.a_base(cur); const char* cB = S.b_base(cur); PG8_SETB(S.bdil(cur));
    S.a_ready(cur);
    if constexpr (SP2) {
        PG8_STAGE(PG8_SB(0, 0), cB, voffB); PG8_STAGE(PG8_SB(0, 1), cB + hstepB, voffB); PG8_STAGE(PG8_SA(0, 0), cA, voffA); PG8_STAGE(PG8_SA(0, 1), cA + hstep, voffA);
        if (wr == 1) PG8_BAR;
        PG8_WAIT_V(2); PG8_BAR;
        PG8_STAGE(PG8_SB(1, 0), cB + kstep, voffB); PG8_STAGE(PG8_SA(1, 0), cA + kstep, voffA); PG8_STAGE(PG8_SB(1, 1), cB + hstepB + kstep, voffB);
        PG8_WAIT_V(6); PG8_BAR;
    } else {
        PG8_STAGE(PG8_SB(0, 0), cB, voffB); PG8_STAGE(PG8_SA(0, 0), cA, voffA); PG8_STAGE(PG8_SB(0, 1), cB + hstepB, voffB); PG8_STAGE(PG8_SA(0, 1), cA + hstep, voffA);
        if (wr == 1) PG8_BAR;
        PG8_WAIT_V(4); PG8_BAR;
        PG8_STAGE(PG8_SB(1, 0), cB + kstep, voffB); PG8_STAGE(PG8_SA(1, 0), cA + kstep, voffA); PG8_STAGE(PG8_SB(1, 1), cB + hstepB + kstep, voffB);
        PG8_WAIT_V(6); PG8_BAR;
    }
    for (;;) {
        const bool has_next = S.next(ui + 1, nxt);
        const char* nA = has_next ? S.a_base(nxt) : cA; const char* nB = has_next ? S.b_base(nxt) : cB;
        for (int t = 0; t < nt; t += 2) {
            const bool last = (t == nt - 2);
            const char* a1 = cA + (size_t)(t + 1) * kstep;
            const char* a2 = last ? nA : cA + (size_t)(t + 2) * kstep; const char* b2 = last ? nB : cB + (size_t)(t + 2) * kstep;
            const char* a3 = a2 + kstep; const char* b3 = b2 + kstep;
            if (last && has_next) { S.a_ready(nxt); PG8_SETB(S.bdil(nxt)); }
            if constexpr (SP2) {
            PG8_LDB(B0, 0, 0); PG8_LDB(B1, 0, 1); PG8_SCHED; PG8_LDA(At, 0, 0); PG8_STAGE(PG8_SA(1, 1), a1 + hstep, voffA);
            PG8_WAIT_V(8); PG8_WAIT_L(0); PG8_BAR; PG8_MMA(0, 0, At, B0); PG8_MMA(0, 1, At, B1); PG8_BAR; PG8_SCHED;
            PG8_LDA(At, 0, 1); PG8_STAGE(PG8_SB(0, 0), b2, voffB); PG8_STAGE(PG8_SB(0, 1), b2 + hstepB, voffB); PG8_STAGE(PG8_SA(0, 0), a2, voffA);
            PG8_WAIT_V(8); PG8_WAIT_L(0); PG8_BAR; PG8_MMA(1, 0, At, B0); PG8_MMA(1, 1, At, B1); PG8_BAR; PG8_SCHED;
            PG8_LDB(B0, 1, 0); PG8_LDB(B1, 1, 1); PG8_SCHED; PG8_LDA(At, 1, 0); PG8_STAGE(PG8_SA(0, 1), a2 + hstep, voffA);
            PG8_WAIT_V(8); PG8_WAIT_L(0); PG8_BAR; PG8_MMA(0, 0, At, B0); PG8_MMA(0, 1, At, B1); PG8_BAR; PG8_SCHED;
            PG8_LDA(At, 1, 1); PG8_STAGE(PG8_SB(1, 0), b3, voffB); PG8_STAGE(PG8_SB(1, 1), b3 + hstepB, voffB); PG8_STAGE(PG8_SA(1, 0), a3, voffA);
            PG8_WAIT_V(8); PG8_WAIT_L(0); PG8_BAR; PG8_MMA(1, 0, At, B0); PG8_MMA(1, 1, At, B1); PG8_BAR; PG8_SCHED;
            } else {
            PG8_LDB(B0, 0, 0); PG8_SCHED; PG8_LDA(At, 0, 0); PG8_STAGE(PG8_SA(1, 1), a1 + hstep, voffA);
            PG8_WAIT_L(8); PG8_BAR; PG8_WAIT_L(0); PG8_MMA(0, 0, At, B0); PG8_BAR; PG8_SCHED;
            PG8_LDB(B1, 0, 1); PG8_STAGE(PG8_SB(0, 0), b2, voffB);
            PG8_BAR; PG8_WAIT_L(0); PG8_MMA(0, 1, At, B1); PG8_BAR;
            PG8_LDA(At, 0, 1); PG8_STAGE(PG8_SA(0, 0), a2, voffA);
            PG8_BAR; PG8_WAIT_L(0); PG8_MMA(1, 0, At, B0); PG8_BAR; PG8_SCHED;
            PG8_STAGE(PG8_SB(0, 1), b2 + hstepB, voffB);
            PG8_WAIT_V(6); PG8_BAR; PG8_MMA(1, 1, At, B1); PG8_BAR;
            PG8_LDB(B0, 1, 0); PG8_SCHED; PG8_LDA(At, 1, 0); PG8_STAGE(PG8_SA(0, 1), a2 + hstep, voffA);
            PG8_WAIT_L(8); PG8_BAR; PG8_WAIT_L(0); PG8_MMA(0, 0, At, B0); PG8_BAR; PG8_SCHED;
            PG8_LDB(B1, 1, 1); PG8_STAGE(PG8_SB(1, 0), b3, voffB);
            PG8_BAR; PG8_WAIT_L(0); PG8_MMA(0, 1, At, B1); PG8_BAR;
            PG8_LDA(At, 1, 1); PG8_STAGE(PG8_SA(1, 0), a3, voffA);
            PG8_BAR; PG8_WAIT_L(0); PG8_MMA(1, 0, At, B0); PG8_BAR; PG8_SCHED;
            PG8_STAGE(PG8_SB(1, 1), b3 + hstepB, voffB);
            PG8_WAIT_V(6); PG8_BAR; PG8_MMA(1, 1, At, B1); PG8_BAR;
            }
        }
        if constexpr (F8) asm volatile("s_nop 15\n\ts_nop 15" ::: "memory");
        if constexpr (ALIGN_EPI) { if (wr == 0) PG8_BAR; }
        if constexpr (!Epi::AFTER_DRAIN) { E(acc, cur, wr, wc, fr, fq); S.done(cur); }
        if (!has_next) break;
#pragma unroll
        for (int a = 0; a < 2; ++a)
#pragma unroll
            for (int b = 0; b < 2; ++b)
#pragma unroll
                for (int m = 0; m < 4; ++m)
#pragma unroll
                    for (int n = 0; n < 2; ++n) acc[a][b][m][n] = (f32x4){0.f, 0.f, 0.f, 0.f};
        cur = nxt; cA = nA; cB = nB; ++ui;
        if constexpr (ALIGN_EPI) { if (wr == 1) PG8_BAR; }
    }
    PG8_WAIT_V(0);
    if constexpr (!ALIGN_EPI) { if (wr == 0) PG8_BAR; }
    PG8_BAR;
    if constexpr (Epi::AFTER_DRAIN) { E.fused(acc, cur, wr, wc, fr, fq, lds, wid, lane); S.done(cur); }
#undef PG8_SA
#undef PG8_SB
#undef PG8_STAGE
#undef PG8_LDA
#undef PG8_LDB
#undef PG8_MMA
#undef PG8_SETB
#undef PG8_CAT8
#undef PG8_WAIT_V
#undef PG8_WAIT_L
#undef PG8_BAR
#undef PG8_SCHED
}
}

constexpr int NWAVES = 8, NTHR = NWAVES * 64;
constexpr int BATCH = 4, SEQ = 2048, DM = 2048, MTOK = BATCH * SEQ;
constexpr int A_IN = 20480, B_IN = 6144, NA1 = 14336;
constexpr float RMS_EPS = 1e-6f, LN_EPS = 1e-5f;
constexpr size_t MiB = 1u << 20;
constexpr size_t SZ_ACT = (size_t)MTOK * DM * 2;
constexpr size_t WS_WAIN = 2 * MiB;
constexpr size_t WS_WAOUT = WS_WAIN + 2 * (size_t)A_IN * DM * 2;
constexpr size_t WS_WBIN = WS_WAOUT + 2 * (size_t)DM * DM * 2;
constexpr size_t WS_WBOUT = WS_WBIN + 2 * (size_t)B_IN * DM * 2;
constexpr size_t WS_WM = WS_WBOUT + 2 * (size_t)DM * DM * 2;
constexpr size_t WS_COS = WS_WM + 2 * 16 * 128 * 128 * 2;
constexpr size_t WS_SIN = WS_COS + (size_t)MTOK * 16 * 4;
constexpr size_t WS_STATS = WS_SIN + (size_t)MTOK * 16 * 4;
constexpr size_t WS_LSE = WS_STATS + 2 * (size_t)MTOK * 2 * 4;
constexpr size_t WS_X = WS_LSE + 3 * (size_t)MTOK * 16 * 4;
constexpr size_t WS_XN = WS_X + 2 * SZ_ACT;
constexpr size_t WS_QK = WS_XN + SZ_ACT;
constexpr size_t WS_VT = WS_QK + 6 * SZ_ACT;
constexpr size_t WS_GATE = WS_VT + 3 * SZ_ACT;
constexpr size_t WS_OG = WS_GATE + SZ_ACT;
constexpr size_t WS_Y = WS_OG + 3 * SZ_ACT;
constexpr size_t WS_XN8 = WS_Y + SZ_ACT;
constexpr size_t WS_RSS = WS_XN8 + SZ_ACT / 2;
constexpr size_t WS_END = WS_RSS + 4 * (size_t)MTOK * 4;
constexpr size_t WS_BAR = 65536;
constexpr int LDS_BYTES = 147456;

typedef unsigned short bf16;
typedef unsigned v4u __attribute__((ext_vector_type(4)));
typedef unsigned v2u __attribute__((ext_vector_type(2)));
typedef float f32x4 __attribute__((ext_vector_type(4)));
typedef float f32x2v __attribute__((ext_vector_type(2)));
typedef float f32x16 __attribute__((ext_vector_type(16)));
typedef short bf16x8 __attribute__((ext_vector_type(8)));
typedef __bf16 bf16x2_t __attribute__((ext_vector_type(2)));
#define LAS __attribute__((address_space(3)))
#define MFMA32(a, b, c) __builtin_amdgcn_mfma_f32_32x32x16_bf16((a), (b), (c), 0, 0, 0)
__device__ __forceinline__ unsigned pk2(float lo, float hi) { f32x2v v = {lo, hi}; bf16x2_t b = __builtin_convertvector(v, bf16x2_t); return __builtin_bit_cast(unsigned, b); }
__device__ __forceinline__ float bflo(unsigned w) { return __builtin_bit_cast(float, w << 16); }
__device__ __forceinline__ float bfhi(unsigned w) { return __builtin_bit_cast(float, w & 0xffff0000u); }
__device__ __forceinline__ float wave_sum(float v) {
#pragma unroll
    for (int o = 1; o < 64; o <<= 1) v += __shfl_xor(v, o);
    return v;
}

#define XB_TMO      128
#define XB_XCNT(j)  (256  + 64 * (j))
#define XB_XSUB(j)  (1280 + 64 * (j))
#define XB_XGEN(j)  (2304 + 64 * (j))
#define XB_TOP      3328
#define XB_TOPGEN   3392
#define XCD_BAR_WORDS 3456
#define XB_SPIN_CAP (1u << 18)

__device__ __forceinline__ unsigned xb_ld(unsigned* p)              { return __hip_atomic_load(p, __ATOMIC_RELAXED, __HIP_MEMORY_SCOPE_AGENT); }
__device__ __forceinline__ unsigned xb_add(unsigned* p, unsigned v) { return __hip_atomic_fetch_add(p, v, __ATOMIC_RELAXED, __HIP_MEMORY_SCOPE_AGENT); }
__device__ __forceinline__ unsigned xb_xcc_id() { return (unsigned)__builtin_amdgcn_s_getreg((3 << 11) | 20) & 0xFu; }
#define XB_SPIN(cond, bar) do { unsigned _sp = 0; while (cond) { __builtin_amdgcn_s_sleep(1); \
    if ((++_sp & 255u) == 0u) { if (xb_ld(&(bar)[XB_TMO])) break; if (_sp > XB_SPIN_CAP) { atomicAdd(&(bar)[XB_TMO], 1u); break; } } } } while (0)

struct XcdBarrier {
    int w;
    unsigned* bar; unsigned x;
    volatile LAS unsigned* st;
};

__device__ __forceinline__ XcdBarrier xcd_barrier_post(unsigned* bar, volatile LAS unsigned* st, int w) {
    XcdBarrier b; b.w = w; b.bar = bar; b.x = xb_xcc_id(); b.st = st;
    if (w == 0 && lane_id() == 0) (void)xb_add(&bar[XB_XCNT(b.x)], 1u);
    return b;
}
__device__ __forceinline__ void xcd_barrier_complete(unsigned* bar, unsigned x, unsigned& nloc, unsigned& nx) {
    const unsigned G = gridDim.x * gridDim.y * gridDim.z;
    unsigned sum, cnt, mine, sp = 0u;
    for (;;) {
        sum = 0u; cnt = 0u; mine = 0u;
#pragma unroll
        for (unsigned j = 0; j < 16; ++j) { const unsigned c = xb_ld(&bar[XB_XCNT(j)]); sum += c; cnt += (c > 0u) ? 1u : 0u; mine = (j == x) ? c : mine; }
        if (sum == G) break;
        __builtin_amdgcn_s_sleep(1);
        if ((++sp & 255u) == 0u) { if (xb_ld(&bar[XB_TMO])) break; if (sp > XB_SPIN_CAP) { atomicAdd(&bar[XB_TMO], 1u); break; } }
    }
    nloc = mine > 0u ? mine : 1u; nx = cnt > 0u ? cnt : 1u;
}

__device__ __forceinline__ void xcd_barrier(const XcdBarrier& b) {
    asm volatile("s_waitcnt vmcnt(0)" ::: "memory");
    __syncthreads();
    if (b.w == 0 && lane_id() == 0) {
        unsigned* bar = b.bar;
        __builtin_amdgcn_s_waitcnt(0);
        unsigned nloc = b.st[0], nx = b.st[1];
        if (nloc == 0u) { xcd_barrier_complete(bar, b.x, nloc, nx); b.st[0] = nloc; b.st[1] = nx; }
        const unsigned old = xb_add(&bar[XB_XSUB(b.x)], 1u);
        const unsigned gen = old / nloc;
        if (old + 1u == (gen + 1u) * nloc) {
            __builtin_amdgcn_fence(__ATOMIC_RELEASE, "agent");
            asm volatile("s_waitcnt vmcnt(0)" ::: "memory");
            const unsigned og = xb_add(&bar[XB_TOP], 1u);
            const unsigned tg = og / nx;
            if (og + 1u == (tg + 1u) * nx) xb_add(&bar[XB_TOPGEN], 1u);
            else XB_SPIN(xb_ld(&bar[XB_TOPGEN]) == tg, bar);
            __builtin_amdgcn_fence(__ATOMIC_ACQUIRE, "agent");
            xb_add(&bar[XB_XGEN(b.x)], 1u);
            asm volatile("s_waitcnt vmcnt(0)" ::: "memory");
        } else {
            XB_SPIN(xb_ld(&bar[XB_XGEN(b.x)]) == gen, bar);
            __builtin_amdgcn_fence(__ATOMIC_ACQUIRE, "agent");
            asm volatile("s_waitcnt vmcnt(0)" ::: "memory");
        }
    }
    __syncthreads();
}

__device__ __forceinline__ int launder_s(int v) { asm volatile("" : "+s"(v)); return v; }
__device__ __forceinline__ int launder(int v) { asm volatile("" : "+v"(v)); return v; }
struct Args {
    const float* x; const int* pos; const float* a_norm_g; const float* a_w_in; const float* a_w_out; const float* b_norm_g; const float* b_w_in;
    const float* b_ln_g; const float* b_ln_b; const float* b_w_s; const float* b_b_s; const float* b_w_out; const float* final_g;
    float* out; unsigned char* ws; double invf[16];
    int ph_lo, ph_hi;
};

__device__ __forceinline__ void p0_transpose_item(const float* W, int K, int N, bf16* WT, int row_off, LAS float* scr, int kb, int nb, int lane) {
    const int k0 = 64 * kb, n0 = 32 * nb;
    float wv[32];
#pragma unroll
    for (int i = 0; i < 32; ++i) wv[i] = W[(size_t)(k0 + 2 * i + (lane >> 5)) * N + n0 + (lane & 31)];
#pragma unroll
    for (int i = 0; i < 32; ++i) scr[(2 * i + (lane >> 5)) * 33 + (lane & 31)] = wv[i];
    asm volatile("s_waitcnt lgkmcnt(0)" ::: "memory");
    const int c = lane & 7;
#pragma unroll
    for (int j = 0; j < 4; ++j) { const int n = (lane >> 3) + 8 * j; const LAS float* s = scr + (8 * c) * 33 + n;
        v4u o; o.x = pk2(s[0 * 33], s[1 * 33]); o.y = pk2(s[2 * 33], s[3 * 33]); o.z = pk2(s[4 * 33], s[5 * 33]); o.w = pk2(s[6 * 33], s[7 * 33]);
        *(v4u*)(WT + (size_t)(row_off + n0 + n) * K + k0 + 8 * c) = o; }
    asm volatile("s_waitcnt lgkmcnt(0)" ::: "memory");
}
constexpr float W8_SCALE = 32.0f;
__device__ __forceinline__ unsigned pk4_fp8(float a, float b, float c, float d) {
    a = fminf(fmaxf(a, -448.f), 448.f); b = fminf(fmaxf(b, -448.f), 448.f); c = fminf(fmaxf(c, -448.f), 448.f); d = fminf(fmaxf(d, -448.f), 448.f);
    int w = 0; w = __builtin_amdgcn_cvt_pk_fp8_f32(a, b, w, false); w = __builtin_amdgcn_cvt_pk_fp8_f32(c, d, w, true); return (unsigned)w; }
__device__ __forceinline__ void p0_transpose_item_f8(const float* W, int K, int N, unsigned char* WT, int row_off, LAS float* scr, int kb, int nb, int lane) {
    const int k0 = 64 * kb, n0 = 32 * nb;
    float wv[32];
#pragma unroll
    for (int i = 0; i < 32; ++i) wv[i] = W[(size_t)(k0 + 2 * i + (lane >> 5)) * N + n0 + (lane & 31)];
#pragma unroll
    for (int i = 0; i < 32; ++i) scr[(2 * i + (lane >> 5)) * 33 + (lane & 31)] = wv[i] * W8_SCALE;
    asm volatile("s_waitcnt lgkmcnt(0)" ::: "memory");
    const int c = lane & 7;
#pragma unroll
    for (int j = 0; j < 4; ++j) { const int n = (lane >> 3) + 8 * j; const LAS float* s = scr + (8 * c) * 33 + n;
        v2u o; o.x = pk4_fp8(s[0 * 33], s[1 * 33], s[2 * 33], s[3 * 33]); o.y = pk4_fp8(s[4 * 33], s[5 * 33], s[6 * 33], s[7 * 33]);
        *(v2u*)(WT + (size_t)(row_off + n0 + n) * K + k0 + 8 * c) = o; }
    asm volatile("s_waitcnt lgkmcnt(0)" ::: "memory");
}
template <bool OB16, bool OF32, bool OF8> __device__ __forceinline__ void rms_row(const float* xrow, const float* g, bf16* o16, float* o32, unsigned char* o8, int lane) {
    const f32x4* xr = (const f32x4*)xrow + lane; const f32x4* gr = (const f32x4*)g + lane;
    f32x4 v[8]; float s = 0.f;
#pragma unroll
    for (int j = 0; j < 8; ++j) { v[j] = xr[64 * j]; s += (v[j].x * v[j].x + v[j].y * v[j].y) + (v[j].z * v[j].z + v[j].w * v[j].w); }
    const float rstd = 1.0f / sqrtf(wave_sum(s) * (1.0f / DM) + RMS_EPS);
#pragma unroll
    for (int j = 0; j < 8; ++j) { const f32x4 gg = gr[64 * j]; const f32x4 y = v[j] * rstd * gg;
        if (OF32) ((f32x4*)o32 + lane)[64 * j] = y;
        if (OF8) ((unsigned*)o8 + lane)[64 * j] = pk4_fp8(y.x, y.y, y.z, y.w);
        if (OB16) { v2u w; w.x = pk2(y.x, y.y); w.y = pk2(y.z, y.w); ((v2u*)o16 + lane)[64 * j] = w; } }
}

constexpr float C2S = 0.08838834764831845f * 1.4426950408889634f;
constexpr int ATT_KP = 144, ATT_VP = 80;
constexpr int ATT_KB = 32 * ATT_KP, ATT_VB = 128 * ATT_VP, ATT_BUF = ATT_KB + ATT_VB;
__device__ __forceinline__ bf16x8 f8x8_to_bf16x8(v2u w) {
    const f32x2v a = __builtin_amdgcn_cvt_pk_f32_fp8((int)w.x, false), b = __builtin_amdgcn_cvt_pk_f32_fp8((int)w.x, true), c = __builtin_amdgcn_cvt_pk_f32_fp8((int)w.y, false), d = __builtin_amdgcn_cvt_pk_f32_fp8((int)w.y, true);
    v4u o; o.x = pk2(a.x, a.y); o.y = pk2(b.x, b.y); o.z = pk2(c.x, c.y); o.w = pk2(d.x, d.y); return __builtin_bit_cast(bf16x8, o); }
struct AttPair { unsigned uq, uk, uv, orow; int j0, g; };
__device__ __forceinline__ AttPair att_decode(int pi, int grp, int qw) {
    AttPair d; const int uid = 2 * pi + grp, g = 2 - (uid >> 10), rest = uid & 1023, blk = rest & 15, h = (rest >> 4) & 15, b = rest >> 8;
    const int dsh = 2 * g; const bool has_prev = (blk & ((16 >> dsh) - 1)) != 0;
    d.j0 = __builtin_amdgcn_readfirstlane(has_prev ? 0 : 4); d.g = __builtin_amdgcn_readfirstlane(g);
    d.uq = __builtin_amdgcn_readfirstlane((unsigned)((((g * 2 + 0) * 4 + b) * 16 + h) * 2048 + blk * 128 + qw * 32) * 128u);
    d.uk = __builtin_amdgcn_readfirstlane((unsigned)((((g * 2 + 1) * 4 + b) * 16 + h) * 2048 + blk * 128 - 128) * 128u);
    d.uv = __builtin_amdgcn_readfirstlane((unsigned)(g * 2048 * 8192 + (b * 64 + blk * 4 - 4) * 65536 + h * 128 * 32) * 2u);
    d.orow = __builtin_amdgcn_readfirstlane((unsigned)(((g * 4 + b) * 16 + h) * 2048 + blk * 128 + qw * 32));
    return d;
}
__device__ __forceinline__ void attn_phase(const bf16* QK, const bf16* VT, bf16* OG, float* LSE, int bx, int G, int wave, int lane, LAS unsigned char* lds) {
    const int q = lane & 31, hh = lane >> 5, grp = wave >> 2, qw = wave & 3;
    const int kperm = (q & 0x13) | ((q & 4) << 1) | ((q & 8) >> 1);
    const char* QKc = (const char*)QK; const char* VTc = (const char*)VT;
    LAS unsigned char* gl = lds + grp * (2 * ATT_BUF);
    const int L2 = (qw * 64 + lane) * 2, L1 = qw * 64 + lane;
    const unsigned kw0 = (unsigned)((L1 >> 3) * ATT_KP + (L1 & 7) * 16);
    const unsigned vw0 = (unsigned)(ATT_KB + (L2 >> 2) * ATT_VP + (L2 & 3) * 16), vw1 = (unsigned)(ATT_KB + ((L2 + 1) >> 2) * ATT_VP + ((L2 + 1) & 3) * 16);
    const unsigned kr = (unsigned)(kperm * ATT_KP + 8 * hh), vr = (unsigned)(ATT_KB + q * ATT_VP + 16 * hh);
    const unsigned lqo = (unsigned)(q * 128 + 8 * hh);
    int pi = bx; if (pi >= 1536) return;
    v4u st[4][3]; long qf[8], qn[8];
#define ATT_FETCH(P, J, D) do { const char* kp_ = QKc + ((P).uk + (unsigned)(J) * 4096u + (unsigned)L1 * 16u); const char* vp_ = VTc + ((P).uv + (unsigned)(J) * 131072u + (unsigned)L2 * 16u); \
            D[0] = *(const v4u*)kp_; D[1] = *(const v4u*)vp_; D[2] = *(const v4u*)(vp_ + 16); } while (0)
#define ATT_PARK(J, D) do { LAS unsigned char* wb_ = gl + ((J) & 1) * ATT_BUF; *(LAS v4u*)(wb_ + kw0) = D[0]; *(LAS v4u*)(wb_ + vw0) = D[1]; *(LAS v4u*)(wb_ + vw1) = D[2]; } while (0)
#define ATT_LDQ(P, D) do { const char* qp_ = QKc + ((P).uq + lqo); _Pragma("unroll") for (int c = 0; c < 8; ++c) D[c] = *(const long*)(qp_ + 16 * c); } while (0)
    AttPair cur = att_decode(pi, grp, qw);
    ATT_LDQ(cur, qf);
    ATT_FETCH(cur, cur.j0, st[0]); ATT_FETCH(cur, cur.j0 + 1, st[1]); ATT_FETCH(cur, cur.j0 + 2, st[2]); ATT_FETCH(cur, cur.j0 + 3, st[3]);
    ATT_PARK(0, st[0]);
    asm volatile("s_waitcnt lgkmcnt(0)\n\ts_barrier" ::: "memory");
    for (;;) {
        const bool has_next = pi + G < 1536;
        AttPair nxt = cur; if (has_next) nxt = att_decode(pi + G, grp, qw);
        const int j0 = cur.j0;
        f32x16 O[4];
#pragma unroll
        for (int db = 0; db < 4; ++db)
#pragma unroll
            for (int i = 0; i < 16; ++i) O[db][i] = 0.f;
        float m = -INFINITY, l = 0.f;
#pragma unroll
        for (int j = 0; j < 8; ++j) {
            if (j < 4 && cur.g == 2) continue;
            if (j < 4) { if (j0 == 0) ATT_FETCH(cur, j + 4, st[j & 3]); }
            else if (has_next) { ATT_FETCH(nxt, nxt.j0 + (j - 4), st[j & 3]); if (j == 4) ATT_LDQ(nxt, qn); }
            const int t = j - qw;
            if (j >= j0 && t >= 0 && t <= 4) {
                const LAS unsigned char* rb = gl + (j & 1) * ATT_BUF;
                f32x16 S;
#pragma unroll
                for (int i = 0; i < 16; ++i) S[i] = 0.f;
                long kf[8]; bf16x8 vf[4][2];
#pragma unroll
                for (int c = 0; c < 8; ++c) kf[c] = *(const LAS long*)(rb + kr + 16 * c);
#pragma unroll
                for (int db = 0; db < 4; ++db) { vf[db][0] = *(const LAS bf16x8*)(rb + vr + db * 32 * ATT_VP); vf[db][1] = *(const LAS bf16x8*)(rb + vr + db * 32 * ATT_VP + 32); }
                __builtin_amdgcn_sched_barrier(0);
#pragma unroll
                for (int c = 0; c < 8; ++c) S = __builtin_amdgcn_mfma_f32_32x32x16_fp8_fp8(kf[c], qf[c], S, 0, 0, 0);
                if (t == 0) {
#pragma unroll
                    for (int i = 0; i < 16; ++i) { const int kt = 16 * (i >> 3) + 8 * hh + (i & 7); if (kt < q) S[i] = -INFINITY; }
                }
                if (t == 4) {
#pragma unroll
                    for (int i = 0; i < 16; ++i) { const int kt = 16 * (i >> 3) + 8 * hh + (i & 7); if (kt > q) S[i] = -INFINITY; }
                }
                float mx = S[0];
#pragma unroll
                for (int i = 1; i < 16; ++i) mx = fmaxf(mx, S[i]);
                mx = fmaxf(mx, __shfl_xor(mx, 32)) * C2S;
                if (__builtin_amdgcn_ballot_w64(mx > m + 8.0f) != 0ull) { const float mn = fmaxf(m, mx), alpha = __builtin_amdgcn_exp2f(m - mn); l *= alpha; m = mn;
#pragma unroll
                    for (int db = 0; db < 4; ++db)
#pragma unroll
                        for (int i = 0; i < 16; ++i) O[db][i] *= alpha; }
                float rs = 0.f;
#pragma unroll
                for (int i = 0; i < 16; ++i) { S[i] = __builtin_amdgcn_exp2f(__builtin_fmaf(S[i], C2S, -m)); rs += S[i]; }
                l += rs;
                v4u w0, w1;
                w0.x = pk2(S[0], S[1]); w0.y = pk2(S[2], S[3]); w0.z = pk2(S[4], S[5]); w0.w = pk2(S[6], S[7]);
                w1.x = pk2(S[8], S[9]); w1.y = pk2(S[10], S[11]); w1.z = pk2(S[12], S[13]); w1.w = pk2(S[14], S[15]);
                const bf16x8 ps0 = __builtin_bit_cast(bf16x8, w0), ps1 = __builtin_bit_cast(bf16x8, w1);
#pragma unroll
                for (int db = 0; db < 4; ++db) { O[db] = MFMA32(vf[db][0], ps0, O[db]); O[db] = MFMA32(vf[db][1], ps1, O[db]); }
            }
            if (j < 7) { if (j + 1 >= j0 + 1) ATT_PARK(j + 1, st[(j + 1) & 3]); }
            else if (has_next) ATT_PARK(0, st[0]);
            asm volatile("s_waitcnt lgkmcnt(0)\n\ts_barrier" ::: "memory");
        }
        l += __shfl_xor(l, 32);
        const float inv = 1.0f / l, lse2 = m + __builtin_amdgcn_logf(l);
        { LAS unsigned char* ob = lds + 61440 + wave * (32 * 272);
#pragma unroll
          for (int db = 0; db < 4; ++db)
#pragma unroll
              for (int i4 = 0; i4 < 4; ++i4) { v2u w; w.x = pk2(O[db][4 * i4] * inv, O[db][4 * i4 + 1] * inv); w.y = pk2(O[db][4 * i4 + 2] * inv, O[db][4 * i4 + 3] * inv);
                  *(LAS v2u*)(ob + q * 272 + (db * 32 + 8 * i4 + 4 * hh) * 2) = w; }
          asm volatile("s_waitcnt lgkmcnt(0)" ::: "memory");
          __attribute__((address_space(1))) unsigned char* og = (__attribute__((address_space(1))) unsigned char*)OG + (size_t)cur.orow * 256;
          const unsigned lo = (unsigned)((lane >> 4) * 256 + (lane & 15) * 16), li = (unsigned)((lane >> 4) * 272 + (lane & 15) * 16);
#pragma unroll
          for (int k = 0; k < 8; ++k) { const v4u x = *(const LAS v4u*)(ob + li + k * (4 * 272)); *(__attribute__((address_space(1))) v4u*)(og + (lo + (unsigned)k * 1024u)) = x; }
          asm volatile("s_waitcnt lgkmcnt(0)" ::: "memory"); }
        if (hh == 0) LSE[cur.orow + q] = lse2;
        if (!has_next) break;
        cur = nxt; pi += G;
#pragma unroll
        for (int c = 0; c < 8; ++c) qf[c] = qn[c];
    }
#undef ATT_FETCH
#undef ATT_PARK
#undef ATT_LDQ
}
__device__ __forceinline__ void merge_phase(const bf16* OG, const float* LSE, const bf16* GATE, bf16* Y, int gw, int NGW, int lane) {
    for (int row = gw; row < MTOK; row += NGW) { const int b = row >> 11, s = row & 2047;
#pragma unroll
        for (int j = 0; j < 4; ++j) { const int col = lane * 8 + 512 * j, h = col >> 7, e = col & 127;
            size_t r[3]; float lg[3];
#pragma unroll
            for (int g = 0; g < 3; ++g) { const int dsh = 2 * g, p = ((s & ((1 << dsh) - 1)) << (11 - dsh)) | (s >> dsh); r[g] = ((size_t)(g * 4 + b) * 16 + h) * 2048 + p; lg[g] = LSE[r[g]]; }
            const float mx = fmaxf(lg[0], fmaxf(lg[1], lg[2]));
            float w0 = __builtin_amdgcn_exp2f(lg[0] - mx), w1 = __builtin_amdgcn_exp2f(lg[1] - mx), w2 = __builtin_amdgcn_exp2f(lg[2] - mx);
            const float inv = 1.0f / (w0 + w1 + w2); w0 *= inv; w1 *= inv; w2 *= inv;
            const v4u a = *(const v4u*)(OG + r[0] * 128 + e), bb = *(const v4u*)(OG + r[1] * 128 + e), c = *(const v4u*)(OG + r[2] * 128 + e), gt = *(const v4u*)(GATE + (size_t)row * 2048 + col);
            v4u o;
#pragma unroll
            for (int k = 0; k < 4; ++k) {
                const float ylo = (w0 * bflo(a[k]) + w1 * bflo(bb[k]) + w2 * bflo(c[k])) * bflo(gt[k]);
                const float yhi = (w0 * bfhi(a[k]) + w1 * bfhi(bb[k]) + w2 * bfhi(c[k])) * bfhi(gt[k]);
                o[k] = pk2(ylo, yhi); }
            *(v4u*)(Y + (size_t)row * 2048 + col) = o; }
    }
}
__device__ __forceinline__ void sgu_phase(const bf16* VTB, const float* STATS, const float* LNG, const float* LNB, const bf16* WM, const float* BS, const bf16* U, const bf16* ZS, bf16* Y,
                                          int gw, int NGW, int lane, LAS unsigned char* wl) {
    const int r = lane & 31, hh = lane >> 5;
    for (int wu = gw; wu < 4096; wu += NGW) {
        const int cblk = wu & 3, g = (wu >> 2) & 15, chunk = (wu >> 6) & 15, b = wu >> 10;
        const int ch = g * 128 + cblk * 32 + r, tok0 = b * 2048 + chunk * 128;
        v4u raw[8];
#pragma unroll
        for (int ks = 0; ks < 8; ++ks) raw[ks] = *(const v4u*)(VTB + (size_t)((tok0 + 16 * ks) >> 5) * 65536 + (size_t)ch * 32 + ((16 * ks) & 31) + 8 * hh);
        v4u ur[4][2], zr[4][2]; float bs[4];
        { const __attribute__((address_space(1))) unsigned char* ub = (const __attribute__((address_space(1))) unsigned char*)U + ((size_t)tok0 * 2048 + g * 128 + cblk * 32) * 2;
          const __attribute__((address_space(1))) unsigned char* zb = (const __attribute__((address_space(1))) unsigned char*)ZS + ((size_t)tok0 * 2048 + g * 128 + cblk * 32) * 2;
          const unsigned lo = (unsigned)((lane >> 2) * 4096 + (lane & 3) * 16);
#pragma unroll
          for (int tb = 0; tb < 4; ++tb) { bs[tb] = BS[g * 128 + tb * 32 + r];
#pragma unroll
              for (int k = 0; k < 2; ++k) { ur[tb][k] = *(const __attribute__((address_space(1))) v4u*)(ub + (lo + (unsigned)(tb * 32 + k * 16) * 4096u)); zr[tb][k] = *(const __attribute__((address_space(1))) v4u*)(zb + (lo + (unsigned)(tb * 32 + k * 16) * 4096u)); } } }
        const float lng = LNG[ch], lnb = LNB[ch];
        bf16x8 af[8];
#pragma unroll
        for (int ks = 0; ks < 8; ++ks) { v4u o; const f32x4* sp = (const f32x4*)(STATS + 2 * (size_t)(tok0 + 16 * ks + 8 * hh));
#pragma unroll
            for (int k = 0; k < 4; ++k) { const f32x4 sv = sp[k];
                const float mu0 = sv.x * (1.0f / 2048), mu1 = sv.z * (1.0f / 2048);
                const float a0 = lng * __builtin_amdgcn_rsqf(fmaxf(sv.y * (1.0f / 2048) - mu0 * mu0, 0.f) + LN_EPS), a1 = lng * __builtin_amdgcn_rsqf(fmaxf(sv.w * (1.0f / 2048) - mu1 * mu1, 0.f) + LN_EPS);
                o[k] = pk2(bflo(raw[ks][k]) * a0 + (lnb - mu0 * a0), bfhi(raw[ks][k]) * a1 + (lnb - mu1 * a1)); }
            af[ks] = __builtin_bit_cast(bf16x8, o); }
        bf16x8 wf[2][8];
        { const bf16* wp = WM + (size_t)(g * 128 + r) * 128 + 8 * hh; wf[0][0] = *(const bf16x8*)wp; wf[0][1] = *(const bf16x8*)(wp + 16); }
#pragma unroll
        for (int tb = 0; tb < 4; ++tb) {
            f32x16 D;
#pragma unroll
            for (int i = 0; i < 16; ++i) D[i] = 0.f;
#pragma unroll
            for (int ks = 0; ks < 2 * tb + 2; ++ks) D = MFMA32(af[ks], wf[tb & 1][ks], D);
            __builtin_amdgcn_sched_barrier(0);
            if (tb < 3) { const bf16* wp = WM + (size_t)(g * 128 + (tb + 1) * 32 + r) * 128 + 8 * hh;
#pragma unroll
                for (int ks = 0; ks < 2 * tb + 4; ++ks) wf[(tb + 1) & 1][ks] = *(const bf16x8*)(wp + 16 * ks); }
            __builtin_amdgcn_sched_barrier(0);
            { const unsigned li = (unsigned)((lane >> 2) * 80 + (lane & 3) * 16);
#pragma unroll
              for (int k = 0; k < 2; ++k) { *(LAS v4u*)(wl + 2560 + li + k * (16 * 80)) = ur[tb][k]; *(LAS v4u*)(wl + 5120 + li + k * (16 * 80)) = zr[tb][k]; } }
            asm volatile("s_waitcnt lgkmcnt(0)" ::: "memory");
            v2u uq4[4], zq4[4];
#pragma unroll
            for (int i4 = 0; i4 < 4; ++i4) { uq4[i4] = *(const LAS v2u*)(wl + 2560 + r * 80 + (8 * i4 + 4 * hh) * 2); zq4[i4] = *(const LAS v2u*)(wl + 5120 + r * 80 + (8 * i4 + 4 * hh) * 2); }
            asm volatile("s_waitcnt lgkmcnt(0)" ::: "memory");
#pragma unroll
            for (int i4 = 0; i4 < 4; ++i4) { const v2u u4 = uq4[i4], z4 = zq4[i4];
                v2u w; w.x = pk2(bflo(u4.x) * (D[4 * i4] + bs[tb]) * bflo(z4.x), bfhi(u4.x) * (D[4 * i4 + 1] + bs[tb]) * bfhi(z4.x));
                w.y = pk2(bflo(u4.y) * (D[4 * i4 + 2] + bs[tb]) * bflo(z4.y), bfhi(u4.y) * (D[4 * i4 + 3] + bs[tb]) * bfhi(z4.y));
                *(LAS v2u*)(wl + r * 80 + (8 * i4 + 4 * hh) * 2) = w; }
            asm volatile("s_waitcnt lgkmcnt(0)" ::: "memory");
            { __attribute__((address_space(1))) unsigned char* yb = (__attribute__((address_space(1))) unsigned char*)Y + ((size_t)(tok0 + tb * 32) * 2048 + g * 128 + cblk * 32) * 2;
              const unsigned lo = (unsigned)((lane >> 2) * 4096 + (lane & 3) * 16), li = (unsigned)((lane >> 2) * 80 + (lane & 3) * 16);
#pragma unroll
              for (int k = 0; k < 2; ++k) { const v4u x = *(const LAS v4u*)(wl + li + k * (16 * 80)); *(__attribute__((address_space(1))) v4u*)(yb + (lo + (unsigned)k * 65536u)) = x; } }
            asm volatile("s_waitcnt lgkmcnt(0)" ::: "memory");
        }
    }
}

constexpr int N_PHASES = 19;
__global__ void __launch_bounds__(NTHR) trunk_fwd(Args args) {
    extern __shared__ __attribute__((aligned(16))) unsigned char lds[];
    const int wave = __builtin_amdgcn_readfirstlane(threadIdx.x >> 6);
#define tid (wave * 64 + lane_id())
#define lane lane_id()
    const int G = gridDim.x, bx = blockIdx.x;
    const int gw = bx * NWAVES + wave, NGW = G * NWAVES;
    unsigned char* ws = args.ws;
#define WS_PTRS unsigned char* wl_ = ws; asm volatile("" : "+s"(wl_)); bf16* WAin = (bf16*)(wl_ + WS_WAIN); bf16* WAout = (bf16*)(wl_ + WS_WAOUT); bf16* WBin = (bf16*)(wl_ + WS_WBIN); bf16* WBout = (bf16*)(wl_ + WS_WBOUT); bf16* WM = (bf16*)(wl_ + WS_WM); float* COS = (float*)(wl_ + WS_COS); float* SIN = (float*)(wl_ + WS_SIN); float* STATS = (float*)(wl_ + WS_STATS); float* LSE = (float*)(wl_ + WS_LSE); float* X = (float*)(wl_ + WS_X); bf16* XN = (bf16*)(wl_ + WS_XN); bf16* QK = (bf16*)(wl_ + WS_QK); bf16* VT = (bf16*)(wl_ + WS_VT); bf16* GATE = (bf16*)(wl_ + WS_GATE); bf16* OG = (bf16*)(wl_ + WS_OG); bf16* Y = (bf16*)(wl_ + WS_Y); bf16* U = OG; bf16* ZS = OG + (size_t)MTOK * 2048; unsigned char* XN8 = wl_ + WS_XN8; float* RSS = (float*)(wl_ + WS_RSS); (void)RSS; (void)WAin; (void)WAout; (void)WBin; (void)WBout; (void)WM; (void)COS; (void)SIN; (void)STATS; (void)LSE; (void)X; (void)XN; (void)QK; (void)VT; (void)GATE; (void)OG; (void)Y; (void)U; (void)ZS; (void)XN8;
    const int lo = args.ph_lo, hi = args.ph_hi; (void)lo; (void)hi;
#if MK_PER_PHASE
#define IN(k) (lo <= (k) && (k) < hi)
#else
#define IN(k) true
#endif
    volatile LAS unsigned* MISC = (volatile LAS unsigned*)((LAS unsigned char*)lds + 131072 + 320);
    if (tid < 32) MISC[tid] = 0u;
    unsigned* barw = (unsigned*)(ws + WS_BAR);
#if !MK_PER_PHASE
    if (bx == 0) for (int i = tid; i < XCD_BAR_WORDS; i += NTHR) __hip_atomic_store(barw + i, 0u, __ATOMIC_RELAXED, __HIP_MEMORY_SCOPE_AGENT);
#endif
    __syncthreads();
    XcdBarrier xbar; xbar.w = wave; xbar.bar = barw; xbar.x = 0; xbar.st = MISC + 8;
#if MK_PER_PHASE
#define SEAM(k) do { } while (0)
#else
#define SEAM(k) do { if (IN(k) && IN((k) + 1)) xcd_barrier(xbar); } while (0)
#endif
    if (IN(0)) { WS_PTRS
        LAS float* scr = (LAS float*)((LAS unsigned char*)lds + wave * 16384);
        constexpr int I_AIN = 32 * (A_IN / 32), I_SQ = 32 * (DM / 32), I_BIN = 32 * (B_IN / 32);
        constexpr int NITEMS = 2 * (I_AIN + I_SQ + I_BIN + I_SQ);
        for (int it = gw; it < NITEMS; it += NGW) {
            int r = it; const int j = r / (NITEMS / 2); r -= j * (NITEMS / 2);
            if (r < I_AIN) { const int nblk = A_IN / 32, kb = r / nblk, nb = r % nblk, sb = (nb * 32) / 2048;
                unsigned char* W8 = (unsigned char*)WAin + (size_t)j * A_IN * DM * 2; bf16* W16 = (bf16*)(W8 + 48 * MiB);
                const float* src = args.a_w_in + (size_t)j * DM * A_IN;
                if (sb < 9 && (sb % 3) < 2) p0_transpose_item_f8(src, DM, A_IN, W8, (2 * (sb / 3) + (sb % 3) - sb) * 2048, scr, kb, nb, lane);
                else if (A_VG_FP8 && !(A_GATE_BF16 && sb == 9)) p0_transpose_item_f8(src, DM, A_IN, W8, ((sb == 9 ? 6 : 7 + sb / 3) - sb) * 2048, scr, kb, nb, lane);
                else p0_transpose_item(src, DM, A_IN, W16, ((sb == 9 ? 0 : 1 + sb / 3) - sb) * 2048, scr, kb, nb, lane);
                continue; } r -= I_AIN;
            if (r < I_SQ) { p0_transpose_item(args.a_w_out + (size_t)j * DM * DM, DM, DM, WAout + (size_t)j * DM * DM, 0, scr, r / (DM / 32), r % (DM / 32), lane); continue; } r -= I_SQ;
            if (r < I_BIN) { const int nblk = B_IN / 32, kb = r / nblk, nb = r % nblk, sb = (nb * 32) / 2048;
                const int db = sb == 0 ? 0 : (sb == 1 ? 2 : 1);
                p0_transpose_item(args.b_w_in + (size_t)j * DM * B_IN, DM, B_IN, WBin + (size_t)j * B_IN * DM, (db - sb) * 2048, scr, kb, nb, lane); continue; } r -= I_BIN;
            p0_transpose_item(args.b_w_out + (size_t)j * DM * DM, DM, DM, WBout + (size_t)j * DM * DM, 0, scr, r / (DM / 32), r % (DM / 32), lane);
        }
        const int gt = bx * NTHR + tid, NGT = G * NTHR;
        for (int i = gt; i < 2 * 16 * 128 * 128 / 2; i += NGT) { const int e = 2 * i, s = e & 127, t = (e >> 7) & 127;
            const f32x2v w = *(const f32x2v*)(args.b_w_s + e); ((unsigned*)WM)[i] = pk2(s <= t ? w.x : 0.f, s + 1 <= t ? w.y : 0.f); }
        for (int i = gt; i < MTOK * 16; i += NGT) { const int tok = i >> 4, f = i & 15; const double rev = (double)args.pos[tok] * args.invf[f]; const float fr = (float)(rev - floor(rev));
            COS[i] = __builtin_amdgcn_cosf(fr); SIN[i] = __builtin_amdgcn_sinf(fr); }
        for (int i = gt; i < 2 * MTOK * 2; i += NGT) STATS[i] = 0.f;
        for (int i = gt; i < 4 * MTOK; i += NGT) RSS[i] = i < MTOK ? 2048.0f * (1.0f - 1e-6f) : 0.f;
        for (int m = gw; m < MTOK; m += NGW) rms_row<(!A_VG_FP8 || A_GATE_BF16), false, true>(args.x + (size_t)m * DM, args.a_norm_g, XN + (size_t)m * DM, nullptr, XN8 + (size_t)m * DM, lane);
    }
#if !MK_PER_PHASE
    cg::this_grid().sync();
    xbar = xcd_barrier_post(barw, MISC + 8, wave);
#endif
    for (int rep = 0; rep < 2; ++rep) {
        const int P = 1 + 9 * rep;
        if (IN(P)) { WS_PTRS
            const char* W8 = (const char*)WAin + (size_t)rep * A_IN * DM * 2;
            const float* rssA = RSS + (size_t)(2 * rep) * MTOK;
            const pg8::EpiA1 e1{QK, GATE, COS, SIN, 1.0f / W8_SCALE, 0, rssA};
#if A_VG_FP8 && A_GATE_BF16
            { pg8::MultiOrder S{{(const char*)XN8, W8, 32, 48, 1}, {W8 + (size_t)14336 * DM, (const char*)XN8, 8, 32, 1}, {W8 + (size_t)16384 * DM, (const char*)XN8, 8, 32, 4},
                                {W8 + (size_t)18432 * DM, (const char*)XN8, 8, 32, 16}, 4, launder_s(G), launder_s(bx), DM};
              pg8::EpiAllA E{e1, pg8::EpiPlain{VT, 1.0f / W8_SCALE, rssA, 0}, 1};
              pg8::gemm_phase<pg8::EpiAllA, pg8::MultiOrder, true, true, true>((LAS unsigned char*)lds, DM, S, E, wave); }
            { const char* W16 = W8 + 48 * MiB;
              pg8::MultiOrder S{{(const char*)XN, W16, 32, 8, 1}, {nullptr, nullptr, 0, 0, 1}, {nullptr, nullptr, 0, 0, 1}, {nullptr, nullptr, 0, 0, 1}, 1, launder_s(G), launder_s(bx), DM * 2};
              const pg8::EpiA1 eg{QK, GATE, COS, SIN, 1.0f, 48, rssA};
              pg8::gemm_phase<pg8::EpiA1, pg8::MultiOrder, true, true, false>((LAS unsigned char*)lds, DM, S, eg, wave); }
#elif A_VG_FP8
            pg8::MultiOrder S{{(const char*)XN8, W8, 32, 56, 1}, {W8 + (size_t)14336 * DM, (const char*)XN8, 8, 32, 1}, {W8 + (size_t)16384 * DM, (const char*)XN8, 8, 32, 4},
                              {W8 + (size_t)18432 * DM, (const char*)XN8, 8, 32, 16}, 4, launder_s(G), launder_s(bx), DM};
            pg8::EpiAllA E{e1, pg8::EpiPlain{VT, 1.0f / W8_SCALE, rssA, 0}, 1};
            pg8::gemm_phase<pg8::EpiAllA, pg8::MultiOrder, true, true, true>((LAS unsigned char*)lds, DM, S, E, wave);
#else
            { pg8::MultiOrder S{{(const char*)XN8, W8, 32, 48, 1}, {nullptr, nullptr, 0, 0, 1}, {nullptr, nullptr, 0, 0, 1}, {nullptr, nullptr, 0, 0, 1}, 1, launder_s(G), launder_s(bx), DM};
              pg8::gemm_phase<pg8::EpiA1, pg8::MultiOrder, true, true, true>((LAS unsigned char*)lds, DM, S, e1, wave); }
            { const char* W16 = W8 + 48 * MiB;
              pg8::MultiOrder S{{(const char*)XN, W16, 32, 8, 1}, {W16 + (size_t)2048 * DM * 2, (const char*)XN, 8, 32, 1}, {W16 + (size_t)4096 * DM * 2, (const char*)XN, 8, 32, 4},
                                {W16 + (size_t)6144 * DM * 2, (const char*)XN, 8, 32, 16}, 4, launder_s(G), launder_s(bx), DM * 2};
              pg8::EpiAllA E{pg8::EpiA1{QK, GATE, COS, SIN, 1.0f, 48, rssA}, pg8::EpiPlain{VT, 1.0f, rssA, 0}, 1};
              pg8::gemm_phase<pg8::EpiAllA, pg8::MultiOrder, true, true, false>((LAS unsigned char*)lds, DM, S, E, wave); }
#endif
        }
        SEAM(P);
        if (IN(P + 1)) { WS_PTRS attn_phase(QK, VT, OG, LSE, bx, G, wave, launder(lane), (LAS unsigned char*)lds); }
        SEAM(P + 1);
        if (IN(P + 2)) { WS_PTRS merge_phase(OG, LSE, GATE, Y, gw, NGW, launder(lane)); }
        SEAM(P + 2);
        if (IN(P + 3)) { WS_PTRS pg8::MultiOrder S{{(const char*)Y, (const char*)(WAout + (size_t)rep * DM * DM), 32, 8, 1}, {nullptr, nullptr, 0, 0, 1}, {nullptr, nullptr, 0, 0, 1}, {nullptr, nullptr, 0, 0, 1}, 1, launder_s(G), launder_s(bx), DM * 2};
            pg8::EpiOut E{rep == 0 ? args.x : X, X, args.b_norm_g + (size_t)rep * DM, XN, nullptr, RSS + (size_t)(2 * rep + 1) * MTOK};
            pg8::gemm_phase<pg8::EpiOut, pg8::MultiOrder, true, true>((LAS unsigned char*)lds, DM, S, E, wave); }
        SEAM(P + 3);
        if (IN(P + 5)) { WS_PTRS
            const char* W = (const char*)(WBin + (size_t)rep * B_IN * DM);
            pg8::MultiOrder S{{(const char*)XN, W, 32, 16, 1}, {W + (size_t)4096 * DM * 2, (const char*)XN, 8, 32, 1}, {nullptr, nullptr, 0, 0, 1}, {nullptr, nullptr, 0, 0, 1}, 2, launder_s(G), launder_s(bx), DM * 2};
            const float* rssB = RSS + (size_t)(2 * rep + 1) * MTOK;
            pg8::EpiAllB E{pg8::EpiB1{U, ZS, rssB}, pg8::EpiB2{VT, STATS + (size_t)rep * MTOK * 2, rssB}};
            pg8::gemm_phase<pg8::EpiAllB, pg8::MultiOrder, true, true>((LAS unsigned char*)lds, DM, S, E, wave);
        }
        SEAM(P + 5);
        if (IN(P + 6)) { WS_PTRS sgu_phase(VT, STATS + (size_t)rep * MTOK * 2, args.b_ln_g + (size_t)rep * DM, args.b_ln_b + (size_t)rep * DM, WM + (size_t)rep * 16 * 128 * 128, args.b_b_s + (size_t)rep * 16 * 128, U, ZS, Y, gw, NGW, launder(lane), (LAS unsigned char*)lds + wave * 8192); }
        SEAM(P + 6);
        if (IN(P + 7)) { WS_PTRS pg8::MultiOrder S{{(const char*)Y, (const char*)(WBout + (size_t)rep * DM * DM), 32, 8, 1}, {nullptr, nullptr, 0, 0, 1}, {nullptr, nullptr, 0, 0, 1}, {nullptr, nullptr, 0, 0, 1}, 1, launder_s(G), launder_s(bx), DM * 2};
            pg8::EpiOut E{X, X, rep == 0 ? args.a_norm_g + DM : nullptr, XN, XN8, RSS + (size_t)2 * MTOK};
            pg8::gemm_phase<pg8::EpiOut, pg8::MultiOrder, true, true>((LAS unsigned char*)lds, DM, S, E, wave); }
        if (rep == 1) SEAM(P + 7);
        if (IN(P + 8)) { WS_PTRS const int ln = launder(lane);
            if (rep == 1) { for (int m = gw; m < MTOK; m += NGW) rms_row<false, true, false>(X + (size_t)m * DM, args.final_g, nullptr, args.out + (size_t)m * DM, nullptr, ln); }
        }
        if (rep == 0) SEAM(P + 8);
    }
#undef IN
#undef SEAM
#undef tid
#undef lane
}

extern "C" void kernel_launch(void* const* d_in, const int* in_sizes, int n_in, void* d_out, int out_size, void* d_ws, size_t ws_size, hipStream_t stream) {
    static int grid = 0;
    if (grid == 0) {
        if (n_in != 13 || in_sizes[0] != MTOK * DM || out_size != MTOK * DM || ws_size < WS_END) { fprintf(stderr, "kernel_launch: unexpected shapes / workspace (n_in %d, in0 %d, out %d, ws %zu, need %zu)\n", n_in, n_in > 0 ? in_sizes[0] : -1, out_size, ws_size, (size_t)WS_END); grid = -1; return; }
        int dev = 0, cus = 0, per_cu = 0;
        if (hipGetDevice(&dev) != hipSuccess || hipDeviceGetAttribute(&cus, hipDeviceAttributeMultiprocessorCount, dev) != hipSuccess) { grid = -1; return; }
        if (hipFuncSetAttribute((const void*)trunk_fwd, hipFuncAttributeMaxDynamicSharedMemorySize, LDS_BYTES) != hipSuccess) { fprintf(stderr, "kernel_launch: hipFuncSetAttribute failed\n"); grid = -1; return; }
        if (hipOccupancyMaxActiveBlocksPerMultiprocessor(&per_cu, (const void*)trunk_fwd, NTHR, LDS_BYTES) != hipSuccess || per_cu < 1) { fprintf(stderr, "kernel_launch: occupancy query failed (%d)\n", per_cu); (void)hipGetLastError(); grid = -1; return; }
        grid = cus * per_cu;
    }
    if (grid < 0) return;
    Args a{};
    a.x = (const float*)d_in[0]; a.pos = (const int*)d_in[1]; a.a_norm_g = (const float*)d_in[2]; a.a_w_in = (const float*)d_in[3]; a.a_w_out = (const float*)d_in[4];
    a.b_norm_g = (const float*)d_in[5]; a.b_w_in = (const float*)d_in[6]; a.b_ln_g = (const float*)d_in[7]; a.b_ln_b = (const float*)d_in[8]; a.b_w_s = (const float*)d_in[9];
    a.b_b_s = (const float*)d_in[10]; a.b_w_out = (const float*)d_in[11]; a.final_g = (const float*)d_in[12];
    a.out = (float*)d_out; a.ws = (unsigned char*)d_ws;
    for (int i = 0; i < 16; ++i) a.invf[i] = pow(500000.0, -(double)i / 16.0) / 6.283185307179586476925;
#if MK_PER_PHASE
    for (int p = 0; p < N_PHASES; ++p) { a.ph_lo = p; a.ph_hi = p + 1; hipLaunchKernelGGL(trunk_fwd, dim3(grid), dim3(NTHR), LDS_BYTES, stream, a); }
#else
    a.ph_lo = 0; a.ph_hi = N_PHASES;
    void* kargs[] = {&a};
    const hipError_t e = hipLaunchCooperativeKernel((const void*)trunk_fwd, dim3(grid), dim3(NTHR), kargs, LDS_BYTES, stream);
    if (e != hipSuccess) fprintf(stderr, "kernel_launch: cooperative launch failed: %s (grid %d)\n", hipGetErrorString(e), grid);
#endif
}
```

```cpp
#include <hip/hip_runtime.h>
#include <hip/hip_cooperative_groups.h>
#include <cstdio>
#include <cstdint>
#include <cmath>
namespace cg = cooperative_groups;
#ifndef A_VG_FP8
#define A_VG_FP8 1
#endif
#ifndef A_GATE_BF16
#define A_GATE_BF16 1
#endif
#ifndef MK_PER_PHASE
#define MK_PER_PHASE 0
#endif
__device__ __forceinline__ int lane_id() { int l; asm volatile("v_mbcnt_lo_u32_b32 %0, -1, 0\n\tv_mbcnt_hi_u32_b32 %0, -1, %0" : "=v"(l)); return l; }
namespace pg8 {
#define PG8_LAS __attribute__((address_space(3)))
typedef unsigned short bf16_t;
typedef short bf16x8 __attribute__((ext_vector_type(8)));
typedef float f32x4 __attribute__((ext_vector_type(4)));
typedef unsigned u32x4 __attribute__((ext_vector_type(4)));
typedef int i32x4 __attribute__((ext_vector_type(4)));
constexpr int BM = 256, BK = 64, HALF = 128, HTB = HALF * BK * 2  , STAGE_BYTES = 8 * HTB, NXCD = 8, WGM = 8;

__host__ __device__ __forceinline__ int lds_byte(int r, int c) { const int st = (r >> 4) * 2 + (c >> 5), rr = r & 15, cc = c & 31, ob = rr * 64 + cc * 2; return st * 1024 + (ob ^ (((ob >> 9) & 1) << 5)); }
__host__ __device__ __forceinline__ void stage_rc(int b, int& R, int& C) { const int st = b / 1024, sb = b % 1024, swz = sb ^ (((sb >> 9) & 1) << 5); R = (st >> 1) * 16 + swz / 64; C = (st & 1) * 32 + (swz % 64) / 2; }
__host__ __device__ __forceinline__ int perm32(int rho) { const int n = rho >> 4, i = rho & 15; return 8 * (i >> 2) + 4 * n + (i & 3); }

struct Unit { int pm, pn, k; };
struct Prob { const char* A; const char* B; int nM, nN, bdil; };
struct StaticOrder {
    int nM, nN, nwg, G, c;
    __host__ __device__ void init(int M, int N, int G_, int c_) { nM = M / BM; nN = N / BM; nwg = nM * nN; G = G_; c = c_; }
    __host__ __device__ bool next(int i, Unit& u) const {
        const long L = (long)i * G + c; if (L >= nwg) return false;
        int wgid = (int)L; { const int q = nwg / NXCD, r = nwg % NXCD, xcd = wgid % NXCD, off = wgid / NXCD; wgid = (xcd < r ? xcd * (q + 1) : r * (q + 1) + (xcd - r) * q) + off; }
        const int nig = WGM * nN, gid = wgid / nig, fm = gid * WGM, gsz = (nM - fm) < WGM ? (nM - fm) : WGM;
        u.pm = fm + ((wgid % nig) % gsz); u.pn = (wgid % nig) / gsz; return true;
    }
    __device__ __forceinline__ void a_ready(const Unit&) const {}
    __device__ __forceinline__ void done(const Unit&) const {}
};
struct MultiOrder {
    Prob p0, p1, p2, p3; int np, G, c, rowbytes;
    __device__ __forceinline__ static void map(const Prob& P, int wgid, Unit& u) {
        const int nM = P.nM, nN = P.nN, nwg = nM * nN;
        { const int q = nwg / NXCD, r = nwg % NXCD, xcd = wgid % NXCD, off = wgid / NXCD; wgid = (xcd < r ? xcd * (q + 1) : r * (q + 1) + (xcd - r) * q) + off; }
        const int nig = WGM * nN, gid = wgid / nig, fm = gid * WGM, gsz = (nM - fm) < WGM ? (nM - fm) : WGM;
        u.pm = fm + ((wgid % nig) % gsz); u.pn = (wgid % nig) / gsz;
    }
    __device__ __forceinline__ bool next(int i, Unit& u) const {
        long L = (long)i * G + c;
        { const int n = p0.nM * p0.nN; if (L < n) { map(p0, (int)L, u); u.k = 0; return true; } L -= n; }
        if (np > 1) { const int n = p1.nM * p1.nN; if (L < n) { map(p1, (int)L, u); u.k = 1; return true; } L -= n; }
        if (np > 2) { const int n = p2.nM * p2.nN; if (L < n) { map(p2, (int)L, u); u.k = 2; return true; } L -= n; }
        if (np > 3) { const int n = p3.nM * p3.nN; if (L < n) { map(p3, (int)L, u); u.k = 3; return true; } L -= n; }
        return false;
    }
    __device__ __forceinline__ const char* selA(int k) const { return k == 0 ? p0.A : (k == 1 ? p1.A : (k == 2 ? p2.A : p3.A)); }
    __device__ __forceinline__ const char* selB(int k) const { return k == 0 ? p0.B : (k == 1 ? p1.B : (k == 2 ? p2.B : p3.B)); }
    __device__ __forceinline__ int bdil(const Unit& u) const { return u.k == 0 ? p0.bdil : (u.k == 1 ? p1.bdil : (u.k == 2 ? p2.bdil : p3.bdil)); }
    __device__ __forceinline__ const char* a_base(const Unit& u) const { return selA(u.k) + (size_t)u.pm * 256 * rowbytes; }
    __device__ __forceinline__ const char* b_base(const Unit& u) const { const int d = bdil(u), t8 = u.pn & 7; const int r = (u.pn >> 3) * 2048 + (d == 1 ? 256 * t8 : (d == 4 ? 1024 * (t8 & 1) + (t8 >> 1) : 2 * t8)); return selB(u.k) + (size_t)r * rowbytes; }
    __device__ __forceinline__ void a_ready(const Unit&) const {}
    __device__ __forceinline__ void done(const Unit&) const {}
};


__device__ __forceinline__ unsigned cvt_pk_bf16(float lo, float hi) { unsigned r; asm volatile("v_cvt_pk_bf16_f32 %0, %1, %2" : "=v"(r) : "v"(lo), "v"(hi)); return r; }
typedef float f32x2 __attribute__((ext_vector_type(2)));
__device__ __forceinline__ f32x2 gelu_pk(f32x2 v) {
    const f32x2 av = __builtin_elementwise_abs(v), d = av * 0.2316418882f + 1.0f;
    f32x2 t; t.x = __builtin_amdgcn_rcpf(d.x); t.y = __builtin_amdgcn_rcpf(d.y);
    f32x2 q = t * 0.5307027145f + (-0.7265760135f); q = q * t + 0.7107068705f; q = q * t + (-0.142248368f); q = q * t + 0.127414796f; q = q * t;
    const f32x2 s = (v * v) * (-0.72134752044f);
    f32x2 e; e.x = __builtin_amdgcn_exp2f(s.x); e.y = __builtin_amdgcn_exp2f(s.y);
    const f32x2 m = v * (q * e), r = v - m;
    f32x2 o; o.x = v.x < 0.f ? m.x : r.x; o.y = v.y < 0.f ? m.y : r.y; return o;
}

constexpr float C2 = 0.08838834764831845f * 1.4426950408889634f;
__device__ __forceinline__ float silu_f(float x) { return x * __builtin_amdgcn_rcpf(1.0f + __builtin_amdgcn_exp2f(-1.4426950408889634f * x)); }
__device__ __forceinline__ u32x4 pack8(const f32x4& v0, const f32x4& v1) { u32x4 w; w.x = cvt_pk_bf16(v0[0], v0[1]); w.y = cvt_pk_bf16(v0[2], v0[3]); w.z = cvt_pk_bf16(v1[0], v1[1]); w.w = cvt_pk_bf16(v1[2], v1[3]); return w; }
__device__ __forceinline__ void gelu8(f32x4& v0, f32x4& v1) { f32x2 a = gelu_pk((f32x2){v0[0], v0[1]}), b = gelu_pk((f32x2){v0[2], v0[3]}), c = gelu_pk((f32x2){v1[0], v1[1]}), d = gelu_pk((f32x2){v1[2], v1[3]});
    v0 = (f32x4){a.x, a.y, b.x, b.y}; v1 = (f32x4){c.x, c.y, d.x, d.y}; }

struct EpiA1 {
    static constexpr bool PERM = true, AFTER_DRAIN = false;
    bf16_t* QK; bf16_t* GATE; const float* COS; const float* SIN; float osc; int pn0; const float* rss;
    __device__ __forceinline__ void operator()(const f32x4 (&acc)[2][2][4][2], const Unit& u, int wr, int wc, int fr, int fq) const {
        const int pn = u.pn + pn0; const int rowb = u.pm * BM + wr * 64 + fr;
        if (pn >= 48) {
            const int col0 = (pn - 48) * 256 + wc * 32 + 8 * fq;
#pragma unroll
            for (int ai = 0; ai < 2; ++ai)
#pragma unroll
                for (int m = 0; m < 4; ++m) { bf16_t* rowp = GATE + (size_t)(rowb + ai * HALF + m * 16) * 2048 + col0; const float rs = osc * __builtin_amdgcn_rsqf(rss[rowb + ai * HALF + m * 16] * (1.0f / 2048) + 1e-6f);
#pragma unroll
                    for (int bj = 0; bj < 2; ++bj) { f32x4 v0 = acc[ai][bj][m][0] * rs, v1 = acc[ai][bj][m][1] * rs;
#pragma unroll
                        for (int i = 0; i < 4; ++i) { v0[i] = silu_f(v0[i]); v1[i] = silu_f(v1[i]); }
                        *(u32x4*)(rowp + bj * HALF) = pack8(v0, v1); } }
        } else {
            const int g = pn >> 4, qk = (pn >> 3) & 1, hp = pn & 7, dsh = 2 * g, dm1 = (1 << dsh) - 1;
            const float sc = osc; const float sgn = fq < 2 ? -1.0f : 1.0f; const int e0 = wc * 32 + 8 * fq;
#pragma unroll
            for (int ai = 0; ai < 2; ++ai)
#pragma unroll
                for (int m = 0; m < 4; ++m) { const int row = rowb + ai * HALF + m * 16, b = row >> 11, s = row & 2047, p = ((s & dm1) << (11 - dsh)) | (s >> dsh);
                    f32x4 c0, c1, s0, s1; const float scr = sc * __builtin_amdgcn_rsqf(rss[row] * (1.0f / 2048) + 1e-6f);
                    if (wc == 0) { const float* cp = COS + (size_t)row * 16 + 8 * (fq & 1); const float* sp = SIN + (size_t)row * 16 + 8 * (fq & 1);
                        c0 = *(const f32x4*)cp; c1 = *(const f32x4*)(cp + 4); s0 = *(const f32x4*)sp; s1 = *(const f32x4*)(sp + 4);
                        }
#pragma unroll
                    for (int bj = 0; bj < 2; ++bj) { f32x4 v0 = acc[ai][bj][m][0], v1 = acc[ai][bj][m][1];
                        if (wc == 0) {
#pragma unroll
                            for (int i = 0; i < 4; ++i) { const float p0 = __shfl_xor(v0[i], 32), p1 = __shfl_xor(v1[i], 32);
                                v0[i] = v0[i] * c0[i] + sgn * p0 * s0[i]; v1[i] = v1[i] * c1[i] + sgn * p1 * s1[i]; } }
                        v0 = v0 * scr; v1 = v1 * scr;
                        unsigned char* dst = (unsigned char*)QK + ((((size_t)((g * 2 + qk) * 4 + b) * 16 + (2 * hp + bj)) * 2048 + p) * 128 + e0);
                        int w0 = 0, w1 = 0; w0 = __builtin_amdgcn_cvt_pk_fp8_f32(v0[0], v0[1], w0, false); w0 = __builtin_amdgcn_cvt_pk_fp8_f32(v0[2], v0[3], w0, true);
                        w1 = __builtin_amdgcn_cvt_pk_fp8_f32(v1[0], v1[1], w1, false); w1 = __builtin_amdgcn_cvt_pk_fp8_f32(v1[2], v1[3], w1, true);
                        *(unsigned long long*)dst = ((unsigned long long)(unsigned)w1 << 32) | (unsigned)w0; } }
        }
    }
};
struct EpiB1 {
    static constexpr bool PERM = true, AFTER_DRAIN = false;
    bf16_t* U; bf16_t* ZS; const float* rss;
    __device__ __forceinline__ void operator()(const f32x4 (&acc)[2][2][4][2], const Unit& u, int wr, int wc, int fr, int fq) const {
        const int pn = u.pn; const int rowb = u.pm * BM + wr * 64 + fr; const bool isz = pn >= 8;
        bf16_t* base = isz ? ZS : U; const int col0 = (pn & 7) * 256 + wc * 32 + 8 * fq;
#pragma unroll
        for (int ai = 0; ai < 2; ++ai)
#pragma unroll
            for (int m = 0; m < 4; ++m) { bf16_t* rowp = base + (size_t)(rowb + ai * HALF + m * 16) * 2048 + col0; const float rs = __builtin_amdgcn_rsqf(rss[rowb + ai * HALF + m * 16] * (1.0f / 2048) + 1e-6f);
#pragma unroll
                for (int bj = 0; bj < 2; ++bj) { f32x4 v0 = acc[ai][bj][m][0] * rs, v1 = acc[ai][bj][m][1] * rs;
                    if (isz) {
#pragma unroll
                        for (int i = 0; i < 4; ++i) { v0[i] = silu_f(v0[i]); v1[i] = silu_f(v1[i]); }
                    } else gelu8(v0, v1);
                    *(u32x4*)(rowp + bj * HALF) = pack8(v0, v1); } }
    }
};
struct EpiPlain {
    static constexpr bool PERM = true, AFTER_DRAIN = false;
    bf16_t* O; float osc; const float* rss; int dsh;
    __device__ __forceinline__ void operator()(const f32x4 (&acc)[2][2][4][2], const Unit& u, int wr, int wc, int fr, int fq) const {
        const int rowb = u.pm * BM + wr * 64 + fr; const int col0 = u.pn * BM + wc * 32 + 8 * fq;
#pragma unroll
        for (int bj = 0; bj < 2; ++bj) { const int c = col0 + bj * HALF, p = c & 2047, Lm1 = (2048 >> dsh) - 1; const float* rp = rss + (c & ~2047) + ((p & Lm1) << dsh) + (p >> (11 - dsh));
            f32x4 r0, r1;
#pragma unroll
            for (int k = 0; k < 4; ++k) { r0[k] = osc * __builtin_amdgcn_rsqf(rp[k << dsh] * (1.0f / 2048) + 1e-6f); r1[k] = osc * __builtin_amdgcn_rsqf(rp[(k + 4) << dsh] * (1.0f / 2048) + 1e-6f); }
#pragma unroll
            for (int ai = 0; ai < 2; ++ai)
#pragma unroll
                for (int m = 0; m < 4; ++m) { bf16_t* rowp = O + (size_t)((c >> 5)) * 65536 + (size_t)(rowb + ai * HALF + m * 16) * 32 + (c & 31);
                    *(u32x4*)rowp = pack8(acc[ai][bj][m][0] * r0, acc[ai][bj][m][1] * r1); } }
    }
};
struct EpiB2 {
    static constexpr bool PERM = true, AFTER_DRAIN = false;
    bf16_t* VT; float* STATS; const float* rss;
    __device__ __forceinline__ static float row16_sum(float v) {
        v += __builtin_bit_cast(float, __builtin_amdgcn_update_dpp(0, __builtin_bit_cast(int, v), 0xB1, 0xf, 0xf, true));
        v += __builtin_bit_cast(float, __builtin_amdgcn_update_dpp(0, __builtin_bit_cast(int, v), 0x4E, 0xf, 0xf, true));
        v += __builtin_bit_cast(float, __builtin_amdgcn_update_dpp(0, __builtin_bit_cast(int, v), 0x141, 0xf, 0xf, true));
        v += __builtin_bit_cast(float, __builtin_amdgcn_update_dpp(0, __builtin_bit_cast(int, v), 0x140, 0xf, 0xf, true));
        return v; }
    __device__ __forceinline__ void operator()(const f32x4 (&acc)[2][2][4][2], const Unit& u, int wr, int wc, int fr, int fq) const {
        const int rowb = u.pm * BM + wr * 64 + fr; const int col0 = u.pn * BM + wc * 32 + 8 * fq;
#pragma unroll
        for (int bj = 0; bj < 2; ++bj) {
            float s1[8], s2[8]; f32x4 r0 = *(const f32x4*)(rss + col0 + bj * HALF), r1 = *(const f32x4*)(rss + col0 + bj * HALF + 4);
#pragma unroll
            for (int k = 0; k < 4; ++k) { r0[k] = __builtin_amdgcn_rsqf(r0[k] * (1.0f / 2048) + 1e-6f); r1[k] = __builtin_amdgcn_rsqf(r1[k] * (1.0f / 2048) + 1e-6f); }
#pragma unroll
            for (int k = 0; k < 8; ++k) { s1[k] = 0.f; s2[k] = 0.f; }
#pragma unroll
            for (int ai = 0; ai < 2; ++ai)
#pragma unroll
                for (int m = 0; m < 4; ++m) { bf16_t* rowp = VT + (size_t)((col0 >> 5) + 4 * bj) * 65536 + (size_t)(rowb + ai * HALF + m * 16) * 32 + (col0 & 31);
                    f32x4 v0 = acc[ai][bj][m][0] * r0, v1 = acc[ai][bj][m][1] * r1; gelu8(v0, v1);
#pragma unroll
                    for (int i = 0; i < 4; ++i) { s1[i] += v0[i]; s2[i] += v0[i] * v0[i]; s1[4 + i] += v1[i]; s2[4 + i] += v1[i] * v1[i]; }
                    *(u32x4*)rowp = pack8(v0, v1); }
#pragma unroll
            for (int k = 0; k < 8; ++k) { const float a = row16_sum(s1[k]), b = row16_sum(s2[k]);
                if (fr == 0) { float* sp = STATS + 2 * (size_t)(col0 + bj * HALF + k); atomicAdd(sp, a); atomicAdd(sp + 1, b); } }
            asm volatile("" ::: "memory");
        }
    }
};
struct EpiAllA {
    static constexpr bool PERM = true, AFTER_DRAIN = false;
    EpiA1 e1; EpiPlain ev; int kv0;
    __device__ __forceinline__ void operator()(const f32x4 (&acc)[2][2][4][2], const Unit& u, int wr, int wc, int fr, int fq) const {
        if (u.k < kv0) e1(acc, u, wr, wc, fr, fq);
        else { EpiPlain e = ev; e.O += (size_t)(u.k - kv0) * 2048 * 8192; e.dsh = 2 * (u.k - kv0); e(acc, u, wr, wc, fr, fq); }
    }
};
struct EpiAllB {
    static constexpr bool PERM = true, AFTER_DRAIN = false;
    EpiB1 e1; EpiB2 e2;
    __device__ __forceinline__ void operator()(const f32x4 (&acc)[2][2][4][2], const Unit& u, int wr, int wc, int fr, int fq) const {
        if (u.k == 0) e1(acc, u, wr, wc, fr, fq); else e2(acc, u, wr, wc, fr, fq);
    }
};
struct EpiOut {
    static constexpr bool PERM = true, AFTER_DRAIN = false;
    const float* base; float* out; const float* gn; bf16_t* xb; unsigned char* x8; float* rss;
    __device__ __forceinline__ void operator()(const f32x4 (&acc)[2][2][4][2], const Unit& u, int wr, int wc, int fr, int fq) const {
        const int rowb = u.pm * BM + wr * 64 + fr; const int col0 = u.pn * BM + wc * 32 + 8 * fq;
        f32x4 gv[2][2];
        if (gn) {
#pragma unroll
            for (int bj = 0; bj < 2; ++bj)
#pragma unroll
                for (int n = 0; n < 2; ++n) gv[bj][n] = *(const f32x4*)(gn + col0 + bj * HALF + n * 4); }
#pragma unroll
        for (int ai = 0; ai < 2; ++ai)
#pragma unroll
            for (int m = 0; m < 4; ++m) { const int row = rowb + ai * HALF + m * 16; const size_t off = (size_t)row * 2048 + col0; float ss = 0.f;
#pragma unroll
                for (int bj = 0; bj < 2; ++bj) { const f32x4 b0 = *(const f32x4*)(base + off + bj * HALF), b1 = *(const f32x4*)(base + off + bj * HALF + 4);
                    const f32x4 x0 = b0 + acc[ai][bj][m][0], x1 = b1 + acc[ai][bj][m][1];
                    *(f32x4*)(out + off + bj * HALF) = x0; *(f32x4*)(out + off + bj * HALF + 4) = x1;
                    if (gn) { ss += ((x0[0] * x0[0] + x0[1] * x0[1]) + (x0[2] * x0[2] + x0[3] * x0[3])) + ((x1[0] * x1[0] + x1[1] * x1[1]) + (x1[2] * x1[2] + x1[3] * x1[3]));
                        const f32x4 y0 = x0 * gv[bj][0], y1 = x1 * gv[bj][1];
                        *(u32x4*)(xb + off + bj * HALF) = pack8(y0, y1);
                        if (x8) { int w0 = 0, w1 = 0; w0 = __builtin_amdgcn_cvt_pk_fp8_f32(y0[0], y0[1], w0, false); w0 = __builtin_amdgcn_cvt_pk_fp8_f32(y0[2], y0[3], w0, true);
                            w1 = __builtin_amdgcn_cvt_pk_fp8_f32(y1[0], y1[1], w1, false); w1 = __builtin_amdgcn_cvt_pk_fp8_f32(y1[2], y1[3], w1, true);
                            *(unsigned long long*)(x8 + off + bj * HALF) = ((unsigned long long)(unsigned)w1 << 32) | (unsigned)w0; } } }
                if (gn) { ss += __shfl_xor(ss, 16); ss += __shfl_xor(ss, 32); if (fq == 0) atomicAdd(rss + row, ss); } }
    }
};
template <class Epi, class Sched, bool ALIGN_EPI = false, bool SP2 = false, bool F8 = false>
__device__ __forceinline__ void gemm_phase(PG8_LAS unsigned char* lds, const int Kel, const Sched& S, const Epi& E, const int wave_) {
    const int tid = wave_ * 64 + ::lane_id(); const int wid = __builtin_amdgcn_readfirstlane(tid >> 6), lane = tid & 63, wr = wid >> 2, wc = wid & 3, fr = lane & 15, fq = lane >> 4;
    const int K = F8 ? Kel / 2 : Kel, nt = K / BK;
    unsigned voffA[2], voffB[2]; size_t hstepB;
#pragma unroll
    for (int i = 0; i < 2; ++i) { int R, C; stage_rc(tid * 16 + i * 8192, R, C); voffA[i] = (unsigned)(R * K + C) * 2u; }
#define PG8_SETB(dil) do { const int d_ = (dil); _Pragma("unroll") for (int i = 0; i < 2; ++i) { int R, C; stage_rc(tid * 16 + i * 8192, R, C); const int Rb = Epi::PERM ? ((R & ~31) + perm32(R & 31)) : R; \
        voffB[i] = (unsigned)(Rb * d_ * K + C) * 2u; } hstepB = (d_ == 16) ? (size_t)K * 2 : (size_t)HALF * d_ * K * 2; } while (0)
    const size_t kstep = (size_t)(BK * 2);
    const size_t hstep = (size_t)HALF * K * 2;
    const size_t tstep = 2 * hstep;
    const unsigned ldsw = (unsigned)wid * 1024u;
    const int aoff = lds_byte(wr * 64 + fr, fq * 8), boff = lds_byte(wc * 32 + fr, fq * 8);
#define PG8_SA(b, h) (((b) * 2 + (h)) * HTB)
#define PG8_SB(b, h) ((4 + (b) * 2 + (h)) * HTB)
#define PG8_STAGE(bufoff, gbase, voff) do { _Pragma("unroll") for (int _i = 0; _i < 2; ++_i) \
        __builtin_amdgcn_global_load_lds((const unsigned*)((const char*)(gbase) + (voff)[_i]), (PG8_LAS unsigned*)(lds + (bufoff) + ldsw + _i * 8192), 16, 0, 0); } while (0)
#define PG8_LDA(dst, b, h) do { _Pragma("unroll") for (int m = 0; m < 4; ++m) _Pragma("unroll") for (int k = 0; k < 2; ++k) dst[m][k] = *(const PG8_LAS bf16x8*)(lds + PG8_SA(b, h) + aoff + m * 2048 + k * 1024); } while (0)
#define PG8_LDB(dst, b, h) do { _Pragma("unroll") for (int n = 0; n < 2; ++n) _Pragma("unroll") for (int k = 0; k < 2; ++k) dst[n][k] = *(const PG8_LAS bf16x8*)(lds + PG8_SB(b, h) + boff + n * 2048 + k * 1024); } while (0)
#define PG8_CAT8(x) __builtin_shufflevector(__builtin_bit_cast(i32x4, (x)[0]), __builtin_bit_cast(i32x4, (x)[1]), 0, 1, 2, 3, 4, 5, 6, 7)
#define PG8_MMA(ai, bj, At, Bt) do { __builtin_amdgcn_s_setprio(1); \
        if constexpr (F8) { _Pragma("unroll") for (int m = 0; m < 4; ++m) _Pragma("unroll") for (int n = 0; n < 2; ++n) \
            asm volatile("v_mfma_f32_16x16x128_f8f6f4 %0, %1, %2, %0" : "+v"(acc[ai][bj][m][n]) : "v"(PG8_CAT8(Bt[n])), "v"(PG8_CAT8(At[m]))); } \
        else { _Pragma("unroll") for (int m = 0; m < 4; ++m) _Pragma("unroll") for (int n = 0; n < 2; ++n) _Pragma("unroll") for (int k = 0; k < 2; ++k) \
            acc[ai][bj][m][n] = __builtin_amdgcn_mfma_f32_16x16x32_bf16(Bt[n][k], At[m][k], acc[ai][bj][m][n], 0, 0, 0); } \
        __builtin_amdgcn_s_setprio(0); } while (0)
#define PG8_WAIT_V(n) asm volatile("s_waitcnt vmcnt(" #n ")" ::: "memory")
#define PG8_WAIT_L(n) asm volatile("s_waitcnt lgkmcnt(" #n ")" ::: "memory")
#define PG8_BAR __builtin_amdgcn_s_barrier()
#define PG8_SCHED __builtin_amdgcn_sched_barrier(0)
    Unit cur, nxt; int ui = 0;
    if (!S.next(0, cur)) return;
    f32x4 acc[2][2][4][2];
#pragma unroll
    for (int a = 0; a < 2; ++a)
#pragma unroll
        for (int b = 0; b < 2; ++b)
#pragma unroll
            for (int m = 0; m < 4; ++m)
#pragma unroll
                for (int n = 0; n < 2; ++n) acc[a][b][m][n] = (f32x4){0.f, 0.f, 0.f, 0.f};
    bf16x8 At[4][2], B0[2][2], B1[2][2];
    const char* cA = S.a_base(cur); const char* cB = S.b_base(cur); PG8_SETB(S.bdil(cur));
    S.a_ready(cur);
    if constexpr (SP2) {
        PG8_STAGE(PG8_SB(0, 0), cB, voffB); PG8_STAGE(PG8_SB(0, 1), cB + hstepB, voffB); PG8_STAGE(PG8_SA(0, 0), cA, voffA); PG8_STAGE(PG8_SA(0, 1), cA + hstep, voffA);
        if (wr == 1) PG8_BAR;
        PG8_WAIT_V(2); PG8_BAR;
        PG8_STAGE(PG8_SB(1, 0), cB + kstep, voffB); PG8_STAGE(PG8_SA(1, 0), cA + kstep, voffA); PG8_STAGE(PG8_SB(1, 1), cB + hstepB + kstep, voffB);
        PG8_WAIT_V(6); PG8_BAR;
    } else {
        PG8_STAGE(PG8_SB(0, 0), cB, voffB); PG8_STAGE(PG8_SA(0, 0), cA, voffA); PG8_STAGE(PG8_SB(0, 1), cB + hstepB, voffB); PG8_STAGE(PG8_SA(0, 1), cA + hstep, voffA);
        if (wr == 1) PG8_BAR;
        PG8_WAIT_V(4); PG8_BAR;
        PG8_STAGE(PG8_SB(1, 0), cB + kstep, voffB); PG8_STAGE(PG8_SA(1, 0), cA + kstep, voffA); PG8_STAGE(PG8_SB(1, 1), cB + hstepB + kstep, voffB);
        PG8_WAIT_V(6); PG8_BAR;
    }
    for (;;) {
        const bool has_next = S.next(ui + 1, nxt);
        const char* nA = has_next ? S.a_base(nxt) : cA; const char* nB = has_next ? S.b_base(nxt) : cB;
        for (int t = 0; t < nt; t += 2) {
            const bool last = (t == nt - 2);
            const char* a1 = cA + (size_t)(t + 1) * kstep;
            const char* a2 = last ? nA : cA + (size_t)(t + 2) * kstep; const char* b2 = last ? nB : cB + (size_t)(t + 2) * kstep;
            const char* a3 = a2 + kstep; const char* b3 = b2 + kstep;
            if (last && has_next) { S.a_ready(nxt); PG8_SETB(S.bdil(nxt)); }
            if constexpr (SP2) {
            PG8_LDB(B0, 0, 0); PG8_LDB(B1, 0, 1); PG8_SCHED; PG8_LDA(At, 0, 0); PG8_STAGE(PG8_SA(1, 1), a1 + hstep, voffA);
            PG8_WAIT_V(8); PG8_WAIT_L(0); PG8_BAR; PG8_MMA(0, 0, At, B0); PG8_MMA(0, 1, At, B1); PG8_BAR; PG8_SCHED;
            PG8_LDA(At, 0, 1); PG8_STAGE(PG8_SB(0, 0), b2, voffB); PG8_STAGE(PG8_SB(0, 1), b2 + hstepB, voffB); PG8_STAGE(PG8_SA(0, 0), a2, voffA);
            PG8_WAIT_V(8); PG8_WAIT_L(0); PG8_BAR; PG8_MMA(1, 0, At, B0); PG8_MMA(1, 1, At, B1); PG8_BAR; PG8_SCHED;
            PG8_LDB(B0, 1, 0); PG8_LDB(B1, 1, 1); PG8_SCHED; PG8_LDA(At, 1, 0); PG8_STAGE(PG8_SA(0, 1), a2 + hstep, voffA);
            PG8_WAIT_V(8); PG8_WAIT_L(0); PG8_BAR; PG8_MMA(0, 0, At, B0); PG8_MMA(0, 1, At, B1); PG8_BAR; PG8_SCHED;
            PG8_LDA(At, 1, 1); PG8_STAGE(PG8_SB(1, 0), b3, voffB); PG8_STAGE(PG8_SB(1, 1), b3 + hstepB, voffB); PG8_STAGE(PG8_SA(1, 0), a3, voffA);
            PG8_WAIT_V(8); PG8_WAIT_L(0); PG8_BAR; PG8_MMA(1, 0, At, B0); PG8_MMA(1, 1, At, B1); PG8_BAR; PG8_SCHED;
            } else {
            PG8_LDB(B0, 0, 0); PG8_SCHED; PG8_LDA(At, 0, 0); PG8_STAGE(PG8_SA(1, 1), a1 + hstep, voffA);
            PG8_WAIT_L(8); PG8_BAR; PG8_WAIT_L(0); PG8_MMA(0, 0, At, B0); PG8_BAR; PG8_SCHED;
            PG8_LDB(B1, 0, 1); PG8_STAGE(PG8_SB(0, 0), b2, voffB);
            PG8_BAR; PG8_WAIT_L(0); PG8_MMA(0, 1, At, B1); PG8_BAR;
            PG8_LDA(At, 0, 1); PG8_STAGE(PG8_SA(0, 0), a2, voffA);
            PG8_BAR; PG8_WAIT_L(0); PG8_MMA(1, 0, At, B0); PG8_BAR; PG8_SCHED;
            PG8_STAGE(PG8_SB(0, 1), b2 + hstepB, voffB);
            PG8_WAIT_V(6); PG8_BAR; PG8_MMA(1, 1, At, B1); PG8_BAR;
            PG8_LDB(B0, 1, 0); PG8_SCHED; PG8_LDA(At, 1, 0); PG8_STAGE(PG8_SA(0, 1), a2 + hstep, voffA);
            PG8_WAIT_L(8); PG8_BAR; PG8_WAIT_L(0); PG8_MMA(0, 0, At, B0); PG8_BAR; PG8_SCHED;
            PG8_LDB(B1, 1, 1); PG8_STAGE(PG8_SB(1, 0), b3, voffB);
            PG8_BAR; PG8_WAIT_L(0); PG8_MMA(0, 1, At, B1); PG8_BAR;
            PG8_LDA(At, 1, 1); PG8_STAGE(PG8_SA(1, 0), a3, voffA);
            PG8_BAR; PG8_WAIT_L(0); PG8_MMA(1, 0, At, B0); PG8_BAR; PG8_SCHED;
            PG8_STAGE(PG8_SB(1, 1), b3 + hstepB, voffB);
            PG8_WAIT_V(6); PG8_BAR; PG8_MMA(1, 1, At, B1); PG8_BAR;
            }
        }
        if constexpr (F8) asm volatile("s_nop 15\n\ts_nop 15" ::: "memory");
        if constexpr (ALIGN_EPI) { if (wr == 0) PG8_BAR; }
        if constexpr (!Epi::AFTER_DRAIN) { E(acc, cur, wr, wc, fr, fq); S.done(cur); }
        if (!has_next) break;
#pragma unroll
        for (int a = 0; a < 2; ++a)
#pragma unroll
            for (int b = 0; b < 2; ++b)
#pragma unroll
                for (int m = 0; m < 4; ++m)
#pragma unroll
                    for (int n = 0; n < 2; ++n) acc[a][b][m][n] = (f32x4){0.f, 0.f, 0.f, 0.f};
        cur = nxt; cA = nA; cB = nB; ++ui;
        if constexpr (ALIGN_EPI) { if (wr == 1) PG8_BAR; }
    }
    PG8_WAIT_V(0);
    if constexpr (!ALIGN_EPI) { if (wr == 0) PG8_BAR; }
    PG8_BAR;
    if constexpr (Epi::AFTER_DRAIN) { E.fused(acc, cur, wr, wc, fr, fq, lds, wid, lane); S.done(cur); }
#undef PG8_SA
#undef PG8_SB
#undef PG8_STAGE
#undef PG8_LDA
#undef PG8_LDB
#undef PG8_MMA
#undef PG8_SETB
#undef PG8_CAT8
#undef PG8_WAIT_V
#undef PG8_WAIT_L
#undef PG8_BAR
#undef PG8_SCHED
}
}

constexpr int NWAVES = 8, NTHR = NWAVES * 64;
constexpr int BATCH = 4, SEQ = 2048, DM = 2048, MTOK = BATCH * SEQ;
constexpr int A_IN = 20480, B_IN = 6144, NA1 = 14336;
constexpr float RMS_EPS = 1e-6f, LN_EPS = 1e-5f;
constexpr size_t MiB = 1u << 20;
constexpr size_t SZ_ACT = (size_t)MTOK * DM * 2;
constexpr size_t WS_WAIN = 2 * MiB;
constexpr size_t WS_WAOUT = WS_WAIN + 2 * (size_t)A_IN * DM * 2;
constexpr size_t WS_WBIN = WS_WAOUT + 2 * (size_t)DM * DM * 2;
constexpr size_t WS_WBOUT = WS_WBIN + 2 * (size_t)B_IN * DM * 2;
constexpr size_t WS_WM = WS_WBOUT + 2 * (size_t)DM * DM * 2;
constexpr size_t WS_COS = WS_WM + 2 * 16 * 128 * 128 * 2;
constexpr size_t WS_SIN = WS_COS + (size_t)MTOK * 16 * 4;
constexpr size_t WS_STATS = WS_SIN + (size_t)MTOK * 16 * 4;
constexpr size_t WS_LSE = WS_STATS + 2 * (size_t)MTOK * 2 * 4;
constexpr size_t WS_X = WS_LSE + 3 * (size_t)MTOK * 16 * 4;
constexpr size_t WS_XN = WS_X + 2 * SZ_ACT;
constexpr size_t WS_QK = WS_XN + SZ_ACT;
constexpr size_t WS_VT = WS_QK + 6 * SZ_ACT;
constexpr size_t WS_GATE = WS_VT + 3 * SZ_ACT;
constexpr size_t WS_OG = WS_GATE + SZ_ACT;
constexpr size_t WS_Y = WS_OG + 3 * SZ_ACT;
constexpr size_t WS_XN8 = WS_Y + SZ_ACT;
constexpr size_t WS_RSS = WS_XN8 + SZ_ACT / 2;
constexpr size_t WS_END = WS_RSS + 4 * (size_t)MTOK * 4;
constexpr size_t WS_BAR = 65536;
constexpr int LDS_BYTES = 147456;

typedef unsigned short bf16;
typedef unsigned v4u __attribute__((ext_vector_type(4)));
typedef unsigned v2u __attribute__((ext_vector_type(2)));
typedef float f32x4 __attribute__((ext_vector_type(4)));
typedef float f32x2v __attribute__((ext_vector_type(2)));
typedef float f32x16 __attribute__((ext_vector_type(16)));
typedef short bf16x8 __attribute__((ext_vector_type(8)));
typedef __bf16 bf16x2_t __attribute__((ext_vector_type(2)));
#define LAS __attribute__((address_space(3)))
#define MFMA32(a, b, c) __builtin_amdgcn_mfma_f32_32x32x16_bf16((a), (b), (c), 0, 0, 0)
__device__ __forceinline__ unsigned pk2(float lo, float hi) { f32x2v v = {lo, hi}; bf16x2_t b = __builtin_convertvector(v, bf16x2_t); return __builtin_bit_cast(unsigned, b); }
__device__ __forceinline__ float bflo(unsigned w) { return __builtin_bit_cast(float, w << 16); }
__device__ __forceinline__ float bfhi(unsigned w) { return __builtin_bit_cast(float, w & 0xffff0000u); }
__device__ __forceinline__ float wave_sum(float v) {
#pragma unroll
    for (int o = 1; o < 64; o <<= 1) v += __shfl_xor(v, o);
    return v;
}

#define XB_TMO      128
#define XB_XCNT(j)  (256  + 64 * (j))
#define XB_XSUB(j)  (1280 + 64 * (j))
#define XB_XGEN(j)  (2304 + 64 * (j))
#define XB_TOP      3328
#define XB_TOPGEN   3392
#define XCD_BAR_WORDS 3456
#define XB_SPIN_CAP (1u << 18)

__device__ __forceinline__ unsigned xb_ld(unsigned* p)              { return __hip_atomic_load(p, __ATOMIC_RELAXED, __HIP_MEMORY_SCOPE_AGENT); }
__device__ __forceinline__ unsigned xb_add(unsigned* p, unsigned v) { return __hip_atomic_fetch_add(p, v, __ATOMIC_RELAXED, __HIP_MEMORY_SCOPE_AGENT); }
__device__ __forceinline__ unsigned xb_xcc_id() { return (unsigned)__builtin_amdgcn_s_getreg((3 << 11) | 20) & 0xFu; }
#define XB_SPIN(cond, bar) do { unsigned _sp = 0; while (cond) { __builtin_amdgcn_s_sleep(1); \
    if ((++_sp & 255u) == 0u) { if (xb_ld(&(bar)[XB_TMO])) break; if (_sp > XB_SPIN_CAP) { atomicAdd(&(bar)[XB_TMO], 1u); break; } } } } while (0)

struct XcdBarrier {
    int w;
    unsigned* bar; unsigned x;
    volatile LAS unsigned* st;
};

__device__ __forceinline__ XcdBarrier xcd_barrier_post(unsigned* bar, volatile LAS unsigned* st, int w) {
    XcdBarrier b; b.w = w; b.bar = bar; b.x = xb_xcc_id(); b.st = st;
    if (w == 0 && lane_id() == 0) (void)xb_add(&bar[XB_XCNT(b.x)], 1u);
    return b;
}
__device__ __forceinline__ void xcd_barrier_complete(unsigned* bar, unsigned x, unsigned& nloc, unsigned& nx) {
    const unsigned G = gridDim.x * gridDim.y * gridDim.z;
    unsigned sum, cnt, mine, sp = 0u;
    for (;;) {
        sum = 0u; cnt = 0u; mine = 0u;
#pragma unroll
        for (unsigned j = 0; j < 16; ++j) { const unsigned c = xb_ld(&bar[XB_XCNT(j)]); sum += c; cnt += (c > 0u) ? 1u : 0u; mine = (j == x) ? c : mine; }
        if (sum == G) break;
        __builtin_amdgcn_s_sleep(1);
        if ((++sp & 255u) == 0u) { if (xb_ld(&bar[XB_TMO])) break; if (sp > XB_SPIN_CAP) { atomicAdd(&bar[XB_TMO], 1u); break; } }
    }
    nloc = mine > 0u ? mine : 1u; nx = cnt > 0u ? cnt : 1u;
}

__device__ __forceinline__ void xcd_barrier(const XcdBarrier& b) {
    asm volatile("s_waitcnt vmcnt(0)" ::: "memory");
    __syncthreads();
    if (b.w == 0 && lane_id() == 0) {
        unsigned* bar = b.bar;
        __builtin_amdgcn_s_waitcnt(0);
        unsigned nloc = b.st[0], nx = b.st[1];
        if (nloc == 0u) { xcd_barrier_complete(bar, b.x, nloc, nx); b.st[0] = nloc; b.st[1] = nx; }
        const unsigned old = xb_add(&bar[XB_XSUB(b.x)], 1u);
        const unsigned gen = old / nloc;
        if (old + 1u == (gen + 1u) * nloc) {
            __builtin_amdgcn_fence(__ATOMIC_RELEASE, "agent");
            asm volatile("s_waitcnt vmcnt(0)" ::: "memory");
            const unsigned og = xb_add(&bar[XB_TOP], 1u);
            const unsigned tg = og / nx;
            if (og + 1u == (tg + 1u) * nx) xb_add(&bar[XB_TOPGEN], 1u);
            else XB_SPIN(xb_ld(&bar[XB_TOPGEN]) == tg, bar);
            __builtin_amdgcn_fence(__ATOMIC_ACQUIRE, "agent");
            xb_add(&bar[XB_XGEN(b.x)], 1u);
            asm volatile("s_waitcnt vmcnt(0)" ::: "memory");
        } else {
            XB_SPIN(xb_ld(&bar[XB_XGEN(b.x)]) == gen, bar);
            __builtin_amdgcn_fence(__ATOMIC_ACQUIRE, "agent");
            asm volatile("s_waitcnt vmcnt(0)" ::: "memory");
        }
    }
    __syncthreads();
}

__device__ __forceinline__ int launder_s(int v) { asm volatile("" : "+s"(v)); return v; }
__device__ __forceinline__ int launder(int v) { asm volatile("" : "+v"(v)); return v; }
struct Args {
    const float* x; const int* pos; const float* a_norm_g; const float* a_w_in; const float* a_w_out; const float* b_norm_g; const float* b_w_in;
    const float* b_ln_g; const float* b_ln_b; const float* b_w_s; const float* b_b_s; const float* b_w_out; const float* final_g;
    float* out; unsigned char* ws; double invf[16];
    int ph_lo, ph_hi;
};

__device__ __forceinline__ void p0_transpose_item(const float* W, int K, int N, bf16* WT, int row_off, LAS float* scr, int kb, int nb, int lane) {
    const int k0 = 64 * kb, n0 = 32 * nb;
    float wv[32];
#pragma unroll
    for (int i = 0; i < 32; ++i) wv[i] = W[(size_t)(k0 + 2 * i + (lane >> 5)) * N + n0 + (lane & 31)];
#pragma unroll
    for (int i = 0; i < 32; ++i) scr[(2 * i + (lane >> 5)) * 33 + (lane & 31)] = wv[i];
    asm volatile("s_waitcnt lgkmcnt(0)" ::: "memory");
    const int c = lane & 7;
#pragma unroll
    for (int j = 0; j < 4; ++j) { const int n = (lane >> 3) + 8 * j; const LAS float* s = scr + (8 * c) * 33 + n;
        v4u o; o.x = pk2(s[0 * 33], s[1 * 33]); o.y = pk2(s[2 * 33], s[3 * 33]); o.z = pk2(s[4 * 33], s[5 * 33]); o.w = pk2(s[6 * 33], s[7 * 33]);
        *(v4u*)(WT + (size_t)(row_off + n0 + n) * K + k0 + 8 * c) = o; }
    asm volatile("s_waitcnt lgkmcnt(0)" ::: "memory");
}
constexpr float W8_SCALE = 32.0f;
__device__ __forceinline__ unsigned pk4_fp8(float a, float b, float c, float d) {
    a = fminf(fmaxf(a, -448.f), 448.f); b = fminf(fmaxf(b, -448.f), 448.f); c = fminf(fmaxf(c, -448.f), 448.f); d = fminf(fmaxf(d, -448.f), 448.f);
    int w = 0; w = __builtin_amdgcn_cvt_pk_fp8_f32(a, b, w, false); w = __builtin_amdgcn_cvt_pk_fp8_f32(c, d, w, true); return (unsigned)w; }
__device__ __forceinline__ void p0_transpose_item_f8(const float* W, int K, int N, unsigned char* WT, int row_off, LAS float* scr, int kb, int nb, int lane) {
    const int k0 = 64 * kb, n0 = 32 * nb;
    float wv[32];
#pragma unroll
    for (int i = 0; i < 32; ++i) wv[i] = W[(size_t)(k0 + 2 * i + (lane >> 5)) * N + n0 + (lane & 31)];
#pragma unroll
    for (int i = 0; i < 32; ++i) scr[(2 * i + (lane >> 5)) * 33 + (lane & 31)] = wv[i] * W8_SCALE;
    asm volatile("s_waitcnt lgkmcnt(0)" ::: "memory");
    const int c = lane & 7;
#pragma unroll
    for (int j = 0; j < 4; ++j) { const int n = (lane >> 3) + 8 * j; const LAS float* s = scr + (8 * c) * 33 + n;
        v2u o; o.x = pk4_fp8(s[0 * 33], s[1 * 33], s[2 * 33], s[3 * 33]); o.y = pk4_fp8(s[4 * 33], s[5 * 33], s[6 * 33], s[7 * 33]);
        *(v2u*)(WT + (size_t)(row_off + n0 + n) * K + k0 + 8 * c) = o; }
    asm volatile("s_waitcnt lgkmcnt(0)" ::: "memory");
}
template <bool OB16, bool OF32, bool OF8> __device__ __forceinline__ void rms_row(const float* xrow, const float* g, bf16* o16, float* o32, unsigned char* o8, int lane) {
    const f32x4* xr = (const f32x4*)xrow + lane; const f32x4* gr = (const f32x4*)g + lane;
    f32x4 v[8]; float s = 0.f;
#pragma unroll
    for (int j = 0; j < 8; ++j) { v[j] = xr[64 * j]; s += (v[j].x * v[j].x + v[j].y * v[j].y) + (v[j].z * v[j].z + v[j].w * v[j].w); }
    const float rstd = 1.0f / sqrtf(wave_sum(s) * (1.0f / DM) + RMS_EPS);
#pragma unroll
    for (int j = 0; j < 8; ++j) { const f32x4 gg = gr[64 * j]; const f32x4 y = v[j] * rstd * gg;
        if (OF32) ((f32x4*)o32 + lane)[64 * j] = y;
        if (OF8) ((unsigned*)o8 + lane)[64 * j] = pk4_fp8(y.x, y.y, y.z, y.w);
        if (OB16) { v2u w; w.x = pk2(y.x, y.y); w.y = pk2(y.z, y.w); ((v2u*)o16 + lane)[64 * j] = w; } }
}

constexpr float C2S = 0.08838834764831845f * 1.4426950408889634f;
constexpr int ATT_KP = 144, ATT_VP = 80;
constexpr int ATT_KB = 32 * ATT_KP, ATT_VB = 128 * ATT_VP, ATT_BUF = ATT_KB + ATT_VB;
__device__ __forceinline__ bf16x8 f8x8_to_bf16x8(v2u w) {
    const f32x2v a = __builtin_amdgcn_cvt_pk_f32_fp8((int)w.x, false), b = __builtin_amdgcn_cvt_pk_f32_fp8((int)w.x, true), c = __builtin_amdgcn_cvt_pk_f32_fp8((int)w.y, false), d = __builtin_amdgcn_cvt_pk_f32_fp8((int)w.y, true);
    v4u o; o.x = pk2(a.x, a.y); o.y = pk2(b.x, b.y); o.z = pk2(c.x, c.y); o.w = pk2(d.x, d.y); return __builtin_bit_cast(bf16x8, o); }
struct AttPair { unsigned uq, uk, uv, orow; int j0, g; };
__device__ __forceinline__ AttPair att_decode(int pi, int grp, int qw) {
    AttPair d; const int uid = 2 * pi + grp, g = 2 - (uid >> 10), rest = uid & 1023, blk = rest & 15, h = (rest >> 4) & 15, b = rest >> 8;
    const int dsh = 2 * g; const bool has_prev = (blk & ((16 >> dsh) - 1)) != 0;
    d.j0 = __builtin_amdgcn_readfirstlane(has_prev ? 0 : 4); d.g = __builtin_amdgcn_readfirstlane(g);
    d.uq = __builtin_amdgcn_readfirstlane((unsigned)((((g * 2 + 0) * 4 + b) * 16 + h) * 2048 + blk * 128 + qw * 32) * 128u);
    d.uk = __builtin_amdgcn_readfirstlane((unsigned)((((g * 2 + 1) * 4 + b) * 16 + h) * 2048 + blk * 128 - 128) * 128u);
    d.uv = __builtin_amdgcn_readfirstlane((unsigned)(g * 2048 * 8192 + (b * 64 + blk * 4 - 4) * 65536 + h * 128 * 32) * 2u);
    d.orow = __builtin_amdgcn_readfirstlane((unsigned)(((g * 4 + b) * 16 + h) * 2048 + blk * 128 + qw * 32));
    return d;
}
__device__ __forceinline__ void attn_phase(const bf16* QK, const bf16* VT, bf16* OG, float* LSE, int bx, int G, int wave, int lane, LAS unsigned char* lds) {
    const int q = lane & 31, hh = lane >> 5, grp = wave >> 2, qw = wave & 3;
    const int kperm = (q & 0x13) | ((q & 4) << 1) | ((q & 8) >> 1);
    const char* QKc = (const char*)QK; const char* VTc = (const char*)VT;
    LAS unsigned char* gl = lds + grp * (2 * ATT_BUF);
    const int L2 = (qw * 64 + lane) * 2, L1 = qw * 64 + lane;
    const unsigned kw0 = (unsigned)((L1 >> 3) * ATT_KP + (L1 & 7) * 16);
    const unsigned vw0 = (unsigned)(ATT_KB + (L2 >> 2) * ATT_VP + (L2 & 3) * 16), vw1 = (unsigned)(ATT_KB + ((L2 + 1) >> 2) * ATT_VP + ((L2 + 1) & 3) * 16);
    const unsigned kr = (unsigned)(kperm * ATT_KP + 8 * hh), vr = (unsigned)(ATT_KB + q * ATT_VP + 16 * hh);
    const unsigned lqo = (unsigned)(q * 128 + 8 * hh);
    int pi = bx; if (pi >= 1536) return;
    v4u st[4][3]; long qf[8], qn[8];
#define ATT_FETCH(P, J, D) do { const char* kp_ = QKc + ((P).uk + (unsigned)(J) * 4096u + (unsigned)L1 * 16u); const char* vp_ = VTc + ((P).uv + (unsigned)(J) * 131072u + (unsigned)L2 * 16u); \
            D[0] = *(const v4u*)kp_; D[1] = *(const v4u*)vp_; D[2] = *(const v4u*)(vp_ + 16); } while (0)
#define ATT_PARK(J, D) do { LAS unsigned char* wb_ = gl + ((J) & 1) * ATT_BUF; *(LAS v4u*)(wb_ + kw0) = D[0]; *(LAS v4u*)(wb_ + vw0) = D[1]; *(LAS v4u*)(wb_ + vw1) = D[2]; } while (0)
#define ATT_LDQ(P, D) do { const char* qp_ = QKc + ((P).uq + lqo); _Pragma("unroll") for (int c = 0; c < 8; ++c) D[c] = *(const long*)(qp_ + 16 * c); } while (0)
    AttPair cur = att_decode(pi, grp, qw);
    ATT_LDQ(cur, qf);
    ATT_FETCH(cur, cur.j0, st[0]); ATT_FETCH(cur, cur.j0 + 1, st[1]); ATT_FETCH(cur, cur.j0 + 2, st[2]); ATT_FETCH(cur, cur.j0 + 3, st[3]);
    ATT_PARK(0, st[0]);
    asm volatile("s_waitcnt lgkmcnt(0)\n\ts_barrier" ::: "memory");
    for (;;) {
        const bool has_next = pi + G < 1536;
        AttPair nxt = cur; if (has_next) nxt = att_decode(pi + G, grp, qw);
        const int j0 = cur.j0;
        f32x16 O[4];
#pragma unroll
        for (int db = 0; db < 4; ++db)
#pragma unroll
            for (int i = 0; i < 16; ++i) O[db][i] = 0.f;
        float m = -INFINITY, l = 0.f;
#pragma unroll
        for (int j = 0; j < 8; ++j) {
            if (j < 4 && cur.g == 2) continue;
            if (j < 4) { if (j0 == 0) ATT_FETCH(cur, j + 4, st[j & 3]); }
            else if (has_next) { ATT_FETCH(nxt, nxt.j0 + (j - 4), st[j & 3]); if (j == 4) ATT_LDQ(nxt, qn); }
            const int t = j - qw;
            if (j >= j0 && t >= 0 && t <= 4) {
                const LAS unsigned char* rb = gl + (j & 1) * ATT_BUF;
                f32x16 S;
#pragma unroll
                for (int i = 0; i < 16; ++i) S[i] = 0.f;
                long kf[8]; bf16x8 vf[4][2];
#pragma unroll
                for (int c = 0; c < 8; ++c) kf[c] = *(const LAS long*)(rb + kr + 16 * c);
#pragma unroll
                for (int db = 0; db < 4; ++db) { vf[db][0] = *(const LAS bf16x8*)(rb + vr + db * 32 * ATT_VP); vf[db][1] = *(const LAS bf16x8*)(rb + vr + db * 32 * ATT_VP + 32); }
                __builtin_amdgcn_sched_barrier(0);
#pragma unroll
                for (int c = 0; c < 8; ++c) S = __builtin_amdgcn_mfma_f32_32x32x16_fp8_fp8(kf[c], qf[c], S, 0, 0, 0);
                if (t == 0) {
#pragma unroll
                    for (int i = 0; i < 16; ++i) { const int kt = 16 * (i >> 3) + 8 * hh + (i & 7); if (kt < q) S[i] = -INFINITY; }
                }
                if (t == 4) {
#pragma unroll
                    for (int i = 0; i < 16; ++i) { const int kt = 16 * (i >> 3) + 8 * hh + (i & 7); if (kt > q) S[i] = -INFINITY; }
                }
                float mx = S[0];
#pragma unroll
                for (int i = 1; i < 16; ++i) mx = fmaxf(mx, S[i]);
                mx = fmaxf(mx, __shfl_xor(mx, 32)) * C2S;
                if (__builtin_amdgcn_ballot_w64(mx > m + 8.0f) != 0ull) { const float mn = fmaxf(m, mx), alpha = __builtin_amdgcn_exp2f(m - mn); l *= alpha; m = mn;
#pragma unroll
                    for (int db = 0; db < 4; ++db)
#pragma unroll
                        for (int i = 0; i < 16; ++i) O[db][i] *= alpha; }
                float rs = 0.f;
#pragma unroll
                for (int i = 0; i < 16; ++i) { S[i] = __builtin_amdgcn_exp2f(__builtin_fmaf(S[i], C2S, -m)); rs += S[i]; }
                l += rs;
                v4u w0, w1;
                w0.x = pk2(S[0], S[1]); w0.y = pk2(S[2], S[3]); w0.z = pk2(S[4], S[5]); w0.w = pk2(S[6], S[7]);
                w1.x = pk2(S[8], S[9]); w1.y = pk2(S[10], S[11]); w1.z = pk2(S[12], S[13]); w1.w = pk2(S[14], S[15]);
                const bf16x8 ps0 = __builtin_bit_cast(bf16x8, w0), ps1 = __builtin_bit_cast(bf16x8, w1);
#pragma unroll
                for (int db = 0; db < 4; ++db) { O[db] = MFMA32(vf[db][0], ps0, O[db]); O[db] = MFMA32(vf[db][1], ps1, O[db]); }
            }
            if (j < 7) { if (j + 1 >= j0 + 1) ATT_PARK(j + 1, st[(j + 1) & 3]); }
            else if (has_next) ATT_PARK(0, st[0]);
            asm volatile("s_waitcnt lgkmcnt(0)\n\ts_barrier" ::: "memory");
        }
        l += __shfl_xor(l, 32);
        const float inv = 1.0f / l, lse2 = m + __builtin_amdgcn_logf(l);
        { LAS unsigned char* ob = lds + 61440 + wave * (32 * 272);
#pragma unroll
          for (int db = 0; db < 4; ++db)
#pragma unroll
              for (int i4 = 0; i4 < 4; ++i4) { v2u w; w.x = pk2(O[db][4 * i4] * inv, O[db][4 * i4 + 1] * inv); w.y = pk2(O[db][4 * i4 + 2] * inv, O[db][4 * i4 + 3] * inv);
                  *(LAS v2u*)(ob + q * 272 + (db * 32 + 8 * i4 + 4 * hh) * 2) = w; }
          asm volatile("s_waitcnt lgkmcnt(0)" ::: "memory");
          __attribute__((address_space(1))) unsigned char* og = (__attribute__((address_space(1))) unsigned char*)OG + (size_t)cur.orow * 256;
          const unsigned lo = (unsigned)((lane >> 4) * 256 + (lane & 15) * 16), li = (unsigned)((lane >> 4) * 272 + (lane & 15) * 16);
#pragma unroll
          for (int k = 0; k < 8; ++k) { const v4u x = *(const LAS v4u*)(ob + li + k * (4 * 272)); *(__attribute__((address_space(1))) v4u*)(og + (lo + (unsigned)k * 1024u)) = x; }
          asm volatile("s_waitcnt lgkmcnt(0)" ::: "memory"); }
        if (hh == 0) LSE[cur.orow + q] = lse2;
        if (!has_next) break;
        cur = nxt; pi += G;
#pragma unroll
        for (int c = 0; c < 8; ++c) qf[c] = qn[c];
    }
#undef ATT_FETCH
#undef ATT_PARK
#undef ATT_LDQ
}
__device__ __forceinline__ void merge_phase(const bf16* OG, const float* LSE, const bf16* GATE, bf16* Y, int gw, int NGW, int lane) {
    for (int row = gw; row < MTOK; row += NGW) { const int b = row >> 11, s = row & 2047;
#pragma unroll
        for (int j = 0; j < 4; ++j) { const int col = lane * 8 + 512 * j, h = col >> 7, e = col & 127;
            size_t r[3]; float lg[3];
#pragma unroll
            for (int g = 0; g < 3; ++g) { const int dsh = 2 * g, p = ((s & ((1 << dsh) - 1)) << (11 - dsh)) | (s >> dsh); r[g] = ((size_t)(g * 4 + b) * 16 + h) * 2048 + p; lg[g] = LSE[r[g]]; }
            const float mx = fmaxf(lg[0], fmaxf(lg[1], lg[2]));
            float w0 = __builtin_amdgcn_exp2f(lg[0] - mx), w1 = __builtin_amdgcn_exp2f(lg[1] - mx), w2 = __builtin_amdgcn_exp2f(lg[2] - mx);
            const float inv = 1.0f / (w0 + w1 + w2); w0 *= inv; w1 *= inv; w2 *= inv;
            const v4u a = *(const v4u*)(OG + r[0] * 128 + e), bb = *(const v4u*)(OG + r[1] * 128 + e), c = *(const v4u*)(OG + r[2] * 128 + e), gt = *(const v4u*)(GATE + (size_t)row * 2048 + col);
            v4u o;
#pragma unroll
            for (int k = 0; k < 4; ++k) {
                const float ylo = (w0 * bflo(a[k]) + w1 * bflo(bb[k]) + w2 * bflo(c[k])) * bflo(gt[k]);
                const float yhi = (w0 * bfhi(a[k]) + w1 * bfhi(bb[k]) + w2 * bfhi(c[k])) * bfhi(gt[k]);
                o[k] = pk2(ylo, yhi); }
            *(v4u*)(Y + (size_t)row * 2048 + col) = o; }
    }
}
__device__ __forceinline__ void sgu_phase(const bf16* VTB, const float* STATS, const float* LNG, const float* LNB, const bf16* WM, const float* BS, const bf16* U, const bf16* ZS, bf16* Y,
                                          int gw, int NGW, int lane, LAS unsigned char* wl) {
    const int r = lane & 31, hh = lane >> 5;
    for (int wu = gw; wu < 4096; wu += NGW) {
        const int cblk = wu & 3, g = (wu >> 2) & 15, chunk = (wu >> 6) & 15, b = wu >> 10;
        const int ch = g * 128 + cblk * 32 + r, tok0 = b * 2048 + chunk * 128;
        v4u raw[8];
#pragma unroll
        for (int ks = 0; ks < 8; ++ks) raw[ks] = *(const v4u*)(VTB + (size_t)((tok0 + 16 * ks) >> 5) * 65536 + (size_t)ch * 32 + ((16 * ks) & 31) + 8 * hh);
        v4u ur[4][2], zr[4][2]; float bs[4];
        { const __attribute__((address_space(1))) unsigned char* ub = (const __attribute__((address_space(1))) unsigned char*)U + ((size_t)tok0 * 2048 + g * 128 + cblk * 32) * 2;
          const __attribute__((address_space(1))) unsigned char* zb = (const __attribute__((address_space(1))) unsigned char*)ZS + ((size_t)tok0 * 2048 + g * 128 + cblk * 32) * 2;
          const unsigned lo = (unsigned)((lane >> 2) * 4096 + (lane & 3) * 16);
#pragma unroll
          for (int tb = 0; tb < 4; ++tb) { bs[tb] = BS[g * 128 + tb * 32 + r];
#pragma unroll
              for (int k = 0; k < 2; ++k) { ur[tb][k] = *(const __attribute__((address_space(1))) v4u*)(ub + (lo + (unsigned)(tb * 32 + k * 16) * 4096u)); zr[tb][k] = *(const __attribute__((address_space(1))) v4u*)(zb + (lo + (unsigned)(tb * 32 + k * 16) * 4096u)); } } }
        const float lng = LNG[ch], lnb = LNB[ch];
        bf16x8 af[8];
#pragma unroll
        for (int ks = 0; ks < 8; ++ks) { v4u o; const f32x4* sp = (const f32x4*)(STATS + 2 * (size_t)(tok0 + 16 * ks + 8 * hh));
#pragma unroll
            for (int k = 0; k < 4; ++k) { const f32x4 sv = sp[k];
                const float mu0 = sv.x * (1.0f / 2048), mu1 = sv.z * (1.0f / 2048);
                const float a0 = lng * __builtin_amdgcn_rsqf(fmaxf(sv.y * (1.0f / 2048) - mu0 * mu0, 0.f) + LN_EPS), a1 = lng * __builtin_amdgcn_rsqf(fmaxf(sv.w * (1.0f / 2048) - mu1 * mu1, 0.f) + LN_EPS);
                o[k] = pk2(bflo(raw[ks][k]) * a0 + (lnb - mu0 * a0), bfhi(raw[ks][k]) * a1 + (lnb - mu1 * a1)); }
            af[ks] = __builtin_bit_cast(bf16x8, o); }
        bf16x8 wf[2][8];
        { const bf16* wp = WM + (size_t)(g * 128 + r) * 128 + 8 * hh; wf[0][0] = *(const bf16x8*)wp; wf[0][1] = *(const bf16x8*)(wp + 16); }
#pragma unroll
        for (int tb = 0; tb < 4; ++tb) {
            f32x16 D;
#pragma unroll
            for (int i = 0; i < 16; ++i) D[i] = 0.f;
#pragma unroll
            for (int ks = 0; ks < 2 * tb + 2; ++ks) D = MFMA32(af[ks], wf[tb & 1][ks], D);
            __builtin_amdgcn_sched_barrier(0);
            if (tb < 3) { const bf16* wp = WM + (size_t)(g * 128 + (tb + 1) * 32 + r) * 128 + 8 * hh;
#pragma unroll
                for (int ks = 0; ks < 2 * tb + 4; ++ks) wf[(tb + 1) & 1][ks] = *(const bf16x8*)(wp + 16 * ks); }
            __builtin_amdgcn_sched_barrier(0);
            { const unsigned li = (unsigned)((lane >> 2) * 80 + (lane & 3) * 16);
#pragma unroll
              for (int k = 0; k < 2; ++k) { *(LAS v4u*)(wl + 2560 + li + k * (16 * 80)) = ur[tb][k]; *(LAS v4u*)(wl + 5120 + li + k * (16 * 80)) = zr[tb][k]; } }
            asm volatile("s_waitcnt lgkmcnt(0)" ::: "memory");
            v2u uq4[4], zq4[4];
#pragma unroll
            for (int i4 = 0; i4 < 4; ++i4) { uq4[i4] = *(const LAS v2u*)(wl + 2560 + r * 80 + (8 * i4 + 4 * hh) * 2); zq4[i4] = *(const LAS v2u*)(wl + 5120 + r * 80 + (8 * i4 + 4 * hh) * 2); }
            asm volatile("s_waitcnt lgkmcnt(0)" ::: "memory");
#pragma unroll
            for (int i4 = 0; i4 < 4; ++i4) { const v2u u4 = uq4[i4], z4 = zq4[i4];
                v2u w; w.x = pk2(bflo(u4.x) * (D[4 * i4] + bs[tb]) * bflo(z4.x), bfhi(u4.x) * (D[4 * i4 + 1] + bs[tb]) * bfhi(z4.x));
                w.y = pk2(bflo(u4.y) * (D[4 * i4 + 2] + bs[tb]) * bflo(z4.y), bfhi(u4.y) * (D[4 * i4 + 3] + bs[tb]) * bfhi(z4.y));
                *(LAS v2u*)(wl + r * 80 + (8 * i4 + 4 * hh) * 2) = w; }
            asm volatile("s_waitcnt lgkmcnt(0)" ::: "memory");
            { __attribute__((address_space(1))) unsigned char* yb = (__attribute__((address_space(1))) unsigned char*)Y + ((size_t)(tok0 + tb * 32) * 2048 + g * 128 + cblk * 32) * 2;
              const unsigned lo = (unsigned)((lane >> 2) * 4096 + (lane & 3) * 16), li = (unsigned)((lane >> 2) * 80 + (lane & 3) * 16);
#pragma unroll
              for (int k = 0; k < 2; ++k) { const v4u x = *(const LAS v4u*)(wl + li + k * (16 * 80)); *(__attribute__((address_space(1))) v4u*)(yb + (lo + (unsigned)k * 65536u)) = x; } }
            asm volatile("s_waitcnt lgkmcnt(0)" ::: "memory");
        }
    }
}

constexpr int N_PHASES = 19;
__global__ void __launch_bounds__(NTHR) trunk_fwd(Args args) {
    extern __shared__ __attribute__((aligned(16))) unsigned char lds[];
    const int wave = __builtin_amdgcn_readfirstlane(threadIdx.x >> 6);
#define tid (wave * 64 + lane_id())
#define lane lane_id()
    const int G = gridDim.x, bx = blockIdx.x;
    const int gw = bx * NWAVES + wave, NGW = G * NWAVES;
    unsigned char* ws = args.ws;
#define WS_PTRS __attribute__((address_space(1))) unsigned char* wg_ = (__attribute__((address_space(1))) unsigned char*)ws; asm volatile("" : "+s"(wg_)); unsigned char* wl_ = (unsigned char*)wg_;     \
    bf16* WAin = (bf16*)(wl_ + WS_WAIN); bf16* WAout = (bf16*)(wl_ + WS_WAOUT); bf16* WBin = (bf16*)(wl_ + WS_WBIN); bf16* WBout = (bf16*)(wl_ + WS_WBOUT); bf16* WM = (bf16*)(wl_ + WS_WM); float* COS = (float*)(wl_ + WS_COS); float* SIN = (float*)(wl_ + WS_SIN); float* STATS = (float*)(wl_ + WS_STATS); float* LSE = (float*)(wl_ + WS_LSE); float* X = (float*)(wl_ + WS_X); bf16* XN = (bf16*)(wl_ + WS_XN); bf16* QK = (bf16*)(wl_ + WS_QK); bf16* VT = (bf16*)(wl_ + WS_VT); bf16* GATE = (bf16*)(wl_ + WS_GATE); bf16* OG = (bf16*)(wl_ + WS_OG); bf16* Y = (bf16*)(wl_ + WS_Y); bf16* U = OG; bf16* ZS = OG + (size_t)MTOK * 2048; unsigned char* XN8 = wl_ + WS_XN8; float* RSS = (float*)(wl_ + WS_RSS); (void)RSS; (void)WAin; (void)WAout; (void)WBin; (void)WBout; (void)WM; (void)COS; (void)SIN; (void)STATS; (void)LSE; (void)X; (void)XN; (void)QK; (void)VT; (void)GATE; (void)OG; (void)Y; (void)U; (void)ZS; (void)XN8;
    const int lo = args.ph_lo, hi = args.ph_hi; (void)lo; (void)hi;
#if MK_PER_PHASE
#define IN(k) (lo <= (k) && (k) < hi)
#else
#define IN(k) true
#endif
    volatile LAS unsigned* MISC = (volatile LAS unsigned*)((LAS unsigned char*)lds + 131072 + 320);
    if (tid < 32) MISC[tid] = 0u;
    unsigned* barw = (unsigned*)(ws + WS_BAR);
#if !MK_PER_PHASE
    if (bx == 0) for (int i = tid; i < XCD_BAR_WORDS; i += NTHR) __hip_atomic_store(barw + i, 0u, __ATOMIC_RELAXED, __HIP_MEMORY_SCOPE_AGENT);
#endif
    __syncthreads();
    XcdBarrier xbar; xbar.w = wave; xbar.bar = barw; xbar.x = 0; xbar.st = MISC + 8;
#if MK_PER_PHASE
#define SEAM(k) do { } while (0)
#else
#define SEAM(k) do { if (IN(k) && IN((k) + 1)) xcd_barrier(xbar); } while (0)
#endif
    if (IN(0)) { WS_PTRS
        LAS float* scr = (LAS float*)((LAS unsigned char*)lds + wave * 16384);
        constexpr int I_AIN = 32 * (A_IN / 32), I_SQ = 32 * (DM / 32), I_BIN = 32 * (B_IN / 32);
        constexpr int NITEMS = 2 * (I_AIN + I_SQ + I_BIN + I_SQ);
        for (int it = gw; it < NITEMS; it += NGW) {
            int r = it; const int j = r / (NITEMS / 2); r -= j * (NITEMS / 2);
            if (r < I_AIN) { const int nblk = A_IN / 32, kb = r / nblk, nb = r % nblk, sb = (nb * 32) / 2048;
                unsigned char* W8 = (unsigned char*)WAin + (size_t)j * A_IN * DM * 2; bf16* W16 = (bf16*)(W8 + 48 * MiB);
                const float* src = args.a_w_in + (size_t)j * DM * A_IN;
                if (sb < 9 && (sb % 3) < 2) p0_transpose_item_f8(src, DM, A_IN, W8, (2 * (sb / 3) + (sb % 3) - sb) * 2048, scr, kb, nb, lane);
                else if (A_VG_FP8 && !(A_GATE_BF16 && sb == 9)) p0_transpose_item_f8(src, DM, A_IN, W8, ((sb == 9 ? 6 : 7 + sb / 3) - sb) * 2048, scr, kb, nb, lane);
                else p0_transpose_item(src, DM, A_IN, W16, ((sb == 9 ? 0 : 1 + sb / 3) - sb) * 2048, scr, kb, nb, lane);
                continue; } r -= I_AIN;
            if (r < I_SQ) { p0_transpose_item(args.a_w_out + (size_t)j * DM * DM, DM, DM, WAout + (size_t)j * DM * DM, 0, scr, r / (DM / 32), r % (DM / 32), lane); continue; } r -= I_SQ;
            if (r < I_BIN) { const int nblk = B_IN / 32, kb = r / nblk, nb = r % nblk, sb = (nb * 32) / 2048;
                const int db = sb == 0 ? 0 : (sb == 1 ? 2 : 1);
                p0_transpose_item(args.b_w_in + (size_t)j * DM * B_IN, DM, B_IN, WBin + (size_t)j * B_IN * DM, (db - sb) * 2048, scr, kb, nb, lane); continue; } r -= I_BIN;
            p0_transpose_item(args.b_w_out + (size_t)j * DM * DM, DM, DM, WBout + (size_t)j * DM * DM, 0, scr, r / (DM / 32), r % (DM / 32), lane);
        }
        const int gt = bx * NTHR + tid, NGT = G * NTHR;
        for (int i = gt; i < 2 * 16 * 128 * 128 / 2; i += NGT) { const int e = 2 * i, s = e & 127, t = (e >> 7) & 127;
            const f32x2v w = *(const f32x2v*)(args.b_w_s + e); ((unsigned*)WM)[i] = pk2(s <= t ? w.x : 0.f, s + 1 <= t ? w.y : 0.f); }
        for (int i = gt; i < MTOK * 16; i += NGT) { const int tok = i >> 4, f = i & 15; const double rev = (double)args.pos[tok] * args.invf[f]; const float fr = (float)(rev - floor(rev));
            COS[i] = __builtin_amdgcn_cosf(fr); SIN[i] = __builtin_amdgcn_sinf(fr); }
        for (int i = gt; i < 2 * MTOK * 2; i += NGT) STATS[i] = 0.f;
        for (int i = gt; i < 4 * MTOK; i += NGT) RSS[i] = i < MTOK ? 2048.0f * (1.0f - 1e-6f) : 0.f;
        for (int m = gw; m < MTOK; m += NGW) rms_row<(!A_VG_FP8 || A_GATE_BF16), false, true>(args.x + (size_t)m * DM, args.a_norm_g, XN + (size_t)m * DM, nullptr, XN8 + (size_t)m * DM, lane);
    }
#if !MK_PER_PHASE
    cg::this_grid().sync();
    xbar = xcd_barrier_post(barw, MISC + 8, wave);
#endif
    for (int rep = 0; rep < 2; ++rep) {
        const int P = 1 + 9 * rep;
        if (IN(P)) { WS_PTRS
            const char* W8 = (const char*)WAin + (size_t)rep * A_IN * DM * 2;
            const float* rssA = RSS + (size_t)(2 * rep) * MTOK;
            const pg8::EpiA1 e1{QK, GATE, COS, SIN, 1.0f / W8_SCALE, 0, rssA};
#if A_VG_FP8 && A_GATE_BF16
            { pg8::MultiOrder S{{(const char*)XN8, W8, 32, 48, 1}, {W8 + (size_t)14336 * DM, (const char*)XN8, 8, 32, 1}, {W8 + (size_t)16384 * DM, (const char*)XN8, 8, 32, 4},
                                {W8 + (size_t)18432 * DM, (const char*)XN8, 8, 32, 16}, 4, launder_s(G), launder_s(bx), DM};
              pg8::EpiAllA E{e1, pg8::EpiPlain{VT, 1.0f / W8_SCALE, rssA, 0}, 1};
              pg8::gemm_phase<pg8::EpiAllA, pg8::MultiOrder, true, true, true>((LAS unsigned char*)lds, DM, S, E, wave); }
            { const char* W16 = W8 + 48 * MiB;
              pg8::MultiOrder S{{(const char*)XN, W16, 32, 8, 1}, {nullptr, nullptr, 0, 0, 1}, {nullptr, nullptr, 0, 0, 1}, {nullptr, nullptr, 0, 0, 1}, 1, launder_s(G), launder_s(bx), DM * 2};
              const pg8::EpiA1 eg{QK, GATE, COS, SIN, 1.0f, 48, rssA};
              pg8::gemm_phase<pg8::EpiA1, pg8::MultiOrder, true, true, false>((LAS unsigned char*)lds, DM, S, eg, wave); }
#elif A_VG_FP8
            pg8::MultiOrder S{{(const char*)XN8, W8, 32, 56, 1}, {W8 + (size_t)14336 * DM, (const char*)XN8, 8, 32, 1}, {W8 + (size_t)16384 * DM, (const char*)XN8, 8, 32, 4},
                              {W8 + (size_t)18432 * DM, (const char*)XN8, 8, 32, 16}, 4, launder_s(G), launder_s(bx), DM};
            pg8::EpiAllA E{e1, pg8::EpiPlain{VT, 1.0f / W8_SCALE, rssA, 0}, 1};
            pg8::gemm_phase<pg8::EpiAllA, pg8::MultiOrder, true, true, true>((LAS unsigned char*)lds, DM, S, E, wave);
#else
            { pg8::MultiOrder S{{(const char*)XN8, W8, 32, 48, 1}, {nullptr, nullptr, 0, 0, 1}, {nullptr, nullptr, 0, 0, 1}, {nullptr, nullptr, 0, 0, 1}, 1, launder_s(G), launder_s(bx), DM};
              pg8::gemm_phase<pg8::EpiA1, pg8::MultiOrder, true, true, true>((LAS unsigned char*)lds, DM, S, e1, wave); }
            { const char* W16 = W8 + 48 * MiB;
              pg8::MultiOrder S{{(const char*)XN, W16, 32, 8, 1}, {W16 + (size_t)2048 * DM * 2, (const char*)XN, 8, 32, 1}, {W16 + (size_t)4096 * DM * 2, (const char*)XN, 8, 32, 4},
                                {W16 + (size_t)6144 * DM * 2, (const char*)XN, 8, 32, 16}, 4, launder_s(G), launder_s(bx), DM * 2};
              pg8::EpiAllA E{pg8::EpiA1{QK, GATE, COS, SIN, 1.0f, 48, rssA}, pg8::EpiPlain{VT, 1.0f, rssA, 0}, 1};
              pg8::gemm_phase<pg8::EpiAllA, pg8::MultiOrder, true, true, false>((LAS unsigned char*)lds, DM, S, E, wave); }
#endif
        }
        SEAM(P);
        if (IN(P + 1)) { WS_PTRS attn_phase(QK, VT, OG, LSE, bx, G, wave, launder(lane), (LAS unsigned char*)lds); }
        SEAM(P + 1);
        if (IN(P + 2)) { WS_PTRS merge_phase(OG, LSE, GATE, Y, gw, NGW, launder(lane)); }
        SEAM(P + 2);
        if (IN(P + 3)) { WS_PTRS pg8::MultiOrder S{{(const char*)Y, (const char*)(WAout + (size_t)rep * DM * DM), 32, 8, 1}, {nullptr, nullptr, 0, 0, 1}, {nullptr, nullptr, 0, 0, 1}, {nullptr, nullptr, 0, 0, 1}, 1, launder_s(G), launder_s(bx), DM * 2};
            pg8::EpiOut E{rep == 0 ? args.x : X, X, args.b_norm_g + (size_t)rep * DM, XN, nullptr, RSS + (size_t)(2 * rep + 1) * MTOK};
            pg8::gemm_phase<pg8::EpiOut, pg8::MultiOrder, true, true>((LAS unsigned char*)lds, DM, S, E, wave); }
        SEAM(P + 3);
        if (IN(P + 5)) { WS_PTRS
            const char* W = (const char*)(WBin + (size_t)rep * B_IN * DM);
            pg8::MultiOrder S{{(const char*)XN, W, 32, 16, 1}, {W + (size_t)4096 * DM * 2, (const char*)XN, 8, 32, 1}, {nullptr, nullptr, 0, 0, 1}, {nullptr, nullptr, 0, 0, 1}, 2, launder_s(G), launder_s(bx), DM * 2};
            const float* rssB = RSS + (size_t)(2 * rep + 1) * MTOK;
            pg8::EpiAllB E{pg8::EpiB1{U, ZS, rssB}, pg8::EpiB2{VT, STATS + (size_t)rep * MTOK * 2, rssB}};
            pg8::gemm_phase<pg8::EpiAllB, pg8::MultiOrder, true, true>((LAS unsigned char*)lds, DM, S, E, wave);
        }
        SEAM(P + 5);
        if (IN(P + 6)) { WS_PTRS sgu_phase(VT, STATS + (size_t)rep * MTOK * 2, args.b_ln_g + (size_t)rep * DM, args.b_ln_b + (size_t)rep * DM, WM + (size_t)rep * 16 * 128 * 128, args.b_b_s + (size_t)rep * 16 * 128, U, ZS, Y, gw, NGW, launder(lane), (LAS unsigned char*)lds + wave * 8192); }
        SEAM(P + 6);
        if (IN(P + 7)) { WS_PTRS pg8::MultiOrder S{{(const char*)Y, (const char*)(WBout + (size_t)rep * DM * DM), 32, 8, 1}, {nullptr, nullptr, 0, 0, 1}, {nullptr, nullptr, 0, 0, 1}, {nullptr, nullptr, 0, 0, 1}, 1, launder_s(G), launder_s(bx), DM * 2};
            pg8::EpiOut E{X, X, rep == 0 ? args.a_norm_g + DM : nullptr, XN, XN8, RSS + (size_t)2 * MTOK};
            pg8::gemm_phase<pg8::EpiOut, pg8::MultiOrder, true, true>((LAS unsigned char*)lds, DM, S, E, wave); }
        if (rep == 1) SEAM(P + 7);
        if (IN(P + 8)) { WS_PTRS const int ln = launder(lane);
            if (rep == 1) { for (int m = gw; m < MTOK; m += NGW) rms_row<false, true, false>(X + (size_t)m * DM, args.final_g, nullptr, args.out + (size_t)m * DM, nullptr, ln); }
        }
        if (rep == 0) SEAM(P + 8);
    }
#undef IN
#undef SEAM
#undef tid
#undef lane
}

extern "C" void kernel_launch(void* const* d_in, const int* in_sizes, int n_in, void* d_out, int out_size, void* d_ws, size_t ws_size, hipStream_t stream) {
    static int grid = 0;
    if (grid == 0) {
        if (n_in != 13 || in_sizes[0] != MTOK * DM || out_size != MTOK * DM || ws_size < WS_END) { fprintf(stderr, "kernel_launch: unexpected shapes / workspace (n_in %d, in0 %d, out %d, ws %zu, need %zu)\n", n_in, n_in > 0 ? in_sizes[0] : -1, out_size, ws_size, (size_t)WS_END); grid = -1; return; }
        int dev = 0, cus = 0, per_cu = 0;
        if (hipGetDevice(&dev) != hipSuccess || hipDeviceGetAttribute(&cus, hipDeviceAttributeMultiprocessorCount, dev) != hipSuccess) { grid = -1; return; }
        if (hipFuncSetAttribute((const void*)trunk_fwd, hipFuncAttributeMaxDynamicSharedMemorySize, LDS_BYTES) != hipSuccess) { fprintf(stderr, "kernel_launch: hipFuncSetAttribute failed\n"); grid = -1; return; }
        if (hipOccupancyMaxActiveBlocksPerMultiprocessor(&per_cu, (const void*)trunk_fwd, NTHR, LDS_BYTES) != hipSuccess || per_cu < 1) { fprintf(stderr, "kernel_launch: occupancy query failed (%d)\n", per_cu); (void)hipGetLastError(); grid = -1; return; }
        grid = cus * per_cu;
    }
    if (grid < 0) return;
    Args a{};
    a.x = (const float*)d_in[0]; a.pos = (const int*)d_in[1]; a.a_norm_g = (const float*)d_in[2]; a.a_w_in = (const float*)d_in[3]; a.a_w_out = (const float*)d_in[4];
    a.b_norm_g = (const float*)d_in[5]; a.b_w_in = (const float*)d_in[6]; a.b_ln_g = (const float*)d_in[7]; a.b_ln_b = (const float*)d_in[8]; a.b_w_s = (const float*)d_in[9];
    a.b_b_s = (const float*)d_in[10]; a.b_w_out = (const float*)d_in[11]; a.final_g = (const float*)d_in[12];
    a.out = (float*)d_out; a.ws = (unsigned char*)d_ws;
    for (int i = 0; i < 16; ++i) a.invf[i] = pow(500000.0, -(double)i / 16.0) / 6.283185307179586476925;
#if MK_PER_PHASE
    for (int p = 0; p < N_PHASES; ++p) { a.ph_lo = p; a.ph_hi = p + 1; hipLaunchKernelGGL(trunk_fwd, dim3(grid), dim3(NTHR), LDS_BYTES, stream, a); }
#else
    a.ph_lo = 0; a.ph_hi = N_PHASES;
    void* kargs[] = {&a};
    const hipError_t e = hipLaunchCooperativeKernel((const void*)trunk_fwd, dim3(grid), dim3(NTHR), kargs, LDS_BYTES, stream);
    if (e != hipSuccess) fprintf(stderr, "kernel_launch: cooperative launch failed: %s (grid %d)\n", hipGetErrorString(e), grid);
#endif
}
```
